# Optimizing an MI355X kernel written in HIP

```python
import math
import jax, jax.numpy as jnp
from jax import lax
import numpy as np

D_MODEL = 1024
BATCH = 8
SEQ = 2048
DEPTH = 2
DEC_BATCH = 128
DEC_SEQ = 8
PAST_LEN = 16384
PAGE_SIZE = 128

BRANCH_W = D_MODEL // 2
N_BRANCH = 4
HG_HEADS = 4
HG_DK = BRANCH_W // HG_HEADS
HG_DV = BRANCH_W // HG_HEADS
HG_CHUNK = 32
RW_HEAD = 64
RW_HEADS = BRANCH_W // RW_HEAD
RW_W_RANK = 64
RW_A_RANK = 64
RW_G_RANK = 128
RW_DECAY_SCALE = 0.606531
RW_GN_EPS = 64e-5
CF_WIDTH = 31
LRU_BLOCKS = 8
LRU_BW = BRANCH_W // LRU_BLOCKS
LRU_CONV = 4
LRU_C = 8.0
MLP_HIDDEN = 4 * D_MODEL
EPS = 1e-6

HG_COLS = 4 * BRANCH_W
RW_COLS = 3 * BRANCH_W + RW_W_RANK + RW_A_RANK + RW_G_RANK
CF_COLS = 2 * BRANCH_W
LRU_COLS = 2 * BRANCH_W
IN_COLS = HG_COLS + RW_COLS + CF_COLS + LRU_COLS

kernel_name = "hgrn2_rwkv7_conformer_rglru_parallel_decoder_step"


def rmsnorm(x, g):
    xf = x.astype(jnp.float32)
    y = xf * lax.rsqrt(jnp.mean(xf * xf, axis=-1, keepdims=True) + EPS)
    return (y * g.astype(jnp.float32)).astype(x.dtype)


def layernorm(x, g, b):
    xf = x.astype(jnp.float32)
    mu = jnp.mean(xf, axis=-1, keepdims=True)
    var = jnp.mean(jnp.square(xf - mu), axis=-1, keepdims=True)
    y = (xf - mu) * lax.rsqrt(var + 1e-5) * g.astype(jnp.float32) + b.astype(jnp.float32)
    return y.astype(x.dtype)


def causal_dwconv(buf, u, w, b):
    k = w.shape[0]
    full = jnp.concatenate([buf.astype(u.dtype), u], axis=1)
    y = lax.conv_general_dilated(full, w[:, None, :].astype(u.dtype), window_strides=(1,),
                                 padding="VALID", dimension_numbers=("NWC", "WIO", "NWC"),
                                 feature_group_count=u.shape[-1])
    return y + b.astype(u.dtype), full[:, -(k - 1):]


def hgrn2_chunked(q, k, logf, v, s0):
    bsz, t, h, _ = q.shape
    dv = v.shape[-1]
    c = math.gcd(t, HG_CHUNK)
    n = t // c

    def to_chunks(a):
        return a.reshape(bsz, n, c, h, a.shape[-1]).transpose(1, 0, 3, 2, 4)

    causal = jnp.tril(jnp.ones((c, c), dtype=bool))[:, :, None]

    def step(s, inp):
        qi, ki, fi, vi = inp
        b = jnp.cumsum(fi, axis=2)
        o_inter = jnp.einsum("bhtd,bhdv->bhtv", qi * jnp.exp(b), s)
        diff = b[:, :, :, None, :] - b[:, :, None, :, :]
        decay = jnp.exp(jnp.where(causal, diff, -jnp.inf))
        scores = jnp.sum(qi[:, :, :, None, :] * ki[:, :, None, :, :] * decay, axis=-1)
        o = o_inter + jnp.einsum("bhts,bhsv->bhtv", scores, vi)
        b_last = b[:, :, -1:, :]
        s_new = jnp.exp(b_last[:, :, 0, :])[..., None] * s + \
            jnp.einsum("bhsd,bhsv->bhdv", ki * jnp.exp(b_last - b), vi)
        return s_new, o

    s_fin, o = lax.scan(step, s0, tuple(map(to_chunks, (q, k, logf, v))))
    return o.transpose(1, 0, 3, 2, 4).reshape(bsz, t, h, dv), s_fin


def rwkv7_scan(r, w, k, v, kk, a, s0):
    def step(s, inp):
        rt, wt, kt, vt, kkt, at = inp
        sa = jnp.einsum("bhvk,bhk->bhv", s, -kkt)
        s = s * wt[:, :, None, :] + sa[..., None] * (kkt * at)[:, :, None, :] + vt[..., None] * kt[:, :, None, :]
        return s, jnp.einsum("bhvk,bhk->bhv", s, rt)

    xs = tuple(jnp.moveaxis(z, 1, 0) for z in (r, w, k, v, kk, a))
    s_fin, y = lax.scan(step, s0, xs)
    return jnp.moveaxis(y, 0, 1), s_fin


def _lin_combine(e1, e2):
    a1, b1 = e1
    a2, b2 = e2
    return a1 * a2, a2 * b1 + b2


def token_mixers(h, p, l, lb_l, s_hg, s_rw, s_shift, s_cf, s_lh, s_lc):
    bsz, t, _ = h.shape
    dt = h.dtype
    f32 = jnp.float32
    W = BRANCH_W
    proj = h @ p["w_in"][l]
    hg, rw, cf, lr = jnp.split(proj, [HG_COLS, HG_COLS + RW_COLS, HG_COLS + RW_COLS + CF_COLS], axis=-1)

    q, fz, iv, og = jnp.split(hg.astype(f32), 4, axis=-1)
    lb_l = lb_l.astype(f32)
    logf = jnp.log(lb_l + (1.0 - lb_l) * jax.nn.sigmoid(fz))
    kf = (1.0 - lb_l) * jax.nn.sigmoid(-fz)
    o, s_hg_new = hgrn2_chunked(jax.nn.silu(q).reshape(bsz, t, HG_HEADS, HG_DK),
                                kf.reshape(bsz, t, HG_HEADS, HG_DK),
                                logf.reshape(bsz, t, HG_HEADS, HG_DK),
                                iv.reshape(bsz, t, HG_HEADS, HG_DV), s_hg.astype(f32))
    o = o * lax.rsqrt(jnp.mean(o * o, axis=-1, keepdims=True) + EPS)
    y_hg = o.reshape(bsz, t, W) * p["hg_norm_g"][l] * jax.nn.silu(og)

    prev = jnp.concatenate([s_shift[:, None, :].astype(dt), rw[:, :-1]], axis=1)
    rwm = (rw + (prev - rw) * p["rw_mu"][l]).astype(f32)
    r, k, v, wd, ad, gd = jnp.split(rwm, [W, 2 * W, 3 * W, 3 * W + RW_W_RANK, 3 * W + RW_W_RANK + RW_A_RANK], axis=-1)
    log_w = -RW_DECAY_SCALE * jax.nn.sigmoid(p["rw_w0"][l] + jnp.tanh(wd) @ p["rw_w_up"][l])
    a = jax.nn.sigmoid(p["rw_a0"][l] + ad @ p["rw_a_up"][l])
    gate = jax.nn.sigmoid(gd) @ p["rw_g_up"][l]
    hr = lambda z: z.reshape(bsz, t, RW_HEADS, RW_HEAD)
    kk = hr(k * p["rw_k_k"][l])
    kk = kk / jnp.maximum(jnp.sqrt(jnp.sum(kk * kk, axis=-1, keepdims=True)), 1e-12)
    k = k * (1.0 + (a - 1.0) * p["rw_k_a"][l])
    y, s_rw_new = rwkv7_scan(hr(r), hr(jnp.exp(log_w)), hr(k), hr(v), kk, hr(a), s_rw.astype(f32))
    mu = jnp.mean(y, axis=-1, keepdims=True)
    var = jnp.mean(jnp.square(y - mu), axis=-1, keepdims=True)
    y = ((y - mu) * lax.rsqrt(var + RW_GN_EPS)).reshape(bsz, t, W) * p["rw_ln_g"][l] + p["rw_ln_b"][l]
    bonus = jnp.sum(hr(r * k * p["rw_r_k"][l]), axis=-1, keepdims=True) * hr(v)
    y_rw = (y + bonus.reshape(bsz, t, W)) * gate

    u = cf[..., :W] * jax.nn.sigmoid(cf[..., W:])
    yc, s_cf_new = causal_dwconv(s_cf, u, p["cf_dw"][l], p["cf_dw_b"][l])
    y_cf = jax.nn.silu(layernorm(yc, p["cf_ln_g"][l], p["cf_ln_b"][l]))

    xl, gl = lr[..., :W], lr[..., W:]
    xc, s_lc_new = causal_dwconv(s_lc, xl, p["lru_conv_w"][l], p["lru_conv_b"][l])
    xcf = xc.astype(f32)
    xb = xcf.reshape(bsz, t, LRU_BLOCKS, LRU_BW)
    rg = jax.nn.sigmoid(jnp.einsum("btnc,ncd->btnd", xb, p["lru_wa"][l]).reshape(bsz, t, W) + p["lru_ba"][l])
    ig = jax.nn.sigmoid(jnp.einsum("btnc,ncd->btnd", xb, p["lru_wx"][l]).reshape(bsz, t, W) + p["lru_bx"][l])
    log_a = -LRU_C * rg * jax.nn.softplus(-p["lru_lambda"][l].astype(f32))
    a_t = jnp.exp(log_a)
    b_t = jnp.sqrt(-jnp.expm1(2.0 * log_a)) * (ig * xcf)
    b_t = b_t.at[:, 0].add(a_t[:, 0] * s_lh.astype(f32))
    _, hs = lax.associative_scan(_lin_combine, (a_t, b_t), axis=1)
    y_lru = hs * jax.nn.gelu(gl.astype(f32))

    branches = jnp.stack([y_hg, y_rw, y_cf, y_lru], axis=2).astype(dt)
    bo = jnp.einsum("btkc,kcd->btkd", branches, p["w_branch"][l])
    gates = jax.nn.sigmoid((h @ p["w_gate"][l] + p["b_gate"][l]).reshape(bsz, t, N_BRANCH, D_MODEL))
    out = jnp.sum(gates * bo, axis=2) @ p["w_out"][l]
    new_states = (s_hg_new.astype(s_hg.dtype), s_rw_new.astype(s_rw.dtype), rw[:, -1].astype(s_shift.dtype),
                  s_cf_new.astype(s_cf.dtype), hs[:, -1].astype(s_lh.dtype), s_lc_new.astype(s_lc.dtype))
    return out, new_states


def trunk(x, c, states, p):
    sm = jax.nn.softmax(p["hg_lower"].astype(jnp.float32), axis=0)
    lb = jnp.cumsum(sm, axis=0) - sm[0]
    mod_c = jax.nn.silu(c)
    collected = [[] for _ in range(6)]
    for l in range(DEPTH):
        mod = mod_c @ p["ada_w"][l] + p["ada_b"][l]
        sh1, sc1, g1, sh2, sc2, g2 = [m[:, None, :] for m in jnp.split(mod, 6, axis=-1)]
        h = rmsnorm(x, p["norm_mix_g"][l]) * (1.0 + sc1) + sh1
        out, st_new = token_mixers(h, p, l, lb[l], *[s[l] for s in states])
        x = x + g1 * out
        h2 = rmsnorm(x, p["norm_mlp_g"][l]) * (1.0 + sc2) + sh2
        x = x + g2 * (jnp.square(jax.nn.relu(h2 @ p["w_mlp1"][l])) @ p["w_mlp2"][l])
        for lst, s in zip(collected, st_new):
            lst.append(s)
    y = rmsnorm(x, p["norm_final_g"])
    return y, [jnp.stack(lst, axis=0) for lst in collected]


def setup_inputs(seed: int = 0) -> dict:
    key = jax.random.key(seed)
    keys = jax.random.split(key, 64)
    ctr = [0]

    def nrm(shape, s):
        kk = keys[ctr[0]]
        ctr[0] += 1
        return s * jax.random.normal(kk, shape, jnp.float32)

    def unif(shape, lo, hi):
        kk = keys[ctr[0]]
        ctr[0] += 1
        return jax.random.uniform(kk, shape, jnp.float32, lo, hi)

    D, W, L = D_MODEL, BRANCH_W, DEPTH
    inp = {}
    inp["x_prompt"] = nrm((BATCH, SEQ, D), 1.0)
    inp["x_sample"] = nrm((DEC_BATCH, DEC_SEQ, D), 1.0)
    inp["state_hgrn"] = nrm((L, DEC_BATCH, HG_HEADS, HG_DK, HG_DV), 0.5)
    inp["state_rwkv"] = nrm((L, DEC_BATCH, RW_HEADS, RW_HEAD, RW_HEAD), 0.3)
    inp["state_rwkv_shift"] = nrm((L, DEC_BATCH, RW_COLS), 1.0)
    inp["state_conv"] = nrm((L, DEC_BATCH, CF_WIDTH - 1, W), 0.5)
    inp["state_lru_h"] = nrm((L, DEC_BATCH, W), 0.5)
    inp["state_lru_conv"] = nrm((L, DEC_BATCH, LRU_CONV - 1, W), 1.0)
    inp["c_prompt"] = nrm((BATCH, D), 1.0)
    inp["c_sample"] = nrm((DEC_BATCH, D), 1.0)
    inp["ada_w"] = nrm((L, D, 6 * D), 0.5 * D ** -0.5)
    inp["ada_b"] = nrm((L, 6 * D), 0.02)
    inp["norm_mix_g"] = 1.0 + nrm((L, D), 0.05)
    inp["norm_mlp_g"] = 1.0 + nrm((L, D), 0.05)
    inp["norm_final_g"] = 1.0 + nrm((D,), 0.05)
    inp["w_in"] = nrm((L, D, IN_COLS), D ** -0.5)
    inp["hg_lower"] = nrm((L, W), 0.1)
    inp["hg_norm_g"] = 1.0 + nrm((L, W), 0.05)
    inp["rw_mu"] = unif((L, RW_COLS), 0.0, 1.0)
    inp["rw_w0"] = nrm((L, W), 0.5)
    inp["rw_w_up"] = nrm((L, RW_W_RANK, W), 0.5 * RW_W_RANK ** -0.5)
    inp["rw_a0"] = nrm((L, W), 0.1)
    inp["rw_a_up"] = nrm((L, RW_A_RANK, W), RW_A_RANK ** -0.5)
    inp["rw_g_up"] = nrm((L, RW_G_RANK, W), RW_G_RANK ** -0.5)
    inp["rw_k_k"] = 0.85 + nrm((L, W), 0.05)
    inp["rw_k_a"] = 1.0 + nrm((L, W), 0.05)
    inp["rw_r_k"] = nrm((L, W), 0.1)
    inp["rw_ln_g"] = 1.0 + nrm((L, W), 0.05)
    inp["rw_ln_b"] = nrm((L, W), 0.02)
    inp["cf_dw"] = nrm((L, CF_WIDTH, W), CF_WIDTH ** -0.5)
    inp["cf_dw_b"] = nrm((L, W), 0.02)
    inp["cf_ln_g"] = 1.0 + nrm((L, W), 0.05)
    inp["cf_ln_b"] = nrm((L, W), 0.02)
    inp["lru_conv_w"] = nrm((L, LRU_CONV, W), LRU_CONV ** -0.5)
    inp["lru_conv_b"] = nrm((L, W), 0.02)
    inp["lru_wa"] = nrm((L, LRU_BLOCKS, LRU_BW, LRU_BW), LRU_BW ** -0.5)
    inp["lru_ba"] = nrm((L, W), 0.02)
    inp["lru_wx"] = nrm((L, LRU_BLOCKS, LRU_BW, LRU_BW), LRU_BW ** -0.5)
    inp["lru_bx"] = nrm((L, W), 0.02)
    a0 = unif((L, W), 0.9, 0.999) ** (1.0 / LRU_C)
    inp["lru_lambda"] = jnp.log(a0) - jnp.log1p(-a0)
    inp["w_branch"] = nrm((L, N_BRANCH, W, D), W ** -0.5)
    inp["w_gate"] = nrm((L, D, N_BRANCH * D), D ** -0.5)
    inp["b_gate"] = nrm((L, N_BRANCH * D), 0.02)
    inp["w_out"] = nrm((L, D, D), D ** -0.5)
    inp["w_mlp1"] = nrm((L, D, MLP_HIDDEN), D ** -0.5)
    inp["w_mlp2"] = nrm((L, MLP_HIDDEN, D), MLP_HIDDEN ** -0.5)
    return inp


def reference(x_prompt, x_sample, state_hgrn, state_rwkv, state_rwkv_shift, state_conv, state_lru_h,
              state_lru_conv, c_prompt, c_sample, ada_w, ada_b, norm_mix_g, norm_mlp_g, norm_final_g,
              w_in, hg_lower, hg_norm_g, rw_mu, rw_w0, rw_w_up, rw_a0, rw_a_up, rw_g_up, rw_k_k, rw_k_a,
              rw_r_k, rw_ln_g, rw_ln_b, cf_dw, cf_dw_b, cf_ln_g, cf_ln_b, lru_conv_w, lru_conv_b, lru_wa,
              lru_ba, lru_wx, lru_bx, lru_lambda, w_branch, w_gate, b_gate, w_out, w_mlp1, w_mlp2):
    p = dict(ada_w=ada_w, ada_b=ada_b, norm_mix_g=norm_mix_g, norm_mlp_g=norm_mlp_g,
             norm_final_g=norm_final_g, w_in=w_in, hg_lower=hg_lower, hg_norm_g=hg_norm_g, rw_mu=rw_mu,
             rw_w0=rw_w0, rw_w_up=rw_w_up, rw_a0=rw_a0, rw_a_up=rw_a_up, rw_g_up=rw_g_up, rw_k_k=rw_k_k,
             rw_k_a=rw_k_a, rw_r_k=rw_r_k, rw_ln_g=rw_ln_g, rw_ln_b=rw_ln_b, cf_dw=cf_dw, cf_dw_b=cf_dw_b,
             cf_ln_g=cf_ln_g, cf_ln_b=cf_ln_b, lru_conv_w=lru_conv_w, lru_conv_b=lru_conv_b, lru_wa=lru_wa,
             lru_ba=lru_ba, lru_wx=lru_wx, lru_bx=lru_bx, lru_lambda=lru_lambda, w_branch=w_branch,
             w_gate=w_gate, b_gate=b_gate, w_out=w_out, w_mlp1=w_mlp1, w_mlp2=w_mlp2)
    dt = x_prompt.dtype
    bp = x_prompt.shape[0]
    zero_states = (
        jnp.zeros((DEPTH, bp, HG_HEADS, HG_DK, HG_DV), dt),
        jnp.zeros((DEPTH, bp, RW_HEADS, RW_HEAD, RW_HEAD), dt),
        jnp.zeros((DEPTH, bp, RW_COLS), dt),
        jnp.zeros((DEPTH, bp, CF_WIDTH - 1, BRANCH_W), dt),
        jnp.zeros((DEPTH, bp, BRANCH_W), dt),
        jnp.zeros((DEPTH, bp, LRU_CONV - 1, BRANCH_W), dt),
    )
    y_prompt, st_p = trunk(x_prompt, c_prompt, zero_states, p)
    sample_states = (state_hgrn, state_rwkv, state_rwkv_shift, state_conv, state_lru_h, state_lru_conv)
    y_sample, st_s = trunk(x_sample, c_sample, sample_states, p)
    hgrn_p, rwkv_p, shift_p, conv_p, lru_h_p, lru_conv_p = st_p
    hgrn_s, rwkv_s, shift_s, conv_s, lru_h_s, lru_conv_s = st_s
    return (y_prompt, y_sample, hgrn_p, rwkv_p, shift_p, conv_p, lru_h_p, lru_conv_p,
            hgrn_s, rwkv_s, shift_s, conv_s, lru_h_s, lru_conv_s)
```

```cpp
#include <hip/hip_runtime.h>
#include <hip/hip_cooperative_groups.h>
#include <cstdio>
#include <cstdint>
namespace cg = cooperative_groups;
namespace pg8 {
#define PG8_LAS __attribute__((address_space(3)))
typedef unsigned short bf16_t;
typedef short bf16x8 __attribute__((ext_vector_type(8)));
typedef float f32x4 __attribute__((ext_vector_type(4)));
typedef unsigned u32x4 __attribute__((ext_vector_type(4)));
constexpr int BM = 256, BK = 64, HALF = 128, HTB = HALF * BK * 2  , STAGE_BYTES = 8 * HTB, NXCD = 8, WGM = 8;

__host__ __device__ __forceinline__ int lds_byte(int r, int c) { const int st = (r >> 4) * 2 + (c >> 5), rr = r & 15, cc = c & 31, ob = rr * 64 + cc * 2; return st * 1024 + (ob ^ (((ob >> 9) & 1) << 5)); }
__host__ __device__ __forceinline__ void stage_rc(int b, int& R, int& C) { const int st = b / 1024, sb = b % 1024, swz = sb ^ (((sb >> 9) & 1) << 5); R = (st >> 1) * 16 + swz / 64; C = (st & 1) * 32 + (swz % 64) / 2; }
__host__ __device__ __forceinline__ int perm32(int rho) { const int n = rho >> 4, i = rho & 15; return 8 * (i >> 2) + 4 * n + (i & 3); }

struct Unit { int pm, pn; };
struct Gemm { const bf16_t* A; const bf16_t* Bt; int M, N, K; };

struct StaticOrder {
    int nM, nN, nwg, G, c;
    __host__ __device__ void init(int M, int N, int G_, int c_) { nM = M / BM; nN = N / BM; nwg = nM * nN; G = G_; c = c_; }
    __host__ __device__ bool next(int i, Unit& u) const {
        const long L = (long)i * G + c; if (L >= nwg) return false;
        int wgid = (int)L; { const int q = nwg / NXCD, r = nwg % NXCD, xcd = wgid % NXCD, off = wgid / NXCD; wgid = (xcd < r ? xcd * (q + 1) : r * (q + 1) + (xcd - r) * q) + off; }
        const int nig = WGM * nN, gid = wgid / nig, fm = gid * WGM, gsz = (nM - fm) < WGM ? (nM - fm) : WGM;
        u.pm = fm + ((wgid % nig) % gsz); u.pn = (wgid % nig) / gsz; return true;
    }
    __device__ __forceinline__ void a_ready(const Unit&) const {}
    __device__ __forceinline__ void done(const Unit&) const {}
};

__device__ __forceinline__ unsigned cvt_pk_bf16(float lo, float hi) { unsigned r; asm volatile("v_cvt_pk_bf16_f32 %0, %1, %2" : "=v"(r) : "v"(lo), "v"(hi)); return r; }
__device__ __forceinline__ float sigm(float x) { return __builtin_amdgcn_rcpf(1.f + __expf(-x)); }
__device__ __forceinline__ float silu_(float x) { return x * sigm(x); }
__device__ __forceinline__ float tanh_(float u) { return 1.f - 2.f * __builtin_amdgcn_rcpf(__expf(2.f * u) + 1.f); }
__device__ __forceinline__ float gelu_tanh(float x) { const float u = 0.7978845608f * (x + 0.044715f * x * x * x); return 0.5f * x * (1.f + tanh_(u)); }
__device__ __forceinline__ int cond_of_row(int row) { return row < 16384 ? (row >> 11) : 8 + ((row - 16384) >> 3); }
__device__ __forceinline__ void unpack8(const u32x4 w, float (&f)[8]) {
    f[0] = __uint_as_float(w.x << 16); f[1] = __uint_as_float(w.x & 0xffff0000u); f[2] = __uint_as_float(w.y << 16); f[3] = __uint_as_float(w.y & 0xffff0000u);
    f[4] = __uint_as_float(w.z << 16); f[5] = __uint_as_float(w.z & 0xffff0000u); f[6] = __uint_as_float(w.w << 16); f[7] = __uint_as_float(w.w & 0xffff0000u);
}
__device__ __forceinline__ u32x4 pack8(const float (&f)[8]) { u32x4 w; w.x = cvt_pk_bf16(f[0], f[1]); w.y = cvt_pk_bf16(f[2], f[3]); w.z = cvt_pk_bf16(f[4], f[5]); w.w = cvt_pk_bf16(f[6], f[7]); return w; }

#define EPI_LOOP_BEGIN \
    _Pragma("unroll") for (int ai = 0; ai < 2; ++ai) _Pragma("unroll") for (int m = 0; m < 4; ++m) { const int row = u.pm * BM + ai * HALF + wr * 64 + m * 16 + fr; \
    _Pragma("unroll") for (int bj = 0; bj < 2; ++bj) { const int colb = u.pn * BM + bj * HALF; const int col = colb + wc * 32 + 8 * fq; \
        float v[8]; v[0] = acc[ai][bj][m][0][0]; v[1] = acc[ai][bj][m][0][1]; v[2] = acc[ai][bj][m][0][2]; v[3] = acc[ai][bj][m][0][3]; \
        v[4] = acc[ai][bj][m][1][0]; v[5] = acc[ai][bj][m][1][1]; v[6] = acc[ai][bj][m][1][2]; v[7] = acc[ai][bj][m][1][3];
#define EPI_LOOP_END } }

struct EpiProj {
    static constexpr bool PERM = true, AFTER_DRAIN = false, HOOK = false;
    bf16_t* O; const float* hgl; int layer;
    __device__ __forceinline__ void operator()(const f32x4 (&acc)[2][2][4][2], const Unit& u, int wr, int wc, int fr, int fq) const {
        EPI_LOOP_BEGIN
            const int sec = colb >> 7;
            if (sec < 4 || (sec >= 12 && sec < 16)) {
#pragma unroll
                for (int j = 0; j < 8; ++j) v[j] = silu_(v[j]);
            } else if (sec < 8) {
#pragma unroll
                for (int j = 0; j < 8; ++j) { const int c = col - 512 + j; const float lb = layer == 0 ? 0.f : __builtin_amdgcn_rcpf(1.f + __expf(hgl[c] - hgl[512 + c])); v[j] = (1.f - lb) * sigm(-v[j]); }
            } else if (sec >= 34 && sec < 38) {
#pragma unroll
                for (int j = 0; j < 8; ++j) v[j] = sigm(v[j]);
            } else if (sec >= 42) {
#pragma unroll
                for (int j = 0; j < 8; ++j) v[j] = gelu_tanh(v[j]);
            }
            *(u32x4*)(O + (size_t)row * 5888 + col) = pack8(v);
        EPI_LOOP_END
    }
};
struct EpiGate {
    static constexpr bool PERM = true, AFTER_DRAIN = false, HOOK = false;
    bf16_t* O; const float* bias;
    __device__ __forceinline__ void operator()(const f32x4 (&acc)[2][2][4][2], const Unit& u, int wr, int wc, int fr, int fq) const {
        EPI_LOOP_BEGIN
            const f32x4 b0 = *(const f32x4*)(bias + col), b1 = *(const f32x4*)(bias + col + 4);
            v[0] = sigm(v[0] + b0[0]); v[1] = sigm(v[1] + b0[1]); v[2] = sigm(v[2] + b0[2]); v[3] = sigm(v[3] + b0[3]);
            v[4] = sigm(v[4] + b1[0]); v[5] = sigm(v[5] + b1[1]); v[6] = sigm(v[6] + b1[2]); v[7] = sigm(v[7] + b1[3]);
            *(u32x4*)(O + (size_t)row * 4096 + col) = pack8(v);
        EPI_LOOP_END
    }
};
struct EpiMod {
    static constexpr bool PERM = true, AFTER_DRAIN = false, HOOK = false;
    float* O; const float* bias;
    __device__ __forceinline__ void operator()(const f32x4 (&acc)[2][2][4][2], const Unit& u, int wr, int wc, int fr, int fq) const {
        EPI_LOOP_BEGIN
            const f32x4 b0 = *(const f32x4*)(bias + col), b1 = *(const f32x4*)(bias + col + 4);
            *(f32x4*)(O + (size_t)row * 12288 + col) = (f32x4){v[0] + b0[0], v[1] + b0[1], v[2] + b0[2], v[3] + b0[3]};
            *(f32x4*)(O + (size_t)row * 12288 + col + 4) = (f32x4){v[4] + b1[0], v[5] + b1[1], v[6] + b1[2], v[7] + b1[3]};
        EPI_LOOP_END
    }
};
struct EpiBranch {
    static constexpr bool PERM = true, AFTER_DRAIN = false, HOOK = true;
    bf16_t* O; const bf16_t* G; const bf16_t* G2;
    __device__ __forceinline__ void hook(f32x4 (&acc)[2][2][4][2], const Unit& u, int kb, int wr, int wc, int fr, int fq) const {
        __builtin_amdgcn_sched_barrier(0);
#pragma unroll
        for (int ai = 0; ai < 2; ++ai)
#pragma unroll
            for (int m = 0; m < 4; ++m) { const int row = u.pm * BM + ai * HALF + wr * 64 + m * 16 + fr;
#pragma unroll
                for (int bj = 0; bj < 2; ++bj) { const int col = u.pn * BM + bj * HALF + wc * 32 + 8 * fq;
                    const bf16_t* gp = (row < 16384 ? G : G2) + (size_t)row * 4096 + kb * 1024 + col;
                    float g0[8], g1[8]; unpack8(*(const u32x4*)gp, g0); unpack8(*(const u32x4*)(gp + 1024), g1);
#pragma unroll
                    for (int j = 0; j < 4; ++j) { acc[ai][bj][m][0][j] *= g0[j] * __builtin_amdgcn_rcpf(g1[j]); acc[ai][bj][m][1][j] *= g0[4 + j] * __builtin_amdgcn_rcpf(g1[4 + j]); }
                }
                __builtin_amdgcn_sched_barrier(0); }
    }
    __device__ __forceinline__ void operator()(const f32x4 (&acc)[2][2][4][2], const Unit& u, int wr, int wc, int fr, int fq) const {
        EPI_LOOP_BEGIN
            float g[8]; unpack8(*(const u32x4*)((row < 16384 ? G : G2) + (size_t)row * 4096 + 3072 + col), g);
#pragma unroll
            for (int j = 0; j < 8; ++j) v[j] *= g[j];
            *(u32x4*)(O + (size_t)row * 1024 + col) = pack8(v);
        EPI_LOOP_END
    }
};
struct EpiRes {
    static constexpr bool PERM = true, AFTER_DRAIN = false, HOOK = false;
    float* X; const float* res0; const float* res1; const float* gmod; int row0;
    __device__ __forceinline__ void operator()(const f32x4 (&acc)[2][2][4][2], const Unit& u, int wr, int wc, int fr, int fq) const {
        EPI_LOOP_BEGIN
            const int grow = row + row0;
            const float* rp = (grow < 16384 ? res0 + (size_t)grow * 1024 : res1 + (size_t)(grow - 16384) * 1024) + col;
            const float* gp = gmod + (size_t)cond_of_row(grow) * 12288 + col;
            const f32x4 r0 = *(const f32x4*)rp, r1 = *(const f32x4*)(rp + 4), g0 = *(const f32x4*)gp, g1 = *(const f32x4*)(gp + 4);
            *(f32x4*)(X + (size_t)grow * 1024 + col) = (f32x4){r0[0] + g0[0] * v[0], r0[1] + g0[1] * v[1], r0[2] + g0[2] * v[2], r0[3] + g0[3] * v[3]};
            *(f32x4*)(X + (size_t)grow * 1024 + col + 4) = (f32x4){r1[0] + g1[0] * v[4], r1[1] + g1[1] * v[5], r1[2] + g1[2] * v[6], r1[3] + g1[3] * v[7]};
        EPI_LOOP_END
    }
};
struct EpiRelu2 {
    static constexpr bool PERM = true, AFTER_DRAIN = false, HOOK = false;
    bf16_t* O;
    __device__ __forceinline__ void operator()(const f32x4 (&acc)[2][2][4][2], const Unit& u, int wr, int wc, int fr, int fq) const {
        EPI_LOOP_BEGIN
#pragma unroll
            for (int j = 0; j < 8; ++j) { const float r = fmaxf(v[j], 0.f); v[j] = r * r; }
            *(u32x4*)(O + (size_t)row * 4096 + col) = pack8(v);
        EPI_LOOP_END
    }
};
template <class Epi, class Sched, bool ALIGN_EPI = false, bool SP2 = false>
__device__ __forceinline__ void gemm_phase(PG8_LAS unsigned char* lds, const Gemm g, const Sched& S, const Epi& E) {
    const int tid = threadIdx.x, wid = __builtin_amdgcn_readfirstlane(tid >> 6), lane = tid & 63, wr = wid >> 2, wc = wid & 3, fr = lane & 15, fq = lane >> 4;
    const int K = g.K, nt = K / BK;
    unsigned voffA[2], voffB[2];
#pragma unroll
    for (int i = 0; i < 2; ++i) { int R, C; stage_rc(tid * 16 + i * 8192, R, C); const int Rb = Epi::PERM ? ((R & ~31) + perm32(R & 31)) : R;
        voffA[i] = (unsigned)(R * K + C) * 2u; voffB[i] = (unsigned)(Rb * K + C) * 2u; }
    const size_t kstep = (size_t)(BK * 2);
    const size_t hstep = (size_t)HALF * K * 2;
    const size_t tstep = 2 * hstep;
    const unsigned ldsw = (unsigned)wid * 1024u;
    const int aoff = lds_byte(wr * 64 + fr, fq * 8), boff = lds_byte(wc * 32 + fr, fq * 8);
#define PG8_SA(b, h) (((b) * 2 + (h)) * HTB)
#define PG8_SB(b, h) ((4 + (b) * 2 + (h)) * HTB)
#define PG8_STAGE(bufoff, gbase, voff) do { _Pragma("unroll") for (int _i = 0; _i < 2; ++_i) \
        __builtin_amdgcn_global_load_lds((const unsigned*)((const char*)(gbase) + (voff)[_i]), (PG8_LAS unsigned*)(lds + (bufoff) + ldsw + _i * 8192), 16, 0, 0); } while (0)
#define PG8_LDA(dst, b, h) do { _Pragma("unroll") for (int m = 0; m < 4; ++m) _Pragma("unroll") for (int k = 0; k < 2; ++k) dst[m][k] = *(const PG8_LAS bf16x8*)(lds + PG8_SA(b, h) + aoff + m * 2048 + k * 1024); } while (0)
#define PG8_LDB(dst, b, h) do { _Pragma("unroll") for (int n = 0; n < 2; ++n) _Pragma("unroll") for (int k = 0; k < 2; ++k) dst[n][k] = *(const PG8_LAS bf16x8*)(lds + PG8_SB(b, h) + boff + n * 2048 + k * 1024); } while (0)
#define PG8_MMA(ai, bj, At, Bt) do { __builtin_amdgcn_s_setprio(1); _Pragma("unroll") for (int m = 0; m < 4; ++m) _Pragma("unroll") for (int n = 0; n < 2; ++n) _Pragma("unroll") for (int k = 0; k < 2; ++k) \
        acc[ai][bj][m][n] = __builtin_amdgcn_mfma_f32_16x16x32_bf16(Bt[n][k], At[m][k], acc[ai][bj][m][n], 0, 0, 0); __builtin_amdgcn_s_setprio(0); } while (0)
#define PG8_WAIT_V(n) asm volatile("s_waitcnt vmcnt(" #n ")" ::: "memory")
#define PG8_WAIT_L(n) asm volatile("s_waitcnt lgkmcnt(" #n ")" ::: "memory")
#define PG8_BAR __builtin_amdgcn_s_barrier()
#define PG8_SCHED __builtin_amdgcn_sched_barrier(0)
    Unit cur, nxt; int ui = 0;
    if (!S.next(0, cur)) return;
    f32x4 acc[2][2][4][2];
#pragma unroll
    for (int a = 0; a < 2; ++a)
#pragma unroll
        for (int b = 0; b < 2; ++b)
#pragma unroll
            for (int m = 0; m < 4; ++m)
#pragma unroll
                for (int n = 0; n < 2; ++n) acc[a][b][m][n] = (f32x4){0.f, 0.f, 0.f, 0.f};
    bf16x8 At[4][2], B0[2][2], B1[2][2];
    const char* cA = (const char*)g.A + (size_t)cur.pm * tstep; const char* cB = (const char*)g.Bt + (size_t)cur.pn * tstep;
    S.a_ready(cur);
    if constexpr (SP2) {
        PG8_STAGE(PG8_SB(0, 0), cB, voffB); PG8_STAGE(PG8_SB(0, 1), cB + hstep, voffB); PG8_STAGE(PG8_SA(0, 0), cA, voffA); PG8_STAGE(PG8_SA(0, 1), cA + hstep, voffA);
        if (wr == 1) PG8_BAR;
        PG8_WAIT_V(2); PG8_BAR;
        PG8_STAGE(PG8_SB(1, 0), cB + kstep, voffB); PG8_STAGE(PG8_SA(1, 0), cA + kstep, voffA); PG8_STAGE(PG8_SB(1, 1), cB + hstep + kstep, voffB);
        PG8_WAIT_V(6); PG8_BAR;
    } else {
        PG8_STAGE(PG8_SB(0, 0), cB, voffB); PG8_STAGE(PG8_SA(0, 0), cA, voffA); PG8_STAGE(PG8_SB(0, 1), cB + hstep, voffB); PG8_STAGE(PG8_SA(0, 1), cA + hstep, voffA);
        if (wr == 1) PG8_BAR;
        PG8_WAIT_V(4); PG8_BAR;
        PG8_STAGE(PG8_SB(1, 0), cB + kstep, voffB); PG8_STAGE(PG8_SA(1, 0), cA + kstep, voffA); PG8_STAGE(PG8_SB(1, 1), cB + hstep + kstep, voffB);
        PG8_WAIT_V(6); PG8_BAR;
    }
    for (;;) {
        const bool has_next = S.next(ui + 1, nxt);
        const char* nA = has_next ? (const char*)g.A + (size_t)nxt.pm * tstep : cA; const char* nB = has_next ? (const char*)g.Bt + (size_t)nxt.pn * tstep : cB;
        for (int t = 0; t < nt; t += 2) {
            const bool last = (t == nt - 2);
            const char* a1 = cA + (size_t)(t + 1) * kstep;
            const char* a2 = last ? nA : cA + (size_t)(t + 2) * kstep; const char* b2 = last ? nB : cB + (size_t)(t + 2) * kstep;
            const char* a3 = a2 + kstep; const char* b3 = b2 + kstep;
            if (last && has_next) S.a_ready(nxt);
            if constexpr (SP2) {
            PG8_LDB(B0, 0, 0); PG8_LDB(B1, 0, 1); PG8_SCHED; PG8_LDA(At, 0, 0); PG8_STAGE(PG8_SA(1, 1), a1 + hstep, voffA);
            PG8_WAIT_V(8); PG8_WAIT_L(0); PG8_BAR; PG8_MMA(0, 0, At, B0); PG8_MMA(0, 1, At, B1); PG8_BAR; PG8_SCHED;
            PG8_LDA(At, 0, 1); PG8_STAGE(PG8_SB(0, 0), b2, voffB); PG8_STAGE(PG8_SB(0, 1), b2 + hstep, voffB); PG8_STAGE(PG8_SA(0, 0), a2, voffA);
            PG8_WAIT_V(8); PG8_WAIT_L(0); PG8_BAR; PG8_MMA(1, 0, At, B0); PG8_MMA(1, 1, At, B1); PG8_BAR; PG8_SCHED;
            PG8_LDB(B0, 1, 0); PG8_LDB(B1, 1, 1); PG8_SCHED; PG8_LDA(At, 1, 0); PG8_STAGE(PG8_SA(0, 1), a2 + hstep, voffA);
            PG8_WAIT_V(8); PG8_WAIT_L(0); PG8_BAR; PG8_MMA(0, 0, At, B0); PG8_MMA(0, 1, At, B1); PG8_BAR; PG8_SCHED;
            PG8_LDA(At, 1, 1); PG8_STAGE(PG8_SB(1, 0), b3, voffB); PG8_STAGE(PG8_SB(1, 1), b3 + hstep, voffB); PG8_STAGE(PG8_SA(1, 0), a3, voffA);
            PG8_WAIT_V(8); PG8_WAIT_L(0); PG8_BAR; PG8_MMA(1, 0, At, B0); PG8_MMA(1, 1, At, B1); PG8_BAR; PG8_SCHED;
            } else {
            PG8_LDB(B0, 0, 0); PG8_SCHED; PG8_LDA(At, 0, 0); PG8_STAGE(PG8_SA(1, 1), a1 + hstep, voffA);
            PG8_WAIT_L(8); PG8_BAR; PG8_WAIT_L(0); PG8_MMA(0, 0, At, B0); PG8_BAR; PG8_SCHED;
            PG8_LDB(B1, 0, 1); PG8_STAGE(PG8_SB(0, 0), b2, voffB);
            PG8_BAR; PG8_WAIT_L(0); PG8_MMA(0, 1, At, B1); PG8_BAR;
            PG8_LDA(At, 0, 1); PG8_STAGE(PG8_SA(0, 0), a2, voffA);
            PG8_BAR; PG8_WAIT_L(0); PG8_MMA(1, 0, At, B0); PG8_BAR; PG8_SCHED;
            PG8_STAGE(PG8_SB(0, 1), b2 + hstep, voffB);
            PG8_WAIT_V(6); PG8_BAR; PG8_MMA(1, 1, At, B1); PG8_BAR;
            PG8_LDB(B0, 1, 0); PG8_SCHED; PG8_LDA(At, 1, 0); PG8_STAGE(PG8_SA(0, 1), a2 + hstep, voffA);
            PG8_WAIT_L(8); PG8_BAR; PG8_WAIT_L(0); PG8_MMA(0, 0, At, B0); PG8_BAR; PG8_SCHED;
            PG8_LDB(B1, 1, 1); PG8_STAGE(PG8_SB(1, 0), b3, voffB);
            PG8_BAR; PG8_WAIT_L(0); PG8_MMA(0, 1, At, B1); PG8_BAR;
            PG8_LDA(At, 1, 1); PG8_STAGE(PG8_SA(1, 0), a3, voffA);
            PG8_BAR; PG8_WAIT_L(0); PG8_MMA(1, 0, At, B0); PG8_BAR; PG8_SCHED;
            PG8_STAGE(PG8_SB(1, 1), b3 + hstep, voffB);
            PG8_WAIT_V(6); PG8_BAR; PG8_MMA(1, 1, At, B1); PG8_BAR;
            }
            if constexpr (Epi::HOOK) { if ((((t + 2) & 7) == 0) && !last) E.hook(acc, cur, ((t + 2) >> 3) - 1, wr, wc, fr, fq); }
        }
        if constexpr (ALIGN_EPI) { if (wr == 0) PG8_BAR; }
        if constexpr (!Epi::AFTER_DRAIN) { E(acc, cur, wr, wc, fr, fq); S.done(cur); }
        if (!has_next) break;
#pragma unroll
        for (int a = 0; a < 2; ++a)
#pragma unroll
            for (int b = 0; b < 2; ++b)
#pragma unroll
                for (int m = 0; m < 4; ++m)
#pragma unroll
                    for (int n = 0; n < 2; ++n) acc[a][b][m][n] = (f32x4){0.f, 0.f, 0.f, 0.f};
        cur = nxt; cA = nA; cB = nB; ++ui;
        if constexpr (ALIGN_EPI) { if (wr == 1) PG8_BAR; }
    }
    PG8_WAIT_V(0);
    if constexpr (!ALIGN_EPI) { if (wr == 0) PG8_BAR; }
    PG8_BAR;
    if constexpr (Epi::AFTER_DRAIN) { E.fused(acc, cur, wr, wc, fr, fq, lds, wid, lane); S.done(cur); }
#undef PG8_SA
#undef PG8_SB
#undef PG8_STAGE
#undef PG8_LDA
#undef PG8_LDB
#undef PG8_MMA
#undef PG8_WAIT_V
#undef PG8_WAIT_L
#undef PG8_BAR
#undef PG8_SCHED
}
}
#ifndef MK_SINGLE
#define MK_SINGLE 1
#endif
#define LAS __attribute__((address_space(3)))
typedef unsigned short bf16;
typedef unsigned v4u __attribute__((ext_vector_type(4)));
typedef unsigned v2u __attribute__((ext_vector_type(2)));
typedef float f32x4 __attribute__((ext_vector_type(4)));
using pg8::sigm; using pg8::silu_; using pg8::tanh_; using pg8::cvt_pk_bf16; using pg8::unpack8; using pg8::pack8; using pg8::cond_of_row;

constexpr int NTOK = 17408, NPR = 16384, DM = 1024, BW = 512, INC = 5888;
constexpr int LDS_BYTES = 147456, MISC_OFF = 144 * 1024 - 1024, TAB_OFF = MISC_OFF + 64;
constexpr size_t MiB = 1u << 20;
constexpr size_t WS_CTL = 0, CTL_BYTES = 65536;
constexpr size_t WS_MOD = 1 * MiB;
constexpr size_t WS_CA = 13 * MiB;
constexpr size_t WS_WIN = 14 * MiB;
constexpr size_t WS_WG = WS_WIN + 5888u * 1024 * 2;
constexpr size_t WS_WB = WS_WG + 8 * MiB;
constexpr size_t WS_WO = WS_WB + 4 * MiB;
constexpr size_t WS_W1 = WS_WO + 2 * MiB;
constexpr size_t WS_W2 = WS_W1 + 8 * MiB;
constexpr size_t WS_H = 56 * MiB;
constexpr size_t WS_BR = 90 * MiB;
constexpr size_t WS_G = 158 * MiB;
constexpr size_t WS_BIG = 192 * MiB;
constexpr size_t WS_SSP = WS_BIG + (size_t)NTOK * INC * 2;
constexpr size_t WS_RST = WS_SSP + (size_t)NTOK * 16 * 4;
constexpr size_t WS_GS = WS_RST + (size_t)NTOK * 32 * 4;
constexpr size_t WS_END = WS_GS + (size_t)(NTOK - NPR) * 4096 * 2;
static_assert(WS_W2 + 8 * MiB <= WS_H, "ws map");
constexpr size_t O_HG_P = 17825792, O_RW_P = 18874368, O_SH_P = 19398656, O_CV_P = 19427328, O_LH_P = 19673088, O_LC_P = 19681280;
constexpr size_t O_HG_S = 19705856, O_RW_S = 36483072, O_SH_S = 44871680, O_CV_S = 45330432, O_LH_S = 49262592, O_LC_S = 49393664;
enum { I_XP = 0, I_XS, I_SHG, I_SRW, I_SSH, I_SCV, I_SLH, I_SLC, I_CP, I_CS, I_ADAW, I_ADAB, I_NMIX, I_NMLP, I_NFIN, I_WIN, I_HGL, I_HGN, I_MU, I_W0, I_WUP, I_A0, I_AUP, I_GUP,
       I_KK, I_KA, I_RK, I_LNG, I_LNB, I_CFDW, I_CFDWB, I_CFLG, I_CFLB, I_LCW, I_LCB, I_LWA, I_LBA, I_LWX, I_LBX, I_LAM, I_WBR, I_WGATE, I_BGATE, I_WOUT, I_WM1, I_WM2 };

struct Args { const float* in[46]; float* out; unsigned char* ws; int ph_lo, ph_hi; };
struct MArgs { float* out; unsigned char* ws; };
extern __shared__ __attribute__((aligned(16))) unsigned char lds_raw[];
__device__ __forceinline__ const float* inp_(int i) {
    const LAS unsigned* t = (const LAS unsigned*)((LAS unsigned char*)lds_raw + TAB_OFF) + 2 * i;
    const unsigned lo = __builtin_amdgcn_readfirstlane(t[0]), hi = __builtin_amdgcn_readfirstlane(t[1]);
    return (const float*)(((unsigned long long)hi << 32) | lo);
}
#define INP(i) inp_(i)

template <int CTRL> __device__ __forceinline__ float dppf(float v) { return __builtin_bit_cast(float, __builtin_amdgcn_update_dpp(0, __builtin_bit_cast(int, v), CTRL, 0xF, 0xF, true)); }
__device__ __forceinline__ float red4(float v) { v += dppf<0xB1>(v); v += dppf<0x4E>(v); return v; }
__device__ __forceinline__ float red8(float v) { v = red4(v); v += dppf<0x141>(v); return v; }
__device__ __forceinline__ float red16(float v) { v = red8(v); v += dppf<0x140>(v); return v; }
__device__ __forceinline__ float wave_sum(float v) {
#pragma unroll
    for (int o = 1; o < 64; o <<= 1) v += __shfl_xor(v, o);
    return v;
}
__device__ __forceinline__ float bf2f(bf16 b) { return __uint_as_float((unsigned)b << 16); }
__device__ __forceinline__ void unpack4(const v2u w, float (&f)[4]) { f[0] = __uint_as_float(w.x << 16); f[1] = __uint_as_float(w.x & 0xffff0000u); f[2] = __uint_as_float(w.y << 16); f[3] = __uint_as_float(w.y & 0xffff0000u); }
__device__ __forceinline__ v2u pack4(float a, float b, float c, float d) { v2u w; w.x = cvt_pk_bf16(a, b); w.y = cvt_pk_bf16(c, d); return w; }
#define LDS_WAIT() asm volatile("s_waitcnt lgkmcnt(0)" ::: "memory")

__device__ __forceinline__ v4u gload16(const void* p) { v4u r; asm volatile("global_load_dwordx4 %0, %1, off" : "=v"(r) : "v"(p) : "memory"); return r; }
__device__ __forceinline__ v2u gload8(const void* p) { v2u r; asm volatile("global_load_dwordx2 %0, %1, off" : "=v"(r) : "v"(p) : "memory"); return r; }
__device__ __forceinline__ unsigned gload4(const void* p) { unsigned r; asm volatile("global_load_dword %0, %1, off" : "=v"(r) : "v"(p) : "memory"); return r; }
#define LDS_BARRIER() asm volatile("s_waitcnt lgkmcnt(0)\n\ts_barrier" ::: "memory")
#define VM_DRAIN_KNOWN() __builtin_amdgcn_s_waitcnt(0x0F70)
__device__ __forceinline__ void tr_item(const float* W, int K, int N, bf16* WT, int ldt, int row_off, int col_off, LAS float* scr, int item, int lane) {
    const int nblk = N / 32, kb = item / nblk, nb = item % nblk, k0 = 64 * kb, n0 = 32 * nb;
#pragma unroll 8
    for (int i = 0; i < 32; ++i) { const int kk = 2 * i + (lane >> 5); scr[kk * 33 + (lane & 31)] = W[(size_t)(k0 + kk) * N + n0 + (lane & 31)]; }
    LDS_WAIT(); asm volatile("" ::: "memory");
    const int c = lane & 7;
#pragma unroll
    for (int j = 0; j < 4; ++j) { const int n = (lane >> 3) + 8 * j; const LAS float* s = scr + (8 * c) * 33 + n;
        v4u o; o.x = cvt_pk_bf16(s[0 * 33], s[1 * 33]); o.y = cvt_pk_bf16(s[2 * 33], s[3 * 33]); o.z = cvt_pk_bf16(s[4 * 33], s[5 * 33]); o.w = cvt_pk_bf16(s[6 * 33], s[7 * 33]);
        *(v4u*)(WT + (size_t)(row_off + n0 + n) * ldt + col_off + k0 + 8 * c) = o; }
    LDS_WAIT(); asm volatile("" ::: "memory");
}

__device__ __forceinline__ void phase_conv_ada(const Args& a, LAS unsigned char* lds, int gw, int NGW, int wave, int lane) {
    LAS float* scr = (LAS float*)(lds + wave * 16384);
    bf16* ADAT = (bf16*)(a.ws + WS_BIG);
    constexpr int IPL = 16 * 192;
    for (int it = gw; it < 2 * IPL; it += NGW) { const int l = it / IPL; tr_item(INP(I_ADAW) + (size_t)l * 1024 * 6144, 1024, 6144, ADAT, 1024, l * 6144, 0, scr, it % IPL, lane); }
    bf16* CA = (bf16*)(a.ws + WS_CA);
    for (int r = gw; r < 256; r += NGW) {
        const float* cp = r < 8 ? INP(I_CP) + r * 1024 : INP(I_CS) + (r - 8) * 1024;
#pragma unroll
        for (int j = 0; j < 4; ++j) { const int c = (lane + 64 * j) * 4; f32x4 v = (f32x4){0.f, 0.f, 0.f, 0.f}; if (r < 136) { v = *(const f32x4*)(cp + c); v[0] = silu_(v[0]); v[1] = silu_(v[1]); v[2] = silu_(v[2]); v[3] = silu_(v[3]); }
            *(v2u*)(CA + r * 1024 + c) = pack4(v[0], v[1], v[2], v[3]); }
    }
}
__device__ __forceinline__ void phase_conv_layer(const Args& a, int l, LAS unsigned char* lds, int gw, int NGW, int wave, int lane, int it_lo, int it_hi) {
    LAS float* scr = (LAS float*)(lds + wave * 16384);
    constexpr int I_IN = 16 * 184, I_G = 16 * 128, I_B = 4 * 256, I_O = 16 * 32, I_1 = 16 * 128, I_2 = 64 * 32, NIT = I_IN + I_G + I_B + I_O + I_1 + I_2;
    static_assert(NIT == 10624 && NIT - I_2 == 8576, "item map");
    for (int it = it_lo + gw; it < it_hi; it += NGW) {
        int r = it;
        if (r < I_IN) { tr_item(INP(I_WIN) + (size_t)l * 1024 * 5888, 1024, 5888, (bf16*)(a.ws + WS_WIN), 1024, 0, 0, scr, r, lane); continue; } r -= I_IN;
        if (r < I_G) { tr_item(INP(I_WGATE) + (size_t)l * 1024 * 4096, 1024, 4096, (bf16*)(a.ws + WS_WG), 1024, 0, 0, scr, r, lane); continue; } r -= I_G;
        if (r < I_B) { const int k = r >> 8; tr_item(INP(I_WBR) + (size_t)(l * 4 + k) * 512 * 1024, 512, 1024, (bf16*)(a.ws + WS_WB), 2048, 0, k * 512, scr, r & 255, lane); continue; } r -= I_B;
        if (r < I_O) { tr_item(INP(I_WOUT) + (size_t)l * 1024 * 1024, 1024, 1024, (bf16*)(a.ws + WS_WO), 1024, 0, 0, scr, r, lane); continue; } r -= I_O;
        if (r < I_1) { tr_item(INP(I_WM1) + (size_t)l * 1024 * 4096, 1024, 4096, (bf16*)(a.ws + WS_W1), 1024, 0, 0, scr, r, lane); continue; } r -= I_1;
        tr_item(INP(I_WM2) + (size_t)l * 4096 * 1024, 4096, 1024, (bf16*)(a.ws + WS_W2), 4096, 0, 0, scr, r, lane);
    }
}
__device__ __forceinline__ void phase_norm(const Args& a, int l, int sel, int gw, int NGW, int lane, int row_lo = 0, int row_hi = NTOK) {
    const float* MOD = (const float*)(a.ws + WS_MOD); bf16* H = (bf16*)(a.ws + WS_H);
    const float* gn = (sel == 0 ? INP(I_NMIX) : INP(I_NMLP)) + l * 1024;
    for (int row = row_lo + gw; row < row_hi; row += NGW) {
        const float* xr = (l == 0 && sel == 0) ? (row < NPR ? INP(I_XP) + (size_t)row * 1024 : INP(I_XS) + (size_t)(row - NPR) * 1024) : a.out + (size_t)row * 1024;
        f32x4 v[4]; float ss = 0.f;
#pragma unroll
        for (int j = 0; j < 4; ++j) { v[j] = *(const f32x4*)(xr + (lane + 64 * j) * 4); ss += (v[j][0] * v[j][0] + v[j][1] * v[j][1]) + (v[j][2] * v[j][2] + v[j][3] * v[j][3]); }
        const float rstd = rsqrtf(wave_sum(ss) * (1.f / 1024.f) + 1e-6f);
        const float* mp = MOD + (size_t)cond_of_row(row) * 12288 + l * 6144 + sel * 3072;
#pragma unroll
        for (int j = 0; j < 4; ++j) { const int c = (lane + 64 * j) * 4; const f32x4 g = *(const f32x4*)(gn + c), sh = *(const f32x4*)(mp + c), sc = *(const f32x4*)(mp + 1024 + c);
            float o[4];
#pragma unroll
            for (int i = 0; i < 4; ++i) o[i] = v[j][i] * rstd * g[i] * (1.f + sc[i]) + sh[i];
            *(v2u*)(H + (size_t)row * 1024 + c) = pack4(o[0], o[1], o[2], o[3]); }
    }
}
__device__ __forceinline__ void phase_final(const Args& a, int gw, int NGW, int lane) {
    const float* gn = INP(I_NFIN);
    for (int row = gw; row < NTOK; row += NGW) {
        float* xr = a.out + (size_t)row * 1024;
        f32x4 v[4]; float ss = 0.f;
#pragma unroll
        for (int j = 0; j < 4; ++j) { v[j] = *(const f32x4*)(xr + (lane + 64 * j) * 4); ss += (v[j][0] * v[j][0] + v[j][1] * v[j][1]) + (v[j][2] * v[j][2] + v[j][3] * v[j][3]); }
        const float rstd = rsqrtf(wave_sum(ss) * (1.f / 1024.f) + 1e-6f);
#pragma unroll
        for (int j = 0; j < 4; ++j) { const int c = (lane + 64 * j) * 4; const f32x4 g = *(const f32x4*)(gn + c);
            *(f32x4*)(xr + c) = (f32x4){v[j][0] * rstd * g[0], v[j][1] * rstd * g[1], v[j][2] * rstd * g[2], v[j][3] * rstd * g[3]}; }
    }
}
__device__ __forceinline__ void phase_hg_post(const Args& a, int gw, int NGW, int lane) {
    bf16* BR = (bf16*)(a.ws + WS_BR); const float* SSP = (const float*)(a.ws + WS_SSP); const float* RST = (const float*)(a.ws + WS_RST); const bf16* GC = (const bf16*)(a.ws + WS_G);
    for (int row = gw; row < NTOK; row += NGW) {
        { const int h = lane >> 4; const f32x4 s4 = *(const f32x4*)(SSP + (size_t)row * 16 + h * 4);
          const float rstd = rsqrtf(((s4[0] + s4[1]) + (s4[2] + s4[3])) * (1.f / 128.f) + 1e-6f);
          bf16* p = BR + (size_t)row * 2048 + lane * 8; float v[8]; unpack8(*(const v4u*)p, v);
#pragma unroll
          for (int j = 0; j < 8; ++j) v[j] *= rstd;
          *(v4u*)p = pack8(v); }
        { const int h = lane >> 3; const f32x4 s4 = *(const f32x4*)(RST + (size_t)row * 32 + h * 4);
          const float mean = (s4[0] + s4[2]) * (1.f / 64.f), var = fmaxf((s4[1] + s4[3]) * (1.f / 64.f) - mean * mean, 0.f), rstd = rsqrtf(var + 64e-5f);
          bf16* p = BR + (size_t)row * 2048 + 512 + lane * 8; float y[8], c1[8], c2[8]; unpack8(*(const v4u*)p, y);
          unpack8(*(const v4u*)(GC + (size_t)row * 1024 + lane * 8), c1); unpack8(*(const v4u*)(GC + (size_t)row * 1024 + 512 + lane * 8), c2);
#pragma unroll
          for (int j = 0; j < 8; ++j) y[j] = (y[j] - mean) * rstd * c1[j] + c2[j];
          *(v4u*)p = pack8(y); }
    }
}

#define SEQ_SETUP const bool smp = seq >= 8; const int T = smp ? 8 : 2048; const int row0 = smp ? NPR + (seq - 8) * 8 : seq * 2048; const int bs = seq - 8; \
    const int Bg = smp ? 128 : 8; const int bo = smp ? bs : seq; (void)Bg; (void)bo; (void)bs;

typedef float f32x2 __attribute__((ext_vector_type(2)));
struct HgVec { f32x4 q0, q1, k0, k1, v4; };
__device__ __forceinline__ void hg_load(HgVec& X, const LAS float* b, const LAS float* pv) {
    X.q0 = *(const LAS f32x4*)b; X.q1 = *(const LAS f32x4*)(b + 4); X.k0 = *(const LAS f32x4*)(b + 8192); X.k1 = *(const LAS f32x4*)(b + 8192 + 4); X.v4 = *(const LAS f32x4*)pv;
}
__device__ __forceinline__ float hg_step1(f32x2 (&s)[4], const HgVec& X, float vv) {
    const f32x2 v2 = {vv, vv};
    s[0] = s[0] + X.k0.lo * (v2 - s[0]); s[1] = s[1] + X.k0.hi * (v2 - s[1]); s[2] = s[2] + X.k1.lo * (v2 - s[2]); s[3] = s[3] + X.k1.hi * (v2 - s[3]);
    f32x2 o = s[0] * X.q0.lo; o = s[1] * X.q0.hi + o; f32x2 p = s[2] * X.q1.lo; p = s[3] * X.q1.hi + p; o = o + p;
    return red16(o.x + o.y);
}
struct HgPre { v4u q, k, v; v2u og; };
#define HG_PF_WAIT(P) asm volatile("s_waitcnt vmcnt(0)" : "+v"(P.q), "+v"(P.k), "+v"(P.v), "+v"(P.og) :: "memory")
__device__ __forceinline__ void hg_prefetch(HgPre& P, const bf16* PROJ, int rowc, int tleft, int tid, int h, int vh) {
    const int t = tid >> 4;
    if (t < tleft) { const bf16* p = PROJ + (size_t)(rowc + t) * INC + h * 128; P.q = gload16(p + (tid & 15) * 8); P.k = gload16(p + 512 + (tid & 15) * 8); P.og = gload8(p + 1536 + vh * 64 + (tid & 15) * 4); }
    if (tid < 256 && (tid >> 3) < tleft) P.v = gload16(PROJ + (size_t)(rowc + (tid >> 3)) * INC + 1024 + h * 128 + vh * 64 + (tid & 7) * 8);
}
__device__ __forceinline__ void hg_unit(LAS unsigned char* lds, const MArgs& a, int tid_in, int l, int seq, int h, int vh, int mode) {
    SEQ_SETUP
    const int tid = tid_in, ds = tid & 15, v = ((tid >> 4) & 15) * 4;
    const bf16* PROJ = (const bf16*)(a.ws + WS_BIG); bf16* BR = (bf16*)(a.ws + WS_BR); float* SSP = (float*)(a.ws + WS_SSP);
    LAS float* SQ = (LAS float*)lds; LAS float* SK = SQ + 8192; LAS float* SV = SK + 8192; LAS float* SO = SV + 4096;
    HgPre P0, P1; P0.q = (v4u){0u, 0u, 0u, 0u}; P0.k = P0.q; P0.v = P0.q; P0.og = (v2u){0u, 0u}; P1 = P0;
    hg_prefetch(P0, PROJ, row0, T, tid, h, vh); hg_prefetch(P1, PROJ, row0 + 32, T - 32, tid, h, vh);
    f32x2 sc[4][4];
    if (smp && tid < 256) { const float* sp = INP(I_SHG) + ((size_t)(l * 128 + bs) * 4 + h) * 16384 + vh * 64 + v;
#pragma unroll
        for (int j = 0; j < 4; ++j) { const f32x4 x0 = *(const f32x4*)(sp + (ds * 8 + 2 * j) * 128), x1 = *(const f32x4*)(sp + (ds * 8 + 2 * j + 1) * 128);
#pragma unroll
            for (int c = 0; c < 4; ++c) sc[c][j] = (f32x2){x0[c], x1[c]}; } }
    else {
#pragma unroll
        for (int c = 0; c < 4; ++c)
#pragma unroll
            for (int j = 0; j < 4; ++j) sc[c][j] = (f32x2){0.f, 0.f}; }
    const f32x4 hg4 = *(const f32x4*)(INP(I_HGN) + l * 512 + h * 128 + vh * 64 + (tid & 15) * 4);
    VM_DRAIN_KNOWN();
    HG_PF_WAIT(P0); HG_PF_WAIT(P1);
    for (int t0 = 0; t0 < T; t0 += 64) {
        const int tc = (T - t0) < 64 ? (T - t0) : 64;
        const HgPre C0 = P0, C1 = P1;
        if (!(mode & 4)) {
#pragma unroll
          for (int hh = 0; hh < 2; ++hh) { const HgPre& C = hh ? C1 : C0; const int t = (tid >> 4) + 32 * hh, d8 = (tid & 15) * 8;
            if (t < tc) { float q[8], k[8]; unpack8(C.q, q); unpack8(C.k, k);
              *(LAS f32x4*)(SQ + t * 128 + d8) = (f32x4){q[0], q[1], q[2], q[3]}; *(LAS f32x4*)(SQ + t * 128 + d8 + 4) = (f32x4){q[4], q[5], q[6], q[7]};
              *(LAS f32x4*)(SK + t * 128 + d8) = (f32x4){k[0], k[1], k[2], k[3]}; *(LAS f32x4*)(SK + t * 128 + d8 + 4) = (f32x4){k[4], k[5], k[6], k[7]}; }
            if (tid < 256) { const int t2 = (tid >> 3) + 32 * hh, c8 = (tid & 7) * 8;
              if (t2 < tc) { float x[8]; unpack8(C.v, x);
                  *(LAS f32x4*)(SV + t2 * 64 + c8) = (f32x4){x[0], x[1], x[2], x[3]}; *(LAS f32x4*)(SV + t2 * 64 + c8 + 4) = (f32x4){x[4], x[5], x[6], x[7]}; } } } }
        if (t0 + 64 < T) { hg_prefetch(P0, PROJ, row0 + t0 + 64, T - t0 - 64, tid, h, vh); hg_prefetch(P1, PROJ, row0 + t0 + 96, T - t0 - 96, tid, h, vh); }
        LDS_BARRIER();
        if (tid < 256 && !(mode & 2)) { const LAS float* bq = SQ + ds * 8; const LAS float* pv = SV + v;
          HgVec A, B; hg_load(A, bq, pv);
          for (int t = 0; t < tc; t += 2) {
              hg_load(B, bq + (t + 1) * 128, pv + (t + 1) * 64);
              { const f32x4 o = {hg_step1(sc[0], A, A.v4[0]), hg_step1(sc[1], A, A.v4[1]), hg_step1(sc[2], A, A.v4[2]), hg_step1(sc[3], A, A.v4[3])}; if (ds == 0) *(LAS f32x4*)(SO + t * 64 + v) = o; }
              if (t + 2 < tc) hg_load(A, bq + (t + 2) * 128, pv + (t + 2) * 64);
              { const f32x4 o = {hg_step1(sc[0], B, B.v4[0]), hg_step1(sc[1], B, B.v4[1]), hg_step1(sc[2], B, B.v4[2]), hg_step1(sc[3], B, B.v4[3])}; if (ds == 0) *(LAS f32x4*)(SO + (t + 1) * 64 + v) = o; }
          } }
        LDS_BARRIER();
#pragma unroll
        for (int hh = 0; hh < 2; ++hh) { const HgPre& C = hh ? C1 : C0; const int t = (tid >> 4) + 32 * hh, c4 = (tid & 15) * 4;
          if (t < tc && !(mode & 1)) { const int row = row0 + t0 + t; const f32x4 o4 = *(const LAS f32x4*)(SO + t * 64 + c4);
              const float ssq = red8((o4[0] * o4[0] + o4[1] * o4[1]) + (o4[2] * o4[2] + o4[3] * o4[3]));
              if ((tid & 7) == 0) SSP[(size_t)row * 16 + h * 4 + vh * 2 + ((tid & 15) >> 3)] = ssq;
              float g[4]; unpack4(C.og, g);
              *(v2u*)(BR + (size_t)row * 2048 + h * 128 + vh * 64 + c4) = pack4(o4[0] * g[0] * hg4[0], o4[1] * g[1] * hg4[1], o4[2] * g[2] * hg4[2], o4[3] * g[3] * hg4[3]); } }
        HG_PF_WAIT(P0); HG_PF_WAIT(P1);
    }
    if (tid < 256 && !(mode & 1)) { float* so = a.out + (smp ? O_HG_S : O_HG_P) + ((size_t)(l * Bg + bo) * 4 + h) * 16384 + vh * 64 + v;
#pragma unroll
        for (int j = 0; j < 4; ++j) { *(f32x4*)(so + (ds * 8 + 2 * j) * 128) = (f32x4){sc[0][j].x, sc[1][j].x, sc[2][j].x, sc[3][j].x}; *(f32x4*)(so + (ds * 8 + 2 * j + 1) * 128) = (f32x4){sc[0][j].y, sc[1][j].y, sc[2][j].y, sc[3][j].y}; } }
    __syncthreads();
}

struct RwPre { v4u lc0, lc1, lp0, lp1; v2u rc, kc, vc, rp, kp, vp; };
__device__ __forceinline__ void rwkv_prefetch(RwPre& P, const bf16* PROJ, const float* shs, bool smp, int row0, int tg, int sub, int hc) {
    const bf16* pc = PROJ + (size_t)(row0 + tg) * INC + 2048;
    P.lc0 = gload16(pc + 1536 + sub * 16); P.lc1 = gload16(pc + 1536 + sub * 16 + 8);
    P.rc = gload8(pc + hc); P.kc = gload8(pc + 512 + hc); P.vc = gload8(pc + 1024 + hc);
    if (tg > 0) { P.lp0 = gload16(pc - INC + 1536 + sub * 16); P.lp1 = gload16(pc - INC + 1536 + sub * 16 + 8);
        P.rp = gload8(pc - INC + hc); P.kp = gload8(pc - INC + 512 + hc); P.vp = gload8(pc - INC + 1024 + hc); }
    else if (smp) {
        const float* q = shs + 1536 + sub * 16; float t8[8];
#pragma unroll
        for (int i = 0; i < 8; ++i) t8[i] = q[i];
        P.lp0 = pack8(t8);
#pragma unroll
        for (int i = 0; i < 8; ++i) t8[i] = q[8 + i];
        P.lp1 = pack8(t8);
        P.rp = pack4(shs[hc], shs[hc + 1], shs[hc + 2], shs[hc + 3]); P.kp = pack4(shs[512 + hc], shs[512 + hc + 1], shs[512 + hc + 2], shs[512 + hc + 3]);
        P.vp = pack4(shs[1024 + hc], shs[1024 + hc + 1], shs[1024 + hc + 2], shs[1024 + hc + 3]); }
    else { P.lp0 = (v4u){0u, 0u, 0u, 0u}; P.lp1 = P.lp0; P.rp = (v2u){0u, 0u}; P.kp = P.rp; P.vp = P.rp; }
}
#define RW_PF_WAIT(P) asm volatile("s_waitcnt vmcnt(0)" : "+v"(P.lc0), "+v"(P.lc1), "+v"(P.lp0), "+v"(P.lp1), "+v"(P.rc), "+v"(P.kc), "+v"(P.vc), "+v"(P.rp), "+v"(P.kp), "+v"(P.vp) :: "memory")
struct RwVec { f32x4 r, w, k, q, e; f32x2 vv; };
__device__ __forceinline__ void rw_load(RwVec& X, const LAS float* b, const LAS float* pv) {
    X.r = *(const LAS f32x4*)b; X.w = *(const LAS f32x4*)(b + 2048); X.k = *(const LAS f32x4*)(b + 4096); X.q = *(const LAS f32x4*)(b + 6144); X.e = *(const LAS f32x4*)(b + 8192); X.vv = *(const LAS f32x2*)pv;
}
__device__ __forceinline__ f32x2 rw_step2(f32x2 (&s0)[2], f32x2 (&s1)[2], const RwVec& X) {
    f32x2 a0 = s0[0] * X.q.lo; a0 = s0[1] * X.q.hi + a0; f32x2 a1 = s1[0] * X.q.lo; a1 = s1[1] * X.q.hi + a1;
    const float sa0 = -red16(a0.x + a0.y), sa1 = -red16(a1.x + a1.y);
    const f32x2 p0 = {sa0, sa0}, p1 = {sa1, sa1}, v0 = {X.vv.x, X.vv.x}, v1 = {X.vv.y, X.vv.y};
    s0[0] = s0[0] * X.w.lo + (p0 * X.e.lo + v0 * X.k.lo); s0[1] = s0[1] * X.w.hi + (p0 * X.e.hi + v0 * X.k.hi);
    s1[0] = s1[0] * X.w.lo + (p1 * X.e.lo + v1 * X.k.lo); s1[1] = s1[1] * X.w.hi + (p1 * X.e.hi + v1 * X.k.hi);
    f32x2 y0 = s0[0] * X.r.lo; y0 = s0[1] * X.r.hi + y0; f32x2 y1 = s1[0] * X.r.lo; y1 = s1[1] * X.r.hi + y1;
    return (f32x2){red16(y0.x + y0.y), red16(y1.x + y1.y)};
}
__device__ __forceinline__ void rwkv_unit(LAS unsigned char* lds, const MArgs& a, int tid_in, int l, int seq, int h, int half, int mode) {
    SEQ_SETUP
    const int tid = tid_in, lane = tid & 63, wave = __builtin_amdgcn_readfirstlane(tid >> 6);
    const bf16* PROJ = (const bf16*)(a.ws + WS_BIG); bf16* BR = (bf16*)(a.ws + WS_BR);
    LAS bf16* WUPT = (LAS bf16*)(lds + 65664); LAS bf16* AUPT = WUPT + 64 * 72; LAS bf16* GUPT = AUPT + 64 * 72;
    LAS bf16* LRB = (LAS bf16*)(lds + 65664 + 35840);
    LAS float* LWA = (LAS float*)(lds + 65664 + 52736);
    LAS float* SR = (LAS float*)(lds + 0); LAS float* SW = SR + 2048; LAS float* SK = SW + 2048; LAS float* SKK = SK + 2048; LAS float* SKA = SKK + 2048;
    LAS float* SV = SKA + 2048; LAS float* SG = SV + 2048; LAS float* SY = SG + 2048; LAS float* SB = SY + 2048;
    const int st = tid >> 4, sub = tid & 15, c4 = sub * 4, hc = h * 64 + c4;
    const float* mu = INP(I_MU) + l * 1792;
    const float* shs = INP(I_SSH) + (size_t)(l * 128 + (smp ? bs : 0)) * 1792;
    RwPre P;
    P.lc0 = (v4u){0u, 0u, 0u, 0u}; P.lc1 = P.lc0; P.lp0 = P.lc0; P.lp1 = P.lc0; P.rc = (v2u){0u, 0u}; P.kc = P.rc; P.vc = P.rc; P.rp = P.rc; P.kp = P.rc; P.vp = P.rc;
    if (st < T) rwkv_prefetch(P, PROJ, shs, smp, row0, st, sub, hc);
    RW_PF_WAIT(P);
    { const int j = tid >> 3, c8 = (tid & 7) * 8;
      const float* p = INP(I_WUP) + ((size_t)l * 64 + j) * 512 + h * 64 + c8; f32x4 x0 = *(const f32x4*)p, x1 = *(const f32x4*)(p + 4);
#pragma unroll
      for (int i = 0; i < 4; ++i) { WUPT[(c8 + i) * 72 + j] = (bf16)(cvt_pk_bf16(x0[i], 0.f) & 0xffffu); WUPT[(c8 + 4 + i) * 72 + j] = (bf16)(cvt_pk_bf16(x1[i], 0.f) & 0xffffu); }
      p = INP(I_AUP) + ((size_t)l * 64 + j) * 512 + h * 64 + c8; x0 = *(const f32x4*)p; x1 = *(const f32x4*)(p + 4);
#pragma unroll
      for (int i = 0; i < 4; ++i) { AUPT[(c8 + i) * 72 + j] = (bf16)(cvt_pk_bf16(x0[i], 0.f) & 0xffffu); AUPT[(c8 + 4 + i) * 72 + j] = (bf16)(cvt_pk_bf16(x1[i], 0.f) & 0xffffu); }
#pragma unroll
      for (int r = 0; r < 2; ++r) { const int jj = j + 64 * r; p = INP(I_GUP) + ((size_t)l * 128 + jj) * 512 + h * 64 + c8; x0 = *(const f32x4*)p; x1 = *(const f32x4*)(p + 4);
#pragma unroll
          for (int i = 0; i < 4; ++i) { GUPT[(c8 + i) * 136 + jj] = (bf16)(cvt_pk_bf16(x0[i], 0.f) & 0xffffu); GUPT[(c8 + 4 + i) * 136 + jj] = (bf16)(cvt_pk_bf16(x1[i], 0.f) & 0xffffu); } } }
    const bool both = smp;
    const int hsel = both ? (tid >> 8) : half;
    const int sv = hsel * 32 + ((tid >> 4) & 15) * 2, ks = tid & 15;
    f32x2 s0[2], s1[2];
    if (smp) { const float* sp = INP(I_SRW) + ((size_t)(l * 128 + bs) * 8 + h) * 4096 + sv * 64 + ks * 4; const f32x4 x0 = *(const f32x4*)sp, x1 = *(const f32x4*)(sp + 64);
        s0[0] = x0.lo; s0[1] = x0.hi; s1[0] = x1.lo; s1[1] = x1.hi; }
    else { s0[0] = (f32x2){0.f, 0.f}; s0[1] = s0[0]; s1[0] = s0[0]; s1[1] = s0[0]; }
    f32x4 pw0, pa0, pkk, pka, prk, plg, plb;
    { pw0 = *(const f32x4*)(INP(I_W0) + l * 512 + hc); pa0 = *(const f32x4*)(INP(I_A0) + l * 512 + hc); pkk = *(const f32x4*)(INP(I_KK) + l * 512 + hc); pka = *(const f32x4*)(INP(I_KA) + l * 512 + hc);
      prk = *(const f32x4*)(INP(I_RK) + l * 512 + hc); plg = *(const f32x4*)(INP(I_LNG) + l * 512 + hc); plb = *(const f32x4*)(INP(I_LNB) + l * 512 + hc); }
    VM_DRAIN_KNOWN();
    for (int t0 = 0; t0 < T; t0 += 32) {
        const int tc = (T - t0) < 32 ? (T - t0) : 32;
        const int grow = row0 + t0 + st;
        const RwPre C = P;
        if (st < tc && !(mode & 4)) { const int j0 = sub * 16;
#pragma unroll
            for (int hh = 0; hh < 2; ++hh) { float xc[8], xp[8]; unpack8(hh ? C.lc1 : C.lc0, xc); unpack8(hh ? C.lp1 : C.lp0, xp);
                const f32x4 m0 = *(const f32x4*)(mu + 1536 + j0 + 8 * hh), m1 = *(const f32x4*)(mu + 1536 + j0 + 8 * hh + 4);
                float o[8];
#pragma unroll
                for (int i = 0; i < 8; ++i) { float x = xc[i] + (xp[i] - xc[i]) * (i < 4 ? m0[i] : m1[i - 4]); o[i] = j0 < 64 ? tanh_(x) : (j0 < 128 ? x : sigm(x)); }
                *(LAS v4u*)(LRB + st * 264 + j0 + 8 * hh) = pack8(o); } }
        LDS_BARRIER();
        { const int mt = wave >> 2, nt = wave & 3, fr = lane & 15, fq = lane >> 4;
          if (mt * 16 < tc && !(mode & 4)) {
              f32x4 cw = {0.f, 0.f, 0.f, 0.f}, ca = {0.f, 0.f, 0.f, 0.f}, cgt = {0.f, 0.f, 0.f, 0.f};
              const LAS bf16* ar = LRB + (mt * 16 + fr) * 264 + fq * 8;
#pragma unroll
              for (int kk = 0; kk < 2; ++kk) {
                  cw = __builtin_amdgcn_mfma_f32_16x16x32_bf16(*(const LAS pg8::bf16x8*)(ar + kk * 32), *(const LAS pg8::bf16x8*)(WUPT + (nt * 16 + fr) * 72 + kk * 32 + fq * 8), cw, 0, 0, 0);
                  ca = __builtin_amdgcn_mfma_f32_16x16x32_bf16(*(const LAS pg8::bf16x8*)(ar + 64 + kk * 32), *(const LAS pg8::bf16x8*)(AUPT + (nt * 16 + fr) * 72 + kk * 32 + fq * 8), ca, 0, 0, 0); }
#pragma unroll
              for (int kk = 0; kk < 4; ++kk)
                  cgt = __builtin_amdgcn_mfma_f32_16x16x32_bf16(*(const LAS pg8::bf16x8*)(ar + 128 + kk * 32), *(const LAS pg8::bf16x8*)(GUPT + (nt * 16 + fr) * 136 + kk * 32 + fq * 8), cgt, 0, 0, 0);
#pragma unroll
              for (int j = 0; j < 4; ++j) { const int o = (mt * 16 + fq * 4 + j) * 64 + nt * 16 + fr; LWA[o] = cw[j]; LWA[2048 + o] = ca[j]; LWA[4096 + o] = cgt[j]; } } }
        LDS_BARRIER();
        if (st < tc && !(mode & 4)) {
            const f32x4 lw = *(const LAS f32x4*)(LWA + st * 64 + c4), la = *(const LAS f32x4*)(LWA + 2048 + st * 64 + c4), lg = *(const LAS f32x4*)(LWA + 4096 + st * 64 + c4);
            float r4[4], k4[4], v4[4];
            { float rc[4], kc[4], vc[4], rp[4], kp[4], vp[4]; unpack4(C.rc, rc); unpack4(C.kc, kc); unpack4(C.vc, vc); unpack4(C.rp, rp); unpack4(C.kp, kp); unpack4(C.vp, vp);
              const f32x4 mr = *(const f32x4*)(mu + hc), mk = *(const f32x4*)(mu + 512 + hc), mv = *(const f32x4*)(mu + 1024 + hc);
#pragma unroll
              for (int i = 0; i < 4; ++i) { r4[i] = rc[i] + (rp[i] - rc[i]) * mr[i]; k4[i] = kc[i] + (kp[i] - kc[i]) * mk[i]; v4[i] = vc[i] + (vp[i] - vc[i]) * mv[i]; } }
            float wd[4], av[4], kkr[4]; float ssq = 0.f;
#pragma unroll
            for (int i = 0; i < 4; ++i) { wd[i] = __expf(-0.606531f * sigm(pw0[i] + lw[i])); av[i] = sigm(pa0[i] + la[i]); kkr[i] = k4[i] * pkk[i]; ssq += kkr[i] * kkr[i]; }
            ssq = red16(ssq); const float inv = 1.f / fmaxf(sqrtf(ssq), 1e-12f);
            float bon = 0.f; float k2[4], kkv[4], kav[4];
#pragma unroll
            for (int i = 0; i < 4; ++i) { kkv[i] = kkr[i] * inv; k2[i] = k4[i] * (1.f + (av[i] - 1.f) * pka[i]); kav[i] = kkv[i] * av[i]; bon += r4[i] * k2[i] * prk[i]; }
            *(LAS f32x4*)(SR + st * 64 + c4) = (f32x4){r4[0], r4[1], r4[2], r4[3]}; *(LAS f32x4*)(SW + st * 64 + c4) = (f32x4){wd[0], wd[1], wd[2], wd[3]};
            *(LAS f32x4*)(SK + st * 64 + c4) = (f32x4){k2[0], k2[1], k2[2], k2[3]}; *(LAS f32x4*)(SKK + st * 64 + c4) = (f32x4){kkv[0], kkv[1], kkv[2], kkv[3]};
            *(LAS f32x4*)(SKA + st * 64 + c4) = (f32x4){kav[0], kav[1], kav[2], kav[3]}; *(LAS f32x4*)(SV + st * 64 + c4) = (f32x4){v4[0], v4[1], v4[2], v4[3]};
            *(LAS f32x4*)(SG + st * 64 + c4) = lg;
            bon = red16(bon); if (sub == 0) SB[st] = bon;
        }
        if (t0 + 32 + st < T) rwkv_prefetch(P, PROJ, shs, smp, row0, t0 + 32 + st, sub, hc);
        LDS_BARRIER();
        if ((both || tid < 256) && !(mode & 2)) { const LAS float* b0 = SR + ks * 4; const LAS float* pv = SV + sv;
          RwVec A, B; rw_load(A, b0, pv);
          for (int t = 0; t < tc; t += 2) {
              rw_load(B, b0 + (t + 1) * 64, pv + (t + 1) * 64);
              const f32x2 ya = rw_step2(s0, s1, A);
              if (ks == 0) *(LAS f32x2*)(SY + t * 64 + sv) = ya;
              if (t + 2 < tc) rw_load(A, b0 + (t + 2) * 64, pv + (t + 2) * 64);
              const f32x2 yb = rw_step2(s0, s1, B);
              if (ks == 0) *(LAS f32x2*)(SY + (t + 1) * 64 + sv) = yb;
          } }
        RW_PF_WAIT(P);
        LDS_BARRIER();
        if (st < tc && (both || (sub >> 3) == half) && !(mode & 1)) {
            const f32x4 y4 = *(const LAS f32x4*)(SY + st * 64 + c4);
            const float sy = red8((y4[0] + y4[1]) + (y4[2] + y4[3])), sq = red8((y4[0] * y4[0] + y4[1] * y4[1]) + (y4[2] * y4[2] + y4[3] * y4[3]));
            if ((sub & 7) == 0) *(f32x2*)((float*)(a.ws + WS_RST) + (size_t)grow * 32 + h * 4 + (sub >> 3) * 2) = (f32x2){sy, sq};
            const float bon = SB[st];
            const f32x4 vv4 = *(const LAS f32x4*)(SV + st * 64 + c4), gg4 = *(const LAS f32x4*)(SG + st * 64 + c4);
            float c1[4], c2[4];
#pragma unroll
            for (int i = 0; i < 4; ++i) { c1[i] = plg[i] * gg4[i]; c2[i] = (plb[i] + bon * vv4[i]) * gg4[i]; }
            *(v2u*)(BR + (size_t)grow * 2048 + 512 + hc) = pack4(y4[0], y4[1], y4[2], y4[3]);
            bf16* GC = (bf16*)(a.ws + WS_G) + (size_t)grow * 1024;
            *(v2u*)(GC + hc) = pack4(c1[0], c1[1], c1[2], c1[3]); *(v2u*)(GC + 512 + hc) = pack4(c2[0], c2[1], c2[2], c2[3]);
        }
    }
    if ((both || tid < 256) && !(mode & 1)) { float* so = a.out + (smp ? O_RW_S : O_RW_P) + ((size_t)(l * Bg + bo) * 8 + h) * 4096 + sv * 64 + ks * 4;
      *(f32x4*)so = (f32x4){s0[0].x, s0[0].y, s0[1].x, s0[1].y}; *(f32x4*)(so + 64) = (f32x4){s1[0].x, s1[0].y, s1[1].x, s1[1].y}; }
    { float* sh = a.out + (smp ? O_SH_S : O_SH_P) + (size_t)(l * Bg + bo) * 1792; const bf16* pl = PROJ + (size_t)(row0 + T - 1) * INC + 2048;
      if ((both || half == 0) && tid < 64 && !(mode & 1)) { sh[h * 64 + tid] = bf2f(pl[h * 64 + tid]); sh[512 + h * 64 + tid] = bf2f(pl[512 + h * 64 + tid]); sh[1024 + h * 64 + tid] = bf2f(pl[1024 + h * 64 + tid]); }
      if ((both || half == 0) && h == 0 && tid >= 256 && !(mode & 1)) sh[1536 + tid - 256] = bf2f(pl[1536 + tid - 256]); }
    __syncthreads();
}

struct LrPre { v2u x0, x1, x2, x3, g; };
#define LR_PF_WAIT(P) asm volatile("s_waitcnt vmcnt(0)" : "+v"(P.x0), "+v"(P.x1), "+v"(P.x2), "+v"(P.x3), "+v"(P.g) :: "memory")
__device__ __forceinline__ void lru_prefetch(LrPre& P, const bf16* PROJ, const float* cst, bool smp, int row0, int tg, int ch) {
    const bf16* p = PROJ + (size_t)(row0 + tg) * INC + 4864 + ch;
    P.g = gload8(p + 512); P.x3 = gload8(p);
    if (tg >= 3) { P.x2 = gload8(p - INC); P.x1 = gload8(p - 2 * INC); P.x0 = gload8(p - 3 * INC); }
    else {
        v2u* dst[3] = {&P.x2, &P.x1, &P.x0};
#pragma unroll
        for (int j = 0; j < 3; ++j) { const int ts = tg - 1 - j;
            if (ts >= 0) *dst[j] = gload8(p - (j + 1) * INC);
            else if (smp) { const float* q = cst + (3 + ts) * 512 + ch; *dst[j] = pack4(q[0], q[1], q[2], q[3]); }
            else *dst[j] = (v2u){0u, 0u}; } }
}
__device__ __forceinline__ void lru_unit(LAS unsigned char* lds, const MArgs& a, int tid_in, int l, int seq, int n) {
    SEQ_SETUP
    const int tid = tid_in, lane = tid & 63, wave = __builtin_amdgcn_readfirstlane(tid >> 6);
    const bf16* PROJ = (const bf16*)(a.ws + WS_BIG); bf16* BR = (bf16*)(a.ws + WS_BR);
    LAS bf16* WAT = (LAS bf16*)lds; LAS bf16* WXT = WAT + 64 * 72; LAS bf16* XCB = WXT + 64 * 72;
    LAS float* RA = (LAS float*)(lds + 23040); LAS float* RI = RA + 2048; LAS float* AA = RI + 2048; LAS float* BB = AA + 2048; LAS float* HS = BB + 2048;
    const int st = tid >> 4, sub = tid & 15, d4 = sub * 4, ch = n * 64 + d4;
    const float* cst = INP(I_SLC) + (size_t)(l * 128 + (smp ? bs : 0)) * 3 * 512;
    LrPre P; P.x0 = (v2u){0u, 0u}; P.x1 = P.x0; P.x2 = P.x0; P.x3 = P.x0; P.g = P.x0;
    if (st < T) lru_prefetch(P, PROJ, cst, smp, row0, st, ch);
    LR_PF_WAIT(P);
    { const int c = tid >> 3, d8 = (tid & 7) * 8;
      const float* p = INP(I_LWA) + (size_t)(l * 8 + n) * 4096 + c * 64 + d8; f32x4 x0 = *(const f32x4*)p, x1 = *(const f32x4*)(p + 4);
#pragma unroll
      for (int i = 0; i < 4; ++i) { WAT[(d8 + i) * 72 + c] = (bf16)(cvt_pk_bf16(x0[i], 0.f) & 0xffffu); WAT[(d8 + 4 + i) * 72 + c] = (bf16)(cvt_pk_bf16(x1[i], 0.f) & 0xffffu); }
      p = INP(I_LWX) + (size_t)(l * 8 + n) * 4096 + c * 64 + d8; x0 = *(const f32x4*)p; x1 = *(const f32x4*)(p + 4);
#pragma unroll
      for (int i = 0; i < 4; ++i) { WXT[(d8 + i) * 72 + c] = (bf16)(cvt_pk_bf16(x0[i], 0.f) & 0xffffu); WXT[(d8 + 4 + i) * 72 + c] = (bf16)(cvt_pk_bf16(x1[i], 0.f) & 0xffffu); } }
    float hprev = (smp && wave == 0) ? INP(I_SLH)[(size_t)(l * 128 + bs) * 512 + n * 64 + lane] : 0.f;
    float cw[4][4], cb[4], ba[4], bx[4], sp[4];
#pragma unroll
    for (int i = 0; i < 4; ++i) {
#pragma unroll
        for (int j = 0; j < 4; ++j) cw[j][i] = INP(I_LCW)[(l * 4 + j) * 512 + ch + i];
        cb[i] = INP(I_LCB)[l * 512 + ch + i]; ba[i] = INP(I_LBA)[l * 512 + ch + i]; bx[i] = INP(I_LBX)[l * 512 + ch + i];
        const float lam = INP(I_LAM)[l * 512 + ch + i]; sp[i] = log1pf(__expf(-lam)); }
    VM_DRAIN_KNOWN();
    for (int t0 = 0; t0 < T; t0 += 32) {
        const int tc = (T - t0) < 32 ? (T - t0) : 32;
        const int grow = row0 + t0 + st;
        const LrPre C = P;
        float xc[4], gl[4];
        if (st < tc) { float x0[4], x1[4], x2[4], x3[4]; unpack4(C.x0, x0); unpack4(C.x1, x1); unpack4(C.x2, x2); unpack4(C.x3, x3); unpack4(C.g, gl);
#pragma unroll
            for (int i = 0; i < 4; ++i) xc[i] = cb[i] + cw[0][i] * x0[i] + cw[1][i] * x1[i] + cw[2][i] * x2[i] + cw[3][i] * x3[i];
            *(LAS v2u*)(XCB + st * 72 + d4) = pack4(xc[0], xc[1], xc[2], xc[3]); }
        LDS_BARRIER();
        { const int mt = wave >> 2, nq = wave & 3, fr = lane & 15, fq = lane >> 4;
          if (mt * 16 < tc) {
              f32x4 ca = {0.f, 0.f, 0.f, 0.f}, cx = {0.f, 0.f, 0.f, 0.f};
#pragma unroll
              for (int kk = 0; kk < 2; ++kk) { const pg8::bf16x8 av = *(const LAS pg8::bf16x8*)(XCB + (mt * 16 + fr) * 72 + kk * 32 + fq * 8);
                  ca = __builtin_amdgcn_mfma_f32_16x16x32_bf16(av, *(const LAS pg8::bf16x8*)(WAT + (nq * 16 + fr) * 72 + kk * 32 + fq * 8), ca, 0, 0, 0);
                  cx = __builtin_amdgcn_mfma_f32_16x16x32_bf16(av, *(const LAS pg8::bf16x8*)(WXT + (nq * 16 + fr) * 72 + kk * 32 + fq * 8), cx, 0, 0, 0); }
#pragma unroll
              for (int j = 0; j < 4; ++j) { const int o = (mt * 16 + fq * 4 + j) * 64 + nq * 16 + fr; RA[o] = ca[j]; RI[o] = cx[j]; } } }
        LDS_BARRIER();
        if (st < tc) {
            const f32x4 ra = *(const LAS f32x4*)(RA + st * 64 + d4), ri = *(const LAS f32x4*)(RI + st * 64 + d4);
            float av[4], bv[4];
#pragma unroll
            for (int i = 0; i < 4; ++i) { const float rg = sigm(ra[i] + ba[i]), ig = sigm(ri[i] + bx[i]); const float la = -8.f * rg * sp[i]; av[i] = __expf(la); bv[i] = sqrtf(1.f - __expf(2.f * la)) * (ig * xc[i]); }
            *(LAS f32x4*)(AA + st * 64 + d4) = (f32x4){av[0], av[1], av[2], av[3]}; *(LAS f32x4*)(BB + st * 64 + d4) = (f32x4){bv[0], bv[1], bv[2], bv[3]};
        }
        if (t0 + 32 + st < T) lru_prefetch(P, PROJ, cst, smp, row0, t0 + 32 + st, ch);
        LDS_BARRIER();
        if (wave == 0) { float ar[32], br[32];
#pragma unroll
            for (int t = 0; t < 32; ++t) { ar[t] = AA[t * 64 + lane]; br[t] = BB[t * 64 + lane]; }
            float hh = hprev;
#pragma unroll
            for (int t = 0; t < 32; ++t) { if (t < tc) { hh = ar[t] * hh + br[t]; br[t] = hh; } }
#pragma unroll
            for (int t = 0; t < 32; ++t) HS[t * 64 + lane] = br[t];
            hprev = hh; }
        LDS_BARRIER();
        if (st < tc) { const f32x4 hs = *(const LAS f32x4*)(HS + st * 64 + d4);
            *(v2u*)(BR + (size_t)grow * 2048 + 1536 + ch) = pack4(hs[0] * gl[0], hs[1] * gl[1], hs[2] * gl[2], hs[3] * gl[3]); }
        LR_PF_WAIT(P);
    }
    if (wave == 0) a.out[(smp ? O_LH_S : O_LH_P) + (size_t)(l * Bg + bo) * 512 + n * 64 + lane] = hprev;
    if (tid < 192) { const int i = tid >> 6, c = tid & 63; a.out[(smp ? O_LC_S : O_LC_P) + ((size_t)(l * Bg + bo) * 3 + i) * 512 + n * 64 + c] = bf2f(PROJ[(size_t)(row0 + T - 3 + i) * INC + 4864 + n * 64 + c]); }
    __syncthreads();
}

template <int TC> __device__ __forceinline__ void cf_unit(LAS unsigned char* lds, const MArgs& a, int tid_in, int l, int seq, int t0, int tc) {
    SEQ_SETUP
    const int tid = tid_in, lane = tid & 63, wave = tid >> 6, c = tid;
    const bf16* PROJ = (const bf16*)(a.ws + WS_BIG); bf16* BR = (bf16*)(a.ws + WS_BR);
    LAS float* U = (LAS float*)lds;
    const float* cst = INP(I_SCV) + (size_t)(l * 128 + (smp ? bs : 0)) * 30 * 512;
    constexpr int NR = TC + 30, NP = (NR + 7) / 8;
    { v4u va[NP], vg[NP];
#pragma unroll
      for (int k = 0; k < NP; ++k) { const int i = wave + 8 * k, tt = t0 - 30 + i;
          if (i < tc + 30 && tt >= 0) { const bf16* p = PROJ + (size_t)(row0 + tt) * INC + 3840 + lane * 8; va[k] = *(const v4u*)p; vg[k] = *(const v4u*)(p + 512); } }
#pragma unroll
      for (int k = 0; k < NP; ++k) { const int i = wave + 8 * k, tt = t0 - 30 + i;
          if (i < tc + 30) { float u[8];
              if (tt >= 0) { float x[8], g[8]; unpack8(va[k], x); unpack8(vg[k], g);
#pragma unroll
                  for (int j = 0; j < 8; ++j) u[j] = x[j] * g[j]; }
              else if (smp) { const float* q = cst + (30 + tt) * 512 + lane * 8; const f32x4 q0 = *(const f32x4*)q, q1 = *(const f32x4*)(q + 4);
                  u[0] = q0[0]; u[1] = q0[1]; u[2] = q0[2]; u[3] = q0[3]; u[4] = q1[0]; u[5] = q1[1]; u[6] = q1[2]; u[7] = q1[3]; }
              else {
#pragma unroll
                  for (int j = 0; j < 8; ++j) u[j] = 0.f; }
              *(LAS f32x4*)(U + i * 512 + lane * 8) = (f32x4){u[0], u[1], u[2], u[3]}; *(LAS f32x4*)(U + i * 512 + lane * 8 + 4) = (f32x4){u[4], u[5], u[6], u[7]}; } } }
    float w[31];
#pragma unroll
    for (int j = 0; j < 31; ++j) w[j] = INP(I_CFDW)[(size_t)(l * 31 + j) * 512 + c];
    const float bias = INP(I_CFDWB)[l * 512 + c];
    __syncthreads();
    { float acc[TC];
#pragma unroll
      for (int t = 0; t < TC; ++t) acc[t] = bias;
#pragma unroll
      for (int i = 0; i < NR; ++i) { const float u = U[i * 512 + c];
#pragma unroll
          for (int t = 0; t < TC; ++t) { if (i - t >= 0 && i - t <= 30) acc[t] += u * w[i - t]; } }
#pragma unroll
      for (int t = 0; t < TC; ++t) { if (t < tc) U[t * 512 + c] = acc[t]; } }
    if (t0 + tc == T) { float* so = a.out + (smp ? O_CV_S : O_CV_P) + (size_t)(l * Bg + bo) * 30 * 512 + c;
#pragma unroll 6
        for (int i = 0; i < 30; ++i) so[i * 512] = U[(tc + i) * 512 + c]; }
    __syncthreads();
    for (int t = wave; t < tc; t += 8) {
        const f32x4 x0 = *(const LAS f32x4*)(U + t * 512 + lane * 8), x1 = *(const LAS f32x4*)(U + t * 512 + lane * 8 + 4);
        const float mean = wave_sum((x0[0] + x0[1]) + (x0[2] + x0[3]) + (x1[0] + x1[1]) + (x1[2] + x1[3])) * (1.f / 512.f);
        float d[8] = {x0[0] - mean, x0[1] - mean, x0[2] - mean, x0[3] - mean, x1[0] - mean, x1[1] - mean, x1[2] - mean, x1[3] - mean};
        float q = 0.f;
#pragma unroll
        for (int j = 0; j < 8; ++j) q += d[j] * d[j];
        const float rstd = rsqrtf(wave_sum(q) * (1.f / 512.f) + 1e-5f);
        const float* g = INP(I_CFLG) + l * 512 + lane * 8; const float* b = INP(I_CFLB) + l * 512 + lane * 8;
#pragma unroll
        for (int j = 0; j < 8; ++j) d[j] = silu_(d[j] * rstd * g[j] + b[j]);
        *(v4u*)(BR + (size_t)(row0 + t0 + t) * 2048 + 1024 + lane * 8) = pack8(d);
    }
    __syncthreads();
}

__device__ __forceinline__ void phase_mixers(const Args& a, int l, LAS unsigned char* lds, int rep = 0, int ulo = 0, int uhi = 3968, int mode = 0) {
    unsigned* ctr = (unsigned*)(a.ws + WS_CTL) + 64 * (1 + l + 2 * rep);
    volatile LAS unsigned* slot = (volatile LAS unsigned*)(lds + MISC_OFF);
    for (;;) {
        if (threadIdx.x == 0) slot[0] = atomicAdd(ctr, 1u);
        __syncthreads();
        const int u = (int)slot[0] + ulo;
        __syncthreads();
        if (u >= uhi) break;
        int kind, seq, p1, p2 = 0;
        if (u < 128) { kind = 0; seq = u >> 4; p1 = (u >> 1) & 7; p2 = u & 1; }
        else if (u < 192) { const int v = u - 128; kind = 1; seq = v >> 3; p1 = (v >> 1) & 3; p2 = v & 1; }
        else if (u < 256) { const int v = u - 192; kind = 2; seq = v >> 3; p1 = v & 7; }
        else if (u < 768) { const int v = u - 256; kind = 3; seq = v >> 6; p1 = (v & 63) * 32; p2 = 32; }
        else if (u < 1792) { const int v = u - 768; kind = 1; seq = 8 + (v >> 3); p1 = (v >> 1) & 3; p2 = v & 1; }
        else if (u < 2816) { const int v = u - 1792; kind = 0; seq = 8 + (v >> 3); p1 = v & 7; p2 = 0; }
        else if (u < 3840) { const int v = u - 2816; kind = 2; seq = 8 + (v >> 3); p1 = v & 7; }
        else { const int v = u - 3840; kind = 3; seq = 8 + v; p1 = 0; p2 = 8; }
        MArgs m; m.out = a.out; m.ws = a.ws; int ll = l;
        int tl = threadIdx.x;
        int md = mode;
        asm volatile("" : "+s"(m.out), "+s"(m.ws), "+s"(ll), "+v"(tl), "+s"(md));
        if (kind == 0) rwkv_unit(lds, m, tl, ll, seq, p1, p2, md);
        else if (kind == 1) hg_unit(lds, m, tl, ll, seq, p1, p2, md);
        else if (kind == 2) lru_unit(lds, m, tl, ll, seq, p1);
        else cf_unit<32>(lds, m, tl, ll, seq, p1, p2);
    }
}

#define XB_TMO      128
#define XB_XCNT(j)  (256  + 64 * (j))
#define XB_XSUB(j)  (1280 + 64 * (j))
#define XB_XGEN(j)  (2304 + 64 * (j))
#define XB_TOP      3328
#define XB_TOPGEN   3392
#define XCD_BAR_WORDS 3456
#define XB_SPIN_CAP (1u << 18)

__device__ __forceinline__ unsigned xb_ld(unsigned* p)              { return __hip_atomic_load(p, __ATOMIC_RELAXED, __HIP_MEMORY_SCOPE_AGENT); }
__device__ __forceinline__ unsigned xb_add(unsigned* p, unsigned v) { return __hip_atomic_fetch_add(p, v, __ATOMIC_RELAXED, __HIP_MEMORY_SCOPE_AGENT); }
__device__ __forceinline__ unsigned xb_xcc_id() { return (unsigned)__builtin_amdgcn_s_getreg((3 << 11) | 20) & 0xFu; }
#define XB_SPIN(cond, bar) do { unsigned _sp = 0; while (cond) { __builtin_amdgcn_s_sleep(1); \
    if ((++_sp & 255u) == 0u) { if (xb_ld(&(bar)[XB_TMO])) break; if (_sp > XB_SPIN_CAP) { atomicAdd(&(bar)[XB_TMO], 1u); break; } } } } while (0)

struct XcdBarrier {
    unsigned* bar; unsigned x;
    volatile LAS unsigned* st;
};

__device__ __forceinline__ XcdBarrier xcd_barrier_post(unsigned* bar, volatile LAS unsigned* st) {
    XcdBarrier b; b.bar = bar; b.x = xb_xcc_id(); b.st = st;
    if (threadIdx.x == 0) (void)xb_add(&bar[XB_XCNT(b.x)], 1u);
    return b;
}
__device__ __forceinline__ void xcd_barrier_complete(unsigned* bar, unsigned x, unsigned& nloc, unsigned& nx) {
    const unsigned G = gridDim.x * gridDim.y * gridDim.z;
    unsigned sum, cnt, mine, sp = 0u;
    for (;;) {
        sum = 0u; cnt = 0u; mine = 0u;
#pragma unroll
        for (unsigned j = 0; j < 16; ++j) { const unsigned c = xb_ld(&bar[XB_XCNT(j)]); sum += c; cnt += (c > 0u) ? 1u : 0u; mine = (j == x) ? c : mine; }
        if (sum == G) break;
        __builtin_amdgcn_s_sleep(1);
        if ((++sp & 255u) == 0u) { if (xb_ld(&bar[XB_TMO])) break; if (sp > XB_SPIN_CAP) { atomicAdd(&bar[XB_TMO], 1u); break; } }
    }
    nloc = mine > 0u ? mine : 1u; nx = cnt > 0u ? cnt : 1u;
}

__device__ __forceinline__ void xcd_barrier(const XcdBarrier& b) {
    asm volatile("s_waitcnt vmcnt(0)" ::: "memory");
    __syncthreads();
    if (threadIdx.x == 0) {
        unsigned* bar = b.bar;
        __builtin_amdgcn_s_waitcnt(0);
        unsigned nloc = b.st[0], nx = b.st[1];
        if (nloc == 0u) { xcd_barrier_complete(bar, b.x, nloc, nx); b.st[0] = nloc; b.st[1] = nx; }
        const unsigned old = xb_add(&bar[XB_XSUB(b.x)], 1u);
        const unsigned gen = old / nloc;
        if (old + 1u == (gen + 1u) * nloc) {
            __builtin_amdgcn_fence(__ATOMIC_RELEASE, "agent");
            asm volatile("s_waitcnt vmcnt(0)" ::: "memory");
            const unsigned og = xb_add(&bar[XB_TOP], 1u);
            const unsigned tg = og / nx;
            if (og + 1u == (tg + 1u) * nx) xb_add(&bar[XB_TOPGEN], 1u);
            else XB_SPIN(xb_ld(&bar[XB_TOPGEN]) == tg, bar);
            __builtin_amdgcn_fence(__ATOMIC_ACQUIRE, "agent");
            xb_add(&bar[XB_XGEN(b.x)], 1u);
            asm volatile("s_waitcnt vmcnt(0)" ::: "memory");
        } else {
            XB_SPIN(xb_ld(&bar[XB_XGEN(b.x)]) == gen, bar);
            __builtin_amdgcn_fence(__ATOMIC_ACQUIRE, "agent");
            asm volatile("s_waitcnt vmcnt(0)" ::: "memory");
        }
    }
    __syncthreads();
}

constexpr int N_PHASES = 21;
#define IN(k) (a.ph_lo <= (k) && (k) < a.ph_hi)
#define SEAM(k) do { if (IN(k) && IN((k) + 1)) { if (a.ph_hi == 0x7fffffff) cg::this_grid().sync(); xcd_barrier(xbar); } } while (0)
template <int l> __device__ __forceinline__ void layer_phases(const Args& a, LAS unsigned char* lds, int G, int gw, int NGW, int wave, int lane, const XcdBarrier& xbar) {
    constexpr int P = 2 + 9 * l;
    const bf16* H = (const bf16*)(a.ws + WS_H);
    const float* MODL = (const float*)(a.ws + WS_MOD) + l * 6144;
    const bool fuse13 = G == 256 && IN(P + 0) && IN(P + 1) && IN(P + 3) && IN(P + 4);
    if (IN(P + 0)) { if (l == 1 && !fuse13) phase_conv_layer(a, 1, lds, gw, NGW, wave, lane, G > 80 ? 6528 : 0, 10624); phase_norm(a, l, 0, gw, NGW, lane); }
    SEAM(P + 0);
    if (IN(P + 1)) {
        pg8::Gemm g{H, (const pg8::bf16_t*)(a.ws + WS_WIN), NTOK, INC, 1024}; pg8::StaticOrder S; S.init(NTOK, INC, G, (int)blockIdx.x);
        pg8::EpiProj E{(pg8::bf16_t*)(a.ws + WS_BIG), INP(I_HGL), l};
        pg8::gemm_phase<pg8::EpiProj, pg8::StaticOrder, true, true>(lds, g, S, E);
        if (fuse13 && (int)blockIdx.x >= 28 && (int)blockIdx.x < 92) {
            pg8::Gemm g2{H + (size_t)NPR * 1024, (const pg8::bf16_t*)(a.ws + WS_WG), NTOK - NPR, 4096, 1024}; pg8::StaticOrder S2; S2.init(NTOK - NPR, 4096, 64, (int)blockIdx.x - 28);
            pg8::EpiGate E2{(pg8::bf16_t*)(a.ws + WS_GS), INP(I_BGATE) + l * 4096};
            pg8::gemm_phase<pg8::EpiGate, pg8::StaticOrder, true, true>(lds, g2, S2, E2);
        }
        if (fuse13 && (int)blockIdx.x >= 92)
            phase_conv_layer(a, l, lds, ((int)blockIdx.x - 92) * 8 + wave, (G - 92) * 8, wave, lane, l == 0 ? 4992 : 6528, 10624);
    }
    SEAM(P + 1);
#ifdef PROBE_MIX
    if (IN(P + 2)) { phase_mixers(a, l, lds); xcd_barrier(xbar); phase_mixers(a, l, lds, 1, PROBE_LO, PROBE_HI, PROBE_MODE); }
#else
    if (IN(P + 2)) phase_mixers(a, l, lds);
#endif
    SEAM(P + 2);
    if (IN(P + 3)) {
        phase_hg_post(a, gw, NGW, lane);
        const int Mg = fuse13 ? NPR : NTOK;
        pg8::Gemm g{H, (const pg8::bf16_t*)(a.ws + WS_WG), Mg, 4096, 1024}; pg8::StaticOrder S; S.init(Mg, 4096, G, (int)blockIdx.x);
        pg8::EpiGate E{(pg8::bf16_t*)(a.ws + WS_BIG), INP(I_BGATE) + l * 4096};
        pg8::gemm_phase<pg8::EpiGate, pg8::StaticOrder, true, true>(lds, g, S, E);
    }
    SEAM(P + 3);
    if (IN(P + 4)) {
        pg8::Gemm g{(const pg8::bf16_t*)(a.ws + WS_BR), (const pg8::bf16_t*)(a.ws + WS_WB), NTOK, 1024, 2048}; pg8::StaticOrder S; S.init(NTOK, 1024, G, (int)blockIdx.x);
        pg8::EpiBranch E{(pg8::bf16_t*)(a.ws + WS_G), (const pg8::bf16_t*)(a.ws + WS_BIG), fuse13 ? (const pg8::bf16_t*)(a.ws + WS_GS) - (size_t)NPR * 4096 : (const pg8::bf16_t*)(a.ws + WS_BIG)};
        pg8::gemm_phase<pg8::EpiBranch, pg8::StaticOrder, true, true>(lds, g, S, E);
    }
    SEAM(P + 4);
    if (IN(P + 5)) {
        pg8::Gemm g{(const pg8::bf16_t*)(a.ws + WS_G), (const pg8::bf16_t*)(a.ws + WS_WO), NTOK, 1024, 1024}; pg8::StaticOrder S; S.init(NTOK, 1024, G, (int)blockIdx.x);
        pg8::EpiRes E{a.out, l == 0 ? INP(I_XP) : a.out, l == 0 ? INP(I_XS) : a.out + (size_t)NPR * 1024, MODL + 2048, 0};
        pg8::gemm_phase<pg8::EpiRes, pg8::StaticOrder, true, true>(lds, g, S, E);
    }
    SEAM(P + 5);
    const bool fuse67 = G > 64 && IN(P + 6) && IN(P + 7) && IN(P + 8);
    if (IN(P + 6)) {
        if (fuse67) {
            phase_norm(a, l, 1, gw, NGW, lane, NPR, NTOK);
            xcd_barrier(xbar);
            if ((int)blockIdx.x < 64) {
                pg8::Gemm g{H + (size_t)NPR * 1024, (const pg8::bf16_t*)(a.ws + WS_W1), NTOK - NPR, 4096, 1024}; pg8::StaticOrder S; S.init(NTOK - NPR, 4096, 64, (int)blockIdx.x);
                pg8::EpiRelu2 E{(pg8::bf16_t*)(a.ws + WS_BIG) + (size_t)NPR * 4096};
                pg8::gemm_phase<pg8::EpiRelu2, pg8::StaticOrder, true, true>(lds, g, S, E);
            } else phase_norm(a, l, 1, ((int)blockIdx.x - 64) * 8 + wave, (G - 64) * 8, lane, 0, NPR);
        } else phase_norm(a, l, 1, gw, NGW, lane);
    }
    SEAM(P + 6);
    if (IN(P + 7)) {
        const pg8::bf16_t* W1 = (const pg8::bf16_t*)(a.ws + WS_W1); pg8::bf16_t* U = (pg8::bf16_t*)(a.ws + WS_BIG);
        if (G > 16 && IN(P + 8)) {
            if (!fuse67) {
              { pg8::Gemm g{H + (size_t)NPR * 1024, W1, NTOK - NPR, 4096, 1024}; pg8::StaticOrder S; S.init(NTOK - NPR, 4096, G, (int)blockIdx.x);
                pg8::EpiRelu2 E{U + (size_t)NPR * 4096};
                pg8::gemm_phase<pg8::EpiRelu2, pg8::StaticOrder, true, true>(lds, g, S, E); }
              xcd_barrier(xbar);
            }
            if ((int)blockIdx.x < 16) {
                pg8::Gemm g{U + (size_t)NPR * 4096, (const pg8::bf16_t*)(a.ws + WS_W2), NTOK - NPR, 1024, 4096}; pg8::StaticOrder S; S.init(NTOK - NPR, 1024, 16, (int)blockIdx.x);
                pg8::EpiRes E{a.out, a.out, a.out + (size_t)NPR * 1024, MODL + 5120, NPR};
                pg8::gemm_phase<pg8::EpiRes, pg8::StaticOrder, true, true>(lds, g, S, E);
            } else {
                pg8::Gemm g{H, W1, NPR, 4096, 1024}; pg8::StaticOrder S; S.init(NPR, 4096, G - 16, (int)blockIdx.x - 16);
                pg8::EpiRelu2 E{U};
                pg8::gemm_phase<pg8::EpiRelu2, pg8::StaticOrder, true, true>(lds, g, S, E);
                if (l == 0 && (int)blockIdx.x >= 80 && G > 80)
                    phase_conv_layer(a, 1, lds, ((int)blockIdx.x - 80) * 8 + wave, (G - 80) * 8, wave, lane, 0, 6528);
            }
        } else {
            pg8::Gemm g{H, W1, NTOK, 4096, 1024}; pg8::StaticOrder S; S.init(NTOK, 4096, G, (int)blockIdx.x);
            pg8::EpiRelu2 E{U};
            pg8::gemm_phase<pg8::EpiRelu2, pg8::StaticOrder, true, true>(lds, g, S, E);
        }
    }
    SEAM(P + 7);
    if (IN(P + 8)) {
        const int Mrows = (G > 16 && IN(P + 7)) ? NPR : NTOK;
        pg8::Gemm g{(const pg8::bf16_t*)(a.ws + WS_BIG), (const pg8::bf16_t*)(a.ws + WS_W2), Mrows, 1024, 4096}; pg8::StaticOrder S; S.init(Mrows, 1024, G, (int)blockIdx.x);
        pg8::EpiRes E{a.out, a.out, a.out + (size_t)NPR * 1024, MODL + 5120, 0};
        pg8::gemm_phase<pg8::EpiRes, pg8::StaticOrder, true, true>(lds, g, S, E);
    }
    SEAM(P + 8);
}
__global__ void __launch_bounds__(512, 2) mega(Args a) {
    LAS unsigned char* lds = (LAS unsigned char*)lds_raw;
    const int tid = threadIdx.x, lane = tid & 63, wave = __builtin_amdgcn_readfirstlane(tid >> 6);
    const int G = gridDim.x, gw = blockIdx.x * 8 + wave, NGW = G * 8;
    if (tid == 0) {
#pragma unroll
        for (int i = 0; i < 46; ++i) *(LAS unsigned long long*)(lds + TAB_OFF + 8 * i) = (unsigned long long)a.in[i];
        *(LAS unsigned*)(lds + MISC_OFF + 32) = 0u; *(LAS unsigned*)(lds + MISC_OFF + 36) = 0u;
    }
    __syncthreads();
    XcdBarrier xbar; xbar.bar = (unsigned*)(a.ws + WS_CTL) + 4096; xbar.x = 0; xbar.st = (volatile LAS unsigned*)(lds + MISC_OFF + 32);
    if (a.ph_hi - a.ph_lo > 1) xbar = xcd_barrier_post((unsigned*)(a.ws + WS_CTL) + 4096, (volatile LAS unsigned*)(lds + MISC_OFF + 32));
    if (IN(0)) phase_conv_ada(a, lds, gw, NGW, wave, lane);
    SEAM(0);
    if (IN(1)) {
        pg8::Gemm g{(const pg8::bf16_t*)(a.ws + WS_CA), (const pg8::bf16_t*)(a.ws + WS_BIG), 256, 12288, 1024}; pg8::StaticOrder S; S.init(256, 12288, G, (int)blockIdx.x);
        pg8::EpiMod E{(float*)(a.ws + WS_MOD), INP(I_ADAB)};
        pg8::gemm_phase<pg8::EpiMod, pg8::StaticOrder, true, true>(lds, g, S, E);
        if ((int)blockIdx.x >= 48 && G > 48)
            phase_conv_layer(a, 0, lds, ((int)blockIdx.x - 48) * 8 + wave, (G - 48) * 8, wave, lane, 0, (G == 256 && a.ph_lo == 0 && a.ph_hi == N_PHASES) ? 4992 : 10624);
        else if (G <= 48) phase_conv_layer(a, 0, lds, gw, NGW, wave, lane, 0, 10624);
    }
    SEAM(1);
    layer_phases<0>(a, lds, G, gw, NGW, wave, lane, xbar);
    layer_phases<1>(a, lds, G, gw, NGW, wave, lane, xbar);
#ifdef PROBE_SYNC
    for (int i = 0; i < 40; ++i) xcd_barrier(xbar);
#endif
    if (IN(20)) phase_final(a, gw, NGW, lane);
}

extern "C" void kernel_launch(void* const* d_in, const int* in_sizes, int n_in, void* d_out, int out_size, void* d_ws, size_t ws_size, hipStream_t stream) {
    static int grid = 0;
    if (grid == 0) {
        if (n_in != 46 || ws_size < WS_END) { fprintf(stderr, "kernel_launch: bad n_in %d or ws %zu (< %zu)\n", n_in, ws_size, (size_t)WS_END); grid = -1; return; }
        (void)hipFuncSetAttribute((const void*)mega, hipFuncAttributeMaxDynamicSharedMemorySize, LDS_BYTES);
        int dev = 0, cus = 0, per_cu = 0;
        (void)hipGetDevice(&dev); (void)hipDeviceGetAttribute(&cus, hipDeviceAttributeMultiprocessorCount, dev);
        (void)hipOccupancyMaxActiveBlocksPerMultiprocessor(&per_cu, (const void*)mega, 512, LDS_BYTES);
        if (per_cu < 1) fprintf(stderr, "kernel_launch: occupancy query says %d\n", per_cu);
        (void)hipGetLastError();
        grid = cus > 0 ? cus : 256;
    }
    if (grid < 0) return;
    (void)hipMemsetAsync((char*)d_ws + WS_CTL, 0, CTL_BYTES, stream);
    Args a{};
    for (int i = 0; i < 46; ++i) a.in[i] = (const float*)d_in[i];
    a.out = (float*)d_out; a.ws = (unsigned char*)d_ws;
#if MK_SINGLE
    a.ph_lo = 0; a.ph_hi = N_PHASES;
    void* args[] = {&a};
    hipError_t e = hipLaunchCooperativeKernel((const void*)mega, dim3(grid), dim3(512), args, LDS_BYTES, stream);
    if (e != hipSuccess) fprintf(stderr, "cooperative launch failed: %s (grid %d)\n", hipGetErrorString(e), grid);
#else
    for (int ph = 0; ph < N_PHASES; ++ph) { a.ph_lo = ph; a.ph_hi = ph + 1; hipLaunchKernelGGL(mega, dim3(grid), dim3(512), LDS_BYTES, stream, a); }
#endif
}
```

```cpp
#include <hip/hip_runtime.h>
#include <hip/hip_cooperative_groups.h>
#include <cstdio>
#include <cstdint>
namespace cg = cooperative_groups;
namespace pg8 {
#define PG8_LAS __attribute__((address_space(3)))
typedef unsigned short bf16_t;
typedef short bf16x8 __attribute__((ext_vector_type(8)));
typedef float f32x4 __attribute__((ext_vector_type(4)));
typedef unsigned u32x4 __attribute__((ext_vector_type(4)));
constexpr int BM = 256, BK = 64, HALF = 128, HTB = HALF * BK * 2  , STAGE_BYTES = 8 * HTB, NXCD = 8, WGM = 8;

__host__ __device__ __forceinline__ int lds_byte(int r, int c) { const int st = (r >> 4) * 2 + (c >> 5), rr = r & 15, cc = c & 31, ob = rr * 64 + cc * 2; return st * 1024 + (ob ^ (((ob >> 9) & 1) << 5)); }
__host__ __device__ __forceinline__ void stage_rc(int b, int& R, int& C) { const int st = b / 1024, sb = b % 1024, swz = sb ^ (((sb >> 9) & 1) << 5); R = (st >> 1) * 16 + swz / 64; C = (st & 1) * 32 + (swz % 64) / 2; }
__host__ __device__ __forceinline__ int perm32(int rho) { const int n = rho >> 4, i = rho & 15; return 8 * (i >> 2) + 4 * n + (i & 3); }

struct Unit { int pm, pn; };
struct Gemm { const bf16_t* A; const bf16_t* Bt; int M, N, K; };

struct StaticOrder {
    int nM, nN, nwg, G, c;
    __host__ __device__ void init(int M, int N, int G_, int c_) { nM = M / BM; nN = N / BM; nwg = nM * nN; G = G_; c = c_; }
    __host__ __device__ bool next(int i, Unit& u) const {
        const long L = (long)i * G + c; if (L >= nwg) return false;
        int wgid = (int)L; { const int q = nwg / NXCD, r = nwg % NXCD, xcd = wgid % NXCD, off = wgid / NXCD; wgid = (xcd < r ? xcd * (q + 1) : r * (q + 1) + (xcd - r) * q) + off; }
        const int nig = WGM * nN, gid = wgid / nig, fm = gid * WGM, gsz = (nM - fm) < WGM ? (nM - fm) : WGM;
        u.pm = fm + ((wgid % nig) % gsz); u.pn = (wgid % nig) / gsz; return true;
    }
    __device__ __forceinline__ void a_ready(const Unit&) const {}
    __device__ __forceinline__ void done(const Unit&) const {}
};

__device__ __forceinline__ unsigned cvt_pk_bf16(float lo, float hi) { unsigned r; asm volatile("v_cvt_pk_bf16_f32 %0, %1, %2" : "=v"(r) : "v"(lo), "v"(hi)); return r; }
__device__ __forceinline__ float sigm(float x) { return __builtin_amdgcn_rcpf(1.f + __expf(-x)); }
__device__ __forceinline__ float silu_(float x) { return x * sigm(x); }
__device__ __forceinline__ float tanh_(float u) { return 1.f - 2.f * __builtin_amdgcn_rcpf(__expf(2.f * u) + 1.f); }
__device__ __forceinline__ float gelu_tanh(float x) { const float u = 0.7978845608f * (x + 0.044715f * x * x * x); return 0.5f * x * (1.f + tanh_(u)); }
__device__ __forceinline__ int cond_of_row(int row) { return row < 16384 ? (row >> 11) : 8 + ((row - 16384) >> 3); }
__device__ __forceinline__ void unpack8(const u32x4 w, float (&f)[8]) {
    f[0] = __uint_as_float(w.x << 16); f[1] = __uint_as_float(w.x & 0xffff0000u); f[2] = __uint_as_float(w.y << 16); f[3] = __uint_as_float(w.y & 0xffff0000u);
    f[4] = __uint_as_float(w.z << 16); f[5] = __uint_as_float(w.z & 0xffff0000u); f[6] = __uint_as_float(w.w << 16); f[7] = __uint_as_float(w.w & 0xffff0000u);
}
__device__ __forceinline__ u32x4 pack8(const float (&f)[8]) { u32x4 w; w.x = cvt_pk_bf16(f[0], f[1]); w.y = cvt_pk_bf16(f[2], f[3]); w.z = cvt_pk_bf16(f[4], f[5]); w.w = cvt_pk_bf16(f[6], f[7]); return w; }

#define EPI_LOOP_BEGIN \
    _Pragma("unroll") for (int ai = 0; ai < 2; ++ai) _Pragma("unroll") for (int m = 0; m < 4; ++m) { const int row = u.pm * BM + ai * HALF + wr * 64 + m * 16 + fr; \
    _Pragma("unroll") for (int bj = 0; bj < 2; ++bj) { const int colb = u.pn * BM + bj * HALF; const int col = colb + wc * 32 + 8 * fq; \
        float v[8]; v[0] = acc[ai][bj][m][0][0]; v[1] = acc[ai][bj][m][0][1]; v[2] = acc[ai][bj][m][0][2]; v[3] = acc[ai][bj][m][0][3]; \
        v[4] = acc[ai][bj][m][1][0]; v[5] = acc[ai][bj][m][1][1]; v[6] = acc[ai][bj][m][1][2]; v[7] = acc[ai][bj][m][1][3];
#define EPI_LOOP_END } }

struct EpiProj {
    static constexpr bool PERM = true, AFTER_DRAIN = false, HOOK = false;
    bf16_t* O; const float* hgl; int layer;
    __device__ __forceinline__ void operator()(const f32x4 (&acc)[2][2][4][2], const Unit& u, int wr, int wc, int fr, int fq) const {
        EPI_LOOP_BEGIN
            const int sec = colb >> 7;
            if (sec < 4 || (sec >= 12 && sec < 16)) {
#pragma unroll
                for (int j = 0; j < 8; ++j) v[j] = silu_(v[j]);
            } else if (sec < 8) {
#pragma unroll
                for (int j = 0; j < 8; ++j) { const int c = col - 512 + j; const float lb = layer == 0 ? 0.f : __builtin_amdgcn_rcpf(1.f + __expf(hgl[c] - hgl[512 + c])); v[j] = (1.f - lb) * sigm(-v[j]); }
            } else if (sec >= 34 && sec < 38) {
#pragma unroll
                for (int j = 0; j < 8; ++j) v[j] = sigm(v[j]);
            } else if (sec >= 42) {
#pragma unroll
                for (int j = 0; j < 8; ++j) v[j] = gelu_tanh(v[j]);
            }
            *(u32x4*)(O + (size_t)row * 5888 + col) = pack8(v);
        EPI_LOOP_END
    }
};
struct EpiGate {
    static constexpr bool PERM = true, AFTER_DRAIN = false, HOOK = false;
    bf16_t* O; const float* bias;
    __device__ __forceinline__ void operator()(const f32x4 (&acc)[2][2][4][2], const Unit& u, int wr, int wc, int fr, int fq) const {
        EPI_LOOP_BEGIN
            const f32x4 b0 = *(const f32x4*)(bias + col), b1 = *(const f32x4*)(bias + col + 4);
            v[0] = sigm(v[0] + b0[0]); v[1] = sigm(v[1] + b0[1]); v[2] = sigm(v[2] + b0[2]); v[3] = sigm(v[3] + b0[3]);
            v[4] = sigm(v[4] + b1[0]); v[5] = sigm(v[5] + b1[1]); v[6] = sigm(v[6] + b1[2]); v[7] = sigm(v[7] + b1[3]);
            *(u32x4*)(O + (size_t)row * 4096 + col) = pack8(v);
        EPI_LOOP_END
    }
};
struct EpiMod {
    static constexpr bool PERM = true, AFTER_DRAIN = false, HOOK = false;
    float* O; const float* bias;
    __device__ __forceinline__ void operator()(const f32x4 (&acc)[2][2][4][2], const Unit& u, int wr, int wc, int fr, int fq) const {
        EPI_LOOP_BEGIN
            const f32x4 b0 = *(const f32x4*)(bias + col), b1 = *(const f32x4*)(bias + col + 4);
            *(f32x4*)(O + (size_t)row * 12288 + col) = (f32x4){v[0] + b0[0], v[1] + b0[1], v[2] + b0[2], v[3] + b0[3]};
            *(f32x4*)(O + (size_t)row * 12288 + col + 4) = (f32x4){v[4] + b1[0], v[5] + b1[1], v[6] + b1[2], v[7] + b1[3]};
        EPI_LOOP_END
    }
};
struct EpiBranch {
    static constexpr bool PERM = true, AFTER_DRAIN = false, HOOK = true;
    bf16_t* O; const bf16_t* G; const bf16_t* G2;
    __device__ __forceinline__ void hook(f32x4 (&acc)[2][2][4][2], const Unit& u, int kb, int wr, int wc, int fr, int fq) const {
        __builtin_amdgcn_sched_barrier(0);
#pragma unroll
        for (int ai = 0; ai < 2; ++ai)
#pragma unroll
            for (int m = 0; m < 4; ++m) { const int row = u.pm * BM + ai * HALF + wr * 64 + m * 16 + fr;
#pragma unroll
                for (int bj = 0; bj < 2; ++bj) { const int col = u.pn * BM + bj * HALF + wc * 32 + 8 * fq;
                    const bf16_t* gp = (row < 16384 ? G : G2) + (size_t)row * 4096 + kb * 1024 + col;
                    float g0[8], g1[8]; unpack8(*(const u32x4*)gp, g0); unpack8(*(const u32x4*)(gp + 1024), g1);
#pragma unroll
                    for (int j = 0; j < 4; ++j) { acc[ai][bj][m][0][j] *= g0[j] * __builtin_amdgcn_rcpf(g1[j]); acc[ai][bj][m][1][j] *= g0[4 + j] * __builtin_amdgcn_rcpf(g1[4 + j]); }
                }
                __builtin_amdgcn_sched_barrier(0); }
    }
    __device__ __forceinline__ void operator()(const f32x4 (&acc)[2][2][4][2], const Unit& u, int wr, int wc, int fr, int fq) const {
        EPI_LOOP_BEGIN
            float g[8]; unpack8(*(const u32x4*)((row < 16384 ? G : G2) + (size_t)row * 4096 + 3072 + col), g);
#pragma unroll
            for (int j = 0; j < 8; ++j) v[j] *= g[j];
            *(u32x4*)(O + (size_t)row * 1024 + col) = pack8(v);
        EPI_LOOP_END
    }
};
struct EpiRes {
    static constexpr bool PERM = true, AFTER_DRAIN = false, HOOK = false;
    float* X; const float* res0; const float* res1; const float* gmod; int row0;
    __device__ __forceinline__ void operator()(const f32x4 (&acc)[2][2][4][2], const Unit& u, int wr, int wc, int fr, int fq) const {
        EPI_LOOP_BEGIN
            const int grow = row + row0;
            const float* rp = (grow < 16384 ? res0 + (size_t)grow * 1024 : res1 + (size_t)(grow - 16384) * 1024) + col;
            const float* gp = gmod + (size_t)cond_of_row(grow) * 12288 + col;
            const f32x4 r0 = *(const f32x4*)rp, r1 = *(const f32x4*)(rp + 4), g0 = *(const f32x4*)gp, g1 = *(const f32x4*)(gp + 4);
            *(f32x4*)(X + (size_t)grow * 1024 + col) = (f32x4){r0[0] + g0[0] * v[0], r0[1] + g0[1] * v[1], r0[2] + g0[2] * v[2], r0[3] + g0[3] * v[3]};
            *(f32x4*)(X + (size_t)grow * 1024 + col + 4) = (f32x4){r1[0] + g1[0] * v[4], r1[1] + g1[1] * v[5], r1[2] + g1[2] * v[6], r1[3] + g1[3] * v[7]};
        EPI_LOOP_END
    }
};
struct EpiRelu2 {
    static constexpr bool PERM = true, AFTER_DRAIN = false, HOOK = false;
    bf16_t* O;
    __device__ __forceinline__ void operator()(const f32x4 (&acc)[2][2][4][2], const Unit& u, int wr, int wc, int fr, int fq) const {
        EPI_LOOP_BEGIN
#pragma unroll
            for (int j = 0; j < 8; ++j) { const float r = fmaxf(v[j], 0.f); v[j] = r * r; }
            *(u32x4*)(O + (size_t)row * 4096 + col) = pack8(v);
        EPI_LOOP_END
    }
};
template <class Epi, class Sched, bool ALIGN_EPI = false, bool SP2 = false>
__device__ __forceinline__ void gemm_phase(PG8_LAS unsigned char* lds, const Gemm g, const Sched& S, const Epi& E) {
    const int tid = threadIdx.x, wid = __builtin_amdgcn_readfirstlane(tid >> 6), lane = tid & 63, wr = wid >> 2, wc = wid & 3, fr = lane & 15, fq = lane >> 4;
    const int K = g.K, nt = K / BK;
    unsigned voffA[2], voffB[2];
#pragma unroll
    for (int i = 0; i < 2; ++i) { int R, C; stage_rc(tid * 16 + i * 8192, R, C); const int Rb = Epi::PERM ? ((R & ~31) + perm32(R & 31)) : R;
        voffA[i] = (unsigned)(R * K + C) * 2u; voffB[i] = (unsigned)(Rb * K + C) * 2u; }
    const size_t kstep = (size_t)(BK * 2);
    const size_t hstep = (size_t)HALF * K * 2;
    const size_t tstep = 2 * hstep;
    const unsigned ldsw = (unsigned)wid * 1024u;
    const int aoff = lds_byte(wr * 64 + fr, fq * 8), boff = lds_byte(wc * 32 + fr, fq * 8);
#define PG8_SA(b, h) (((b) * 2 + (h)) * HTB)
#define PG8_SB(b, h) ((4 + (b) * 2 + (h)) * HTB)
#define PG8_STAGE(bufoff, gbase, voff) do { _Pragma("unroll") for (int _i = 0; _i < 2; ++_i) \
        __builtin_amdgcn_global_load_lds((const unsigned*)((const char*)(gbase) + (voff)[_i]), (PG8_LAS unsigned*)(lds + (bufoff) + ldsw + _i * 8192), 16, 0, 0); } while (0)
#define PG8_LDA(dst, b, h) do { _Pragma("unroll") for (int m = 0; m < 4; ++m) _Pragma("unroll") for (int k = 0; k < 2; ++k) dst[m][k] = *(const PG8_LAS bf16x8*)(lds + PG8_SA(b, h) + aoff + m * 2048 + k * 1024); } while (0)
#define PG8_LDB(dst, b, h) do { _Pragma("unroll") for (int n = 0; n < 2; ++n) _Pragma("unroll") for (int k = 0; k < 2; ++k) dst[n][k] = *(const PG8_LAS bf16x8*)(lds + PG8_SB(b, h) + boff + n * 2048 + k * 1024); } while (0)
#define PG8_MMA(ai, bj, At, Bt) do { __builtin_amdgcn_s_setprio(1); _Pragma("unroll") for (int m = 0; m < 4; ++m) _Pragma("unroll") for (int n = 0; n < 2; ++n) _Pragma("unroll") for (int k = 0; k < 2; ++k) \
        acc[ai][bj][m][n] = __builtin_amdgcn_mfma_f32_16x16x32_bf16(Bt[n][k], At[m][k], acc[ai][bj][m][n], 0, 0, 0); __builtin_amdgcn_s_setprio(0); } while (0)
#define PG8_WAIT_V(n) asm volatile("s_waitcnt vmcnt(" #n ")" ::: "memory")
#define PG8_WAIT_L(n) asm volatile("s_waitcnt lgkmcnt(" #n ")" ::: "memory")
#define PG8_BAR __builtin_amdgcn_s_barrier()
#define PG8_SCHED __builtin_amdgcn_sched_barrier(0)
    Unit cur, nxt; int ui = 0;
    if (!S.next(0, cur)) return;
    f32x4 acc[2][2][4][2];
#pragma unroll
    for (int a = 0; a < 2; ++a)
#pragma unroll
        for (int b = 0; b < 2; ++b)
#pragma unroll
            for (int m = 0; m < 4; ++m)
#pragma unroll
                for (int n = 0; n < 2; ++n) acc[a][b][m][n] = (f32x4){0.f, 0.f, 0.f, 0.f};
    bf16x8 At[4][2], B0[2][2], B1[2][2];
    const char* cA = (const char*)g.A + (size_t)cur.pm * tstep; const char* cB = (const char*)g.Bt + (size_t)cur.pn * tstep;
    S.a_ready(cur);
    if constexpr (SP2) {
        PG8_STAGE(PG8_SB(0, 0), cB, voffB); PG8_STAGE(PG8_SB(0, 1), cB + hstep, voffB); PG8_STAGE(PG8_SA(0, 0), cA, voffA); PG8_STAGE(PG8_SA(0, 1), cA + hstep, voffA);
        if (wr == 1) PG8_BAR;
        PG8_WAIT_V(2); PG8_BAR;
        PG8_STAGE(PG8_SB(1, 0), cB + kstep, voffB); PG8_STAGE(PG8_SA(1, 0), cA + kstep, voffA); PG8_STAGE(PG8_SB(1, 1), cB + hstep + kstep, voffB);
        PG8_WAIT_V(6); PG8_BAR;
    } else {
        PG8_STAGE(PG8_SB(0, 0), cB, voffB); PG8_STAGE(PG8_SA(0, 0), cA, voffA); PG8_STAGE(PG8_SB(0, 1), cB + hstep, voffB); PG8_STAGE(PG8_SA(0, 1), cA + hstep, voffA);
        if (wr == 1) PG8_BAR;
        PG8_WAIT_V(4); PG8_BAR;
        PG8_STAGE(PG8_SB(1, 0), cB + kstep, voffB); PG8_STAGE(PG8_SA(1, 0), cA + kstep, voffA); PG8_STAGE(PG8_SB(1, 1), cB + hstep + kstep, voffB);
        PG8_WAIT_V(6); PG8_BAR;
    }
    for (;;) {
        const bool has_next = S.next(ui + 1, nxt);
        const char* nA = has_next ? (const char*)g.A + (size_t)nxt.pm * tstep : cA; const char* nB = has_next ? (const char*)g.Bt + (size_t)nxt.pn * tstep : cB;
        for (int t = 0; t < nt; t += 2) {
            const bool last = (t == nt - 2);
            const char* a1 = cA + (size_t)(t + 1) * kstep;
            const char* a2 = last ? nA : cA + (size_t)(t + 2) * kstep; const char* b2 = last ? nB : cB + (size_t)(t + 2) * kstep;
            const char* a3 = a2 + kstep; const char* b3 = b2 + kstep;
            if (last && has_next) S.a_ready(nxt);
            if constexpr (SP2) {
            PG8_LDB(B0, 0, 0); PG8_LDB(B1, 0, 1); PG8_SCHED; PG8_LDA(At, 0, 0); PG8_STAGE(PG8_SA(1, 1), a1 + hstep, voffA);
            PG8_WAIT_V(8); PG8_WAIT_L(0); PG8_BAR; PG8_MMA(0, 0, At, B0); PG8_MMA(0, 1, At, B1); PG8_BAR; PG8_SCHED;
            PG8_LDA(At, 0, 1); PG8_STAGE(PG8_SB(0, 0), b2, voffB); PG8_STAGE(PG8_SB(0, 1), b2 + hstep, voffB); PG8_STAGE(PG8_SA(0, 0), a2, voffA);
            PG8_WAIT_V(8); PG8_WAIT_L(0); PG8_BAR; PG8_MMA(1, 0, At, B0); PG8_MMA(1, 1, At, B1); PG8_BAR; PG8_SCHED;
            PG8_LDB(B0, 1, 0); PG8_LDB(B1, 1, 1); PG8_SCHED; PG8_LDA(At, 1, 0); PG8_STAGE(PG8_SA(0, 1), a2 + hstep, voffA);
            PG8_WAIT_V(8); PG8_WAIT_L(0); PG8_BAR; PG8_MMA(0, 0, At, B0); PG8_MMA(0, 1, At, B1); PG8_BAR; PG8_SCHED;
            PG8_LDA(At, 1, 1); PG8_STAGE(PG8_SB(1, 0), b3, voffB); PG8_STAGE(PG8_SB(1, 1), b3 + hstep, voffB); PG8_STAGE(PG8_SA(1, 0), a3, voffA);
            PG8_WAIT_V(8); PG8_WAIT_L(0); PG8_BAR; PG8_MMA(1, 0, At, B0); PG8_MMA(1, 1, At, B1); PG8_BAR; PG8_SCHED;
            } else {
            PG8_LDB(B0, 0, 0); PG8_SCHED; PG8_LDA(At, 0, 0); PG8_STAGE(PG8_SA(1, 1), a1 + hstep, voffA);
            PG8_WAIT_L(8); PG8_BAR; PG8_WAIT_L(0); PG8_MMA(0, 0, At, B0); PG8_BAR; PG8_SCHED;
            PG8_LDB(B1, 0, 1); PG8_STAGE(PG8_SB(0, 0), b2, voffB);
            PG8_BAR; PG8_WAIT_L(0); PG8_MMA(0, 1, At, B1); PG8_BAR;
            PG8_LDA(At, 0, 1); PG8_STAGE(PG8_SA(0, 0), a2, voffA);
            PG8_BAR; PG8_WAIT_L(0); PG8_MMA(1, 0, At, B0); PG8_BAR; PG8_SCHED;
            PG8_STAGE(PG8_SB(0, 1), b2 + hstep, voffB);
            PG8_WAIT_V(6); PG8_BAR; PG8_MMA(1, 1, At, B1); PG8_BAR;
            PG8_LDB(B0, 1, 0); PG8_SCHED; PG8_LDA(At, 1, 0); PG8_STAGE(PG8_SA(0, 1), a2 + hstep, voffA);
            PG8_WAIT_L(8); PG8_BAR; PG8_WAIT_L(0); PG8_MMA(0, 0, At, B0); PG8_BAR; PG8_SCHED;
            PG8_LDB(B1, 1, 1); PG8_STAGE(PG8_SB(1, 0), b3, voffB);
            PG8_BAR; PG8_WAIT_L(0); PG8_MMA(0, 1, At, B1); PG8_BAR;
            PG8_LDA(At, 1, 1); PG8_STAGE(PG8_SA(1, 0), a3, voffA);
            PG8_BAR; PG8_WAIT_L(0); PG8_MMA(1, 0, At, B0); PG8_BAR; PG8_SCHED;
            PG8_STAGE(PG8_SB(1, 1), b3 + hstep, voffB);
            PG8_WAIT_V(6); PG8_BAR; PG8_MMA(1, 1, At, B1); PG8_BAR;
            }
            if constexpr (Epi::HOOK) { if ((((t + 2) & 7) == 0) && !last) E.hook(acc, cur, ((t + 2) >> 3) - 1, wr, wc, fr, fq); }
        }
        if constexpr (ALIGN_EPI) { if (wr == 0) PG8_BAR; }
        if constexpr (!Epi::AFTER_DRAIN) { E(acc, cur, wr, wc, fr, fq); S.done(cur); }
        if (!has_next) break;
#pragma unroll
        for (int a = 0; a < 2; ++a)
#pragma unroll
            for (int b = 0; b < 2; ++b)
#pragma unroll
                for (int m = 0; m < 4; ++m)
#pragma unroll
                    for (int n = 0; n < 2; ++n) acc[a][b][m][n] = (f32x4){0.f, 0.f, 0.f, 0.f};
        cur = nxt; cA = nA; cB = nB; ++ui;
        if constexpr (ALIGN_EPI) { if (wr == 1) PG8_BAR; }
    }
    PG8_WAIT_V(0);
    if constexpr (!ALIGN_EPI) { if (wr == 0) PG8_BAR; }
    PG8_BAR;
    if constexpr (Epi::AFTER_DRAIN) { E.fused(acc, cur, wr, wc, fr, fq, lds, wid, lane); S.done(cur); }
#undef PG8_SA
#undef PG8_SB
#undef PG8_STAGE
#undef PG8_LDA
#undef PG8_LDB
#undef PG8_MMA
#undef PG8_WAIT_V
#undef PG8_WAIT_L
#undef PG8_BAR
#undef PG8_SCHED
}
}
#ifndef MK_SINGLE
#define MK_SINGLE 1
#endif
#define LAS __attribute__((address_space(3)))
typedef unsigned short bf16;
typedef unsigned v4u __attribute__((ext_vector_type(4)));
typedef unsigned v2u __attribute__((ext_vector_type(2)));
typedef float f32x4 __attribute__((ext_vector_type(4)));
using pg8::sigm; using pg8::silu_; using pg8::tanh_; using pg8::cvt_pk_bf16; using pg8::unpack8; using pg8::pack8; using pg8::cond_of_row;

constexpr int NTOK = 17408, NPR = 16384, DM = 1024, BW = 512, INC = 5888;
constexpr int LDS_BYTES = 147456, MISC_OFF = 144 * 1024 - 1024, TAB_OFF = MISC_OFF + 64;
constexpr size_t MiB = 1u << 20;
constexpr size_t WS_CTL = 0, CTL_BYTES = 65536;
constexpr size_t WS_MOD = 1 * MiB;
constexpr size_t WS_CA = 13 * MiB;
constexpr size_t WS_WIN = 14 * MiB;
constexpr size_t WS_WG = WS_WIN + 5888u * 1024 * 2;
constexpr size_t WS_WB = WS_WG + 8 * MiB;
constexpr size_t WS_WO = WS_WB + 4 * MiB;
constexpr size_t WS_W1 = WS_WO + 2 * MiB;
constexpr size_t WS_W2 = WS_W1 + 8 * MiB;
constexpr size_t WS_H = 56 * MiB;
constexpr size_t WS_BR = 90 * MiB;
constexpr size_t WS_G = 158 * MiB;
constexpr size_t WS_BIG = 192 * MiB;
constexpr size_t WS_SSP = WS_BIG + (size_t)NTOK * INC * 2;
constexpr size_t WS_RST = WS_SSP + (size_t)NTOK * 16 * 4;
constexpr size_t WS_GS = WS_RST + (size_t)NTOK * 32 * 4;
constexpr size_t WS_END = WS_GS + (size_t)(NTOK - NPR) * 4096 * 2;
static_assert(WS_W2 + 8 * MiB <= WS_H, "ws map");
constexpr size_t O_HG_P = 17825792, O_RW_P = 18874368, O_SH_P = 19398656, O_CV_P = 19427328, O_LH_P = 19673088, O_LC_P = 19681280;
constexpr size_t O_HG_S = 19705856, O_RW_S = 36483072, O_SH_S = 44871680, O_CV_S = 45330432, O_LH_S = 49262592, O_LC_S = 49393664;
enum { I_XP = 0, I_XS, I_SHG, I_SRW, I_SSH, I_SCV, I_SLH, I_SLC, I_CP, I_CS, I_ADAW, I_ADAB, I_NMIX, I_NMLP, I_NFIN, I_WIN, I_HGL, I_HGN, I_MU, I_W0, I_WUP, I_A0, I_AUP, I_GUP,
       I_KK, I_KA, I_RK, I_LNG, I_LNB, I_CFDW, I_CFDWB, I_CFLG, I_CFLB, I_LCW, I_LCB, I_LWA, I_LBA, I_LWX, I_LBX, I_LAM, I_WBR, I_WGATE, I_BGATE, I_WOUT, I_WM1, I_WM2 };

struct Args { const float* in[46]; float* out; unsigned char* ws; int ph_lo, ph_hi; };
struct MArgs { float* out; unsigned char* ws; };
extern __shared__ __attribute__((aligned(16))) unsigned char lds_raw[];
__device__ __forceinline__ const float* inp_(int i) {
    const LAS unsigned* t = (const LAS unsigned*)((LAS unsigned char*)lds_raw + TAB_OFF) + 2 * i;
    const unsigned lo = __builtin_amdgcn_readfirstlane(t[0]), hi = __builtin_amdgcn_readfirstlane(t[1]);
    return (const float*)(((unsigned long long)hi << 32) | lo);
}
#define INP(i) inp_(i)

template <int CTRL> __device__ __forceinline__ float dppf(float v) { return __builtin_bit_cast(float, __builtin_amdgcn_update_dpp(0, __builtin_bit_cast(int, v), CTRL, 0xF, 0xF, true)); }
__device__ __forceinline__ float red4(float v) { v += dppf<0xB1>(v); v += dppf<0x4E>(v); return v; }
__device__ __forceinline__ float red8(float v) { v = red4(v); v += dppf<0x141>(v); return v; }
__device__ __forceinline__ float red16(float v) { v = red8(v); v += dppf<0x140>(v); return v; }
__device__ __forceinline__ float wave_sum(float v) {
#pragma unroll
    for (int o = 1; o < 64; o <<= 1) v += __shfl_xor(v, o);
    return v;
}
__device__ __forceinline__ float bf2f(bf16 b) { return __uint_as_float((unsigned)b << 16); }
__device__ __forceinline__ void unpack4(const v2u w, float (&f)[4]) { f[0] = __uint_as_float(w.x << 16); f[1] = __uint_as_float(w.x & 0xffff0000u); f[2] = __uint_as_float(w.y << 16); f[3] = __uint_as_float(w.y & 0xffff0000u); }
__device__ __forceinline__ v2u pack4(float a, float b, float c, float d) { v2u w; w.x = cvt_pk_bf16(a, b); w.y = cvt_pk_bf16(c, d); return w; }
#define LDS_WAIT() asm volatile("s_waitcnt lgkmcnt(0)" ::: "memory")

__device__ __forceinline__ v4u gload16(const void* p) { v4u r; asm volatile("global_load_dwordx4 %0, %1, off" : "=v"(r) : "v"(p) : "memory"); return r; }
__device__ __forceinline__ v2u gload8(const void* p) { v2u r; asm volatile("global_load_dwordx2 %0, %1, off" : "=v"(r) : "v"(p) : "memory"); return r; }
__device__ __forceinline__ unsigned gload4(const void* p) { unsigned r; asm volatile("global_load_dword %0, %1, off" : "=v"(r) : "v"(p) : "memory"); return r; }
#define LDS_BARRIER() asm volatile("s_waitcnt lgkmcnt(0)\n\ts_barrier" ::: "memory")
#define VM_DRAIN_KNOWN() __builtin_amdgcn_s_waitcnt(0x0F70)
__device__ __forceinline__ void tr_item(const float* W, int K, int N, bf16* WT, int ldt, int row_off, int col_off, LAS float* scr, int item, int lane) {
    const int nblk = N / 32, kb = item / nblk, nb = item % nblk, k0 = 64 * kb, n0 = 32 * nb;
#pragma unroll 8
    for (int i = 0; i < 32; ++i) { const int kk = 2 * i + (lane >> 5); scr[kk * 33 + (lane & 31)] = W[(size_t)(k0 + kk) * N + n0 + (lane & 31)]; }
    LDS_WAIT(); asm volatile("" ::: "memory");
    const int c = lane & 7;
#pragma unroll
    for (int j = 0; j < 4; ++j) { const int n = (lane >> 3) + 8 * j; const LAS float* s = scr + (8 * c) * 33 + n;
        v4u o; o.x = cvt_pk_bf16(s[0 * 33], s[1 * 33]); o.y = cvt_pk_bf16(s[2 * 33], s[3 * 33]); o.z = cvt_pk_bf16(s[4 * 33], s[5 * 33]); o.w = cvt_pk_bf16(s[6 * 33], s[7 * 33]);
        *(v4u*)(WT + (size_t)(row_off + n0 + n) * ldt + col_off + k0 + 8 * c) = o; }
    LDS_WAIT(); asm volatile("" ::: "memory");
}

__device__ __forceinline__ void phase_conv_ada(const Args& a, LAS unsigned char* lds, int gw, int NGW, int wave, int lane) {
    LAS float* scr = (LAS float*)(lds + wave * 16384);
    bf16* ADAT = (bf16*)(a.ws + WS_BIG);
    constexpr int IPL = 16 * 192;
    for (int it = gw; it < 2 * IPL; it += NGW) { const int l = it / IPL; tr_item(INP(I_ADAW) + (size_t)l * 1024 * 6144, 1024, 6144, ADAT, 1024, l * 6144, 0, scr, it % IPL, lane); }
    bf16* CA = (bf16*)(a.ws + WS_CA);
    for (int r = gw; r < 256; r += NGW) {
        const float* cp = r < 8 ? INP(I_CP) + r * 1024 : INP(I_CS) + (r - 8) * 1024;
#pragma unroll
        for (int j = 0; j < 4; ++j) { const int c = (lane + 64 * j) * 4; f32x4 v = (f32x4){0.f, 0.f, 0.f, 0.f}; if (r < 136) { v = *(const f32x4*)(cp + c); v[0] = silu_(v[0]); v[1] = silu_(v[1]); v[2] = silu_(v[2]); v[3] = silu_(v[3]); }
            *(v2u*)(CA + r * 1024 + c) = pack4(v[0], v[1], v[2], v[3]); }
    }
}
__device__ __forceinline__ void phase_conv_layer(const Args& a, int l, LAS unsigned char* lds, int gw, int NGW, int wave, int lane, int it_lo, int it_hi) {
    LAS float* scr = (LAS float*)(lds + wave * 16384);
    constexpr int I_IN = 16 * 184, I_G = 16 * 128, I_B = 4 * 256, I_O = 16 * 32, I_1 = 16 * 128, I_2 = 64 * 32, NIT = I_IN + I_G + I_B + I_O + I_1 + I_2;
    static_assert(NIT == 10624 && NIT - I_2 == 8576, "item map");
    for (int it = it_lo + gw; it < it_hi; it += NGW) {
        int r = it;
        if (r < I_IN) { tr_item(INP(I_WIN) + (size_t)l * 1024 * 5888, 1024, 5888, (bf16*)(a.ws + WS_WIN), 1024, 0, 0, scr, r, lane); continue; } r -= I_IN;
        if (r < I_G) { tr_item(INP(I_WGATE) + (size_t)l * 1024 * 4096, 1024, 4096, (bf16*)(a.ws + WS_WG), 1024, 0, 0, scr, r, lane); continue; } r -= I_G;
        if (r < I_B) { const int k = r >> 8; tr_item(INP(I_WBR) + (size_t)(l * 4 + k) * 512 * 1024, 512, 1024, (bf16*)(a.ws + WS_WB), 2048, 0, k * 512, scr, r & 255, lane); continue; } r -= I_B;
        if (r < I_O) { tr_item(INP(I_WOUT) + (size_t)l * 1024 * 1024, 1024, 1024, (bf16*)(a.ws + WS_WO), 1024, 0, 0, scr, r, lane); continue; } r -= I_O;
        if (r < I_1) { tr_item(INP(I_WM1) + (size_t)l * 1024 * 4096, 1024, 4096, (bf16*)(a.ws + WS_W1), 1024, 0, 0, scr, r, lane); continue; } r -= I_1;
        tr_item(INP(I_WM2) + (size_t)l * 4096 * 1024, 4096, 1024, (bf16*)(a.ws + WS_W2), 4096, 0, 0, scr, r, lane);
    }
}
__device__ __forceinline__ void phase_norm(const Args& a, int l, int sel, int gw, int NGW, int lane, int row_lo = 0, int row_hi = NTOK) {
    const float* MOD = (const float*)(a.ws + WS_MOD); bf16* H = (bf16*)(a.ws + WS_H);
    const float* gn = (sel == 0 ? INP(I_NMIX) : INP(I_NMLP)) + l * 1024;
    for (int row = row_lo + gw; row < row_hi; row += NGW) {
        const float* xr = (l == 0 && sel == 0) ? (row < NPR ? INP(I_XP) + (size_t)row * 1024 : INP(I_XS) + (size_t)(row - NPR) * 1024) : a.out + (size_t)row * 1024;
        f32x4 v[4]; float ss = 0.f;
#pragma unroll
        for (int j = 0; j < 4; ++j) { v[j] = *(const f32x4*)(xr + (lane + 64 * j) * 4); ss += (v[j][0] * v[j][0] + v[j][1] * v[j][1]) + (v[j][2] * v[j][2] + v[j][3] * v[j][3]); }
        const float rstd = rsqrtf(wave_sum(ss) * (1.f / 1024.f) + 1e-6f);
        const float* mp = MOD + (size_t)cond_of_row(row) * 12288 + l * 6144 + sel * 3072;
#pragma unroll
        for (int j = 0; j < 4; ++j) { const int c = (lane + 64 * j) * 4; const f32x4 g = *(const f32x4*)(gn + c), sh = *(const f32x4*)(mp + c), sc = *(const f32x4*)(mp + 1024 + c);
            float o[4];
#pragma unroll
            for (int i = 0; i < 4; ++i) o[i] = v[j][i] * rstd * g[i] * (1.f + sc[i]) + sh[i];
            *(v2u*)(H + (size_t)row * 1024 + c) = pack4(o[0], o[1], o[2], o[3]); }
    }
}
__device__ __forceinline__ void phase_final(const Args& a, int gw, int NGW, int lane) {
    const float* gn = INP(I_NFIN);
    for (int row = gw; row < NTOK; row += NGW) {
        float* xr = a.out + (size_t)row * 1024;
        f32x4 v[4]; float ss = 0.f;
#pragma unroll
        for (int j = 0; j < 4; ++j) { v[j] = *(const f32x4*)(xr + (lane + 64 * j) * 4); ss += (v[j][0] * v[j][0] + v[j][1] * v[j][1]) + (v[j][2] * v[j][2] + v[j][3] * v[j][3]); }
        const float rstd = rsqrtf(wave_sum(ss) * (1.f / 1024.f) + 1e-6f);
#pragma unroll
        for (int j = 0; j < 4; ++j) { const int c = (lane + 64 * j) * 4; const f32x4 g = *(const f32x4*)(gn + c);
            *(f32x4*)(xr + c) = (f32x4){v[j][0] * rstd * g[0], v[j][1] * rstd * g[1], v[j][2] * rstd * g[2], v[j][3] * rstd * g[3]}; }
    }
}
__device__ __forceinline__ void phase_hg_post(const Args& a, int gw, int NGW, int lane) {
    bf16* BR = (bf16*)(a.ws + WS_BR); const float* SSP = (const float*)(a.ws + WS_SSP); const float* RST = (const float*)(a.ws + WS_RST); const bf16* GC = (const bf16*)(a.ws + WS_G);
    for (int row = gw; row < NTOK; row += NGW) {
        { const int h = lane >> 4; const f32x4 s4 = *(const f32x4*)(SSP + (size_t)row * 16 + h * 4);
          const float rstd = rsqrtf(((s4[0] + s4[1]) + (s4[2] + s4[3])) * (1.f / 128.f) + 1e-6f);
          bf16* p = BR + (size_t)row * 2048 + lane * 8; float v[8]; unpack8(*(const v4u*)p, v);
#pragma unroll
          for (int j = 0; j < 8; ++j) v[j] *= rstd;
          *(v4u*)p = pack8(v); }
        { const int h = lane >> 3; const f32x4 s4 = *(const f32x4*)(RST + (size_t)row * 32 + h * 4);
          const float mean = (s4[0] + s4[2]) * (1.f / 64.f), var = fmaxf((s4[1] + s4[3]) * (1.f / 64.f) - mean * mean, 0.f), rstd = rsqrtf(var + 64e-5f);
          bf16* p = BR + (size_t)row * 2048 + 512 + lane * 8; float y[8], c1[8], c2[8]; unpack8(*(const v4u*)p, y);
          unpack8(*(const v4u*)(GC + (size_t)row * 1024 + lane * 8), c1); unpack8(*(const v4u*)(GC + (size_t)row * 1024 + 512 + lane * 8), c2);
#pragma unroll
          for (int j = 0; j < 8; ++j) y[j] = (y[j] - mean) * rstd * c1[j] + c2[j];
          *(v4u*)p = pack8(y); }
    }
}

#define SEQ_SETUP const bool smp = seq >= 8; const int T = smp ? 8 : 2048; const int row0 = smp ? NPR + (seq - 8) * 8 : seq * 2048; const int bs = seq - 8; \
    const int Bg = smp ? 128 : 8; const int bo = smp ? bs : seq; (void)Bg; (void)bo; (void)bs;

typedef float f32x2 __attribute__((ext_vector_type(2)));
struct HgVec { f32x4 q0, q1, k0, k1, v4; };
__device__ __forceinline__ void hg_load(HgVec& X, const LAS float* b, const LAS float* pv) {
    X.q0 = *(const LAS f32x4*)b; X.q1 = *(const LAS f32x4*)(b + 4); X.k0 = *(const LAS f32x4*)(b + 8192); X.k1 = *(const LAS f32x4*)(b + 8192 + 4); X.v4 = *(const LAS f32x4*)pv;
}
__device__ __forceinline__ float hg_step1(f32x2 (&s)[4], const HgVec& X, float vv) {
    const f32x2 v2 = {vv, vv};
    s[0] = s[0] + X.k0.lo * (v2 - s[0]); s[1] = s[1] + X.k0.hi * (v2 - s[1]); s[2] = s[2] + X.k1.lo * (v2 - s[2]); s[3] = s[3] + X.k1.hi * (v2 - s[3]);
    f32x2 o = s[0] * X.q0.lo; o = s[1] * X.q0.hi + o; f32x2 p = s[2] * X.q1.lo; p = s[3] * X.q1.hi + p; o = o + p;
    return red16(o.x + o.y);
}
struct HgPre { v4u q, k, v; v2u og; };
#define HG_PF_WAIT(P) asm volatile("s_waitcnt vmcnt(0)" : "+v"(P.q), "+v"(P.k), "+v"(P.v), "+v"(P.og) :: "memory")
__device__ __forceinline__ void hg_prefetch(HgPre& P, const bf16* PROJ, int rowc, int tleft, int tid, int h, int vh) {
    const int t = tid >> 4;
    if (t < tleft) { const bf16* p = PROJ + (size_t)(rowc + t) * INC + h * 128; P.q = gload16(p + (tid & 15) * 8); P.k = gload16(p + 512 + (tid & 15) * 8); P.og = gload8(p + 1536 + vh * 64 + (tid & 15) * 4); }
    if (tid < 256 && (tid >> 3) < tleft) P.v = gload16(PROJ + (size_t)(rowc + (tid >> 3)) * INC + 1024 + h * 128 + vh * 64 + (tid & 7) * 8);
}
__device__ __forceinline__ void hg_unit(LAS unsigned char* lds, const MArgs& a, int tid_in, int l, int seq, int h, int vh, int mode) {
    SEQ_SETUP
    const int tid = tid_in, ds = tid & 15, v = ((tid >> 4) & 15) * 4;
    const bf16* PROJ = (const bf16*)(a.ws + WS_BIG); bf16* BR = (bf16*)(a.ws + WS_BR); float* SSP = (float*)(a.ws + WS_SSP);
    LAS float* SQ = (LAS float*)lds; LAS float* SK = SQ + 8192; LAS float* SV = SK + 8192; LAS float* SO = SV + 4096;
    HgPre P0, P1; P0.q = (v4u){0u, 0u, 0u, 0u}; P0.k = P0.q; P0.v = P0.q; P0.og = (v2u){0u, 0u}; P1 = P0;
    hg_prefetch(P0, PROJ, row0, T, tid, h, vh); hg_prefetch(P1, PROJ, row0 + 32, T - 32, tid, h, vh);
    f32x2 sc[4][4];
    if (smp && tid < 256) { const float* sp = INP(I_SHG) + ((size_t)(l * 128 + bs) * 4 + h) * 16384 + vh * 64 + v;
#pragma unroll
        for (int j = 0; j < 4; ++j) { const f32x4 x0 = *(const f32x4*)(sp + (ds * 8 + 2 * j) * 128), x1 = *(const f32x4*)(sp + (ds * 8 + 2 * j + 1) * 128);
#pragma unroll
            for (int c = 0; c < 4; ++c) sc[c][j] = (f32x2){x0[c], x1[c]}; } }
    else {
#pragma unroll
        for (int c = 0; c < 4; ++c)
#pragma unroll
            for (int j = 0; j < 4; ++j) sc[c][j] = (f32x2){0.f, 0.f}; }
    const f32x4 hg4 = *(const f32x4*)(INP(I_HGN) + l * 512 + h * 128 + vh * 64 + (tid & 15) * 4);
    VM_DRAIN_KNOWN();
    HG_PF_WAIT(P0); HG_PF_WAIT(P1);
    for (int t0 = 0; t0 < T; t0 += 64) {
        const int tc = (T - t0) < 64 ? (T - t0) : 64;
        const HgPre C0 = P0, C1 = P1;
        if (!(mode & 4)) {
#pragma unroll
          for (int hh = 0; hh < 2; ++hh) { const HgPre& C = hh ? C1 : C0; const int t = (tid >> 4) + 32 * hh, d8 = (tid & 15) * 8;
            if (t < tc) { float q[8], k[8]; unpack8(C.q, q); unpack8(C.k, k);
              *(LAS f32x4*)(SQ + t * 128 + d8) = (f32x4){q[0], q[1], q[2], q[3]}; *(LAS f32x4*)(SQ + t * 128 + d8 + 4) = (f32x4){q[4], q[5], q[6], q[7]};
              *(LAS f32x4*)(SK + t * 128 + d8) = (f32x4){k[0], k[1], k[2], k[3]}; *(LAS f32x4*)(SK + t * 128 + d8 + 4) = (f32x4){k[4], k[5], k[6], k[7]}; }
            if (tid < 256) { const int t2 = (tid >> 3) + 32 * hh, c8 = (tid & 7) * 8;
              if (t2 < tc) { float x[8]; unpack8(C.v, x);
                  *(LAS f32x4*)(SV + t2 * 64 + c8) = (f32x4){x[0], x[1], x[2], x[3]}; *(LAS f32x4*)(SV + t2 * 64 + c8 + 4) = (f32x4){x[4], x[5], x[6], x[7]}; } } } }
        if (t0 + 64 < T) { hg_prefetch(P0, PROJ, row0 + t0 + 64, T - t0 - 64, tid, h, vh); hg_prefetch(P1, PROJ, row0 + t0 + 96, T - t0 - 96, tid, h, vh); }
        LDS_BARRIER();
        if (tid < 256 && !(mode & 2)) { const LAS float* bq = SQ + ds * 8; const LAS float* pv = SV + v;
          HgVec A, B; hg_load(A, bq, pv);
          for (int t = 0; t < tc; t += 2) {
              hg_load(B, bq + (t + 1) * 128, pv + (t + 1) * 64);
              { const f32x4 o = {hg_step1(sc[0], A, A.v4[0]), hg_step1(sc[1], A, A.v4[1]), hg_step1(sc[2], A, A.v4[2]), hg_step1(sc[3], A, A.v4[3])}; if (ds == 0) *(LAS f32x4*)(SO + t * 64 + v) = o; }
              if (t + 2 < tc) hg_load(A, bq + (t + 2) * 128, pv + (t + 2) * 64);
              { const f32x4 o = {hg_step1(sc[0], B, B.v4[0]), hg_step1(sc[1], B, B.v4[1]), hg_step1(sc[2], B, B.v4[2]), hg_step1(sc[3], B, B.v4[3])}; if (ds == 0) *(LAS f32x4*)(SO + (t + 1) * 64 + v) = o; }
          } }
        LDS_BARRIER();
#pragma unroll
        for (int hh = 0; hh < 2; ++hh) { const HgPre& C = hh ? C1 : C0; const int t = (tid >> 4) + 32 * hh, c4 = (tid & 15) * 4;
          if (t < tc && !(mode & 1)) { const int row = row0 + t0 + t; const f32x4 o4 = *(const LAS f32x4*)(SO + t * 64 + c4);
              const float ssq = red8((o4[0] * o4[0] + o4[1] * o4[1]) + (o4[2] * o4[2] + o4[3] * o4[3]));
              if ((tid & 7) == 0) SSP[(size_t)row * 16 + h * 4 + vh * 2 + ((tid & 15) >> 3)] = ssq;
              float g[4]; unpack4(C.og, g);
              *(v2u*)(BR + (size_t)row * 2048 + h * 128 + vh * 64 + c4) = pack4(o4[0] * g[0] * hg4[0], o4[1] * g[1] * hg4[1], o4[2] * g[2] * hg4[2], o4[3] * g[3] * hg4[3]); } }
        HG_PF_WAIT(P0); HG_PF_WAIT(P1);
    }
    if (tid < 256 && !(mode & 1)) { float* so = a.out + (smp ? O_HG_S : O_HG_P) + ((size_t)(l * Bg + bo) * 4 + h) * 16384 + vh * 64 + v;
#pragma unroll
        for (int j = 0; j < 4; ++j) { *(f32x4*)(so + (ds * 8 + 2 * j) * 128) = (f32x4){sc[0][j].x, sc[1][j].x, sc[2][j].x, sc[3][j].x}; *(f32x4*)(so + (ds * 8 + 2 * j + 1) * 128) = (f32x4){sc[0][j].y, sc[1][j].y, sc[2][j].y, sc[3][j].y}; } }
    __syncthreads();
}

struct RwPre { v4u lc0, lc1, lp0, lp1; v2u rc, kc, vc, rp, kp, vp; };
__device__ __forceinline__ void rwkv_prefetch(RwPre& P, const bf16* PROJ, const float* shs, bool smp, int row0, int tg, int sub, int hc) {
    const bf16* pc = PROJ + (size_t)(row0 + tg) * INC + 2048;
    P.lc0 = gload16(pc + 1536 + sub * 16); P.lc1 = gload16(pc + 1536 + sub * 16 + 8);
    P.rc = gload8(pc + hc); P.kc = gload8(pc + 512 + hc); P.vc = gload8(pc + 1024 + hc);
    if (tg > 0) { P.lp0 = gload16(pc - INC + 1536 + sub * 16); P.lp1 = gload16(pc - INC + 1536 + sub * 16 + 8);
        P.rp = gload8(pc - INC + hc); P.kp = gload8(pc - INC + 512 + hc); P.vp = gload8(pc - INC + 1024 + hc); }
    else if (smp) {
        const float* q = shs + 1536 + sub * 16; float t8[8];
#pragma unroll
        for (int i = 0; i < 8; ++i) t8[i] = q[i];
        P.lp0 = pack8(t8);
#pragma unroll
        for (int i = 0; i < 8; ++i) t8[i] = q[8 + i];
        P.lp1 = pack8(t8);
        P.rp = pack4(shs[hc], shs[hc + 1], shs[hc + 2], shs[hc + 3]); P.kp = pack4(shs[512 + hc], shs[512 + hc + 1], shs[512 + hc + 2], shs[512 + hc + 3]);
        P.vp = pack4(shs[1024 + hc], shs[1024 + hc + 1], shs[1024 + hc + 2], shs[1024 + hc + 3]); }
    else { P.lp0 = (v4u){0u, 0u, 0u, 0u}; P.lp1 = P.lp0; P.rp = (v2u){0u, 0u}; P.kp = P.rp; P.vp = P.rp; }
}
#define RW_PF_WAIT(P) asm volatile("s_waitcnt vmcnt(0)" : "+v"(P.lc0), "+v"(P.lc1), "+v"(P.lp0), "+v"(P.lp1), "+v"(P.rc), "+v"(P.kc), "+v"(P.vc), "+v"(P.rp), "+v"(P.kp), "+v"(P.vp) :: "memory")
struct RwVec { f32x4 r, w, k, q, e; f32x2 vv; };
__device__ __forceinline__ void rw_load(RwVec& X, const LAS float* b, const LAS float* pv) {
    X.r = *(const LAS f32x4*)b; X.w = *(const LAS f32x4*)(b + 2048); X.k = *(const LAS f32x4*)(b + 4096); X.q = *(const LAS f32x4*)(b + 6144); X.e = *(const LAS f32x4*)(b + 8192); X.vv = *(const LAS f32x2*)pv;
}
__device__ __forceinline__ f32x2 rw_step2(f32x2 (&s0)[2], f32x2 (&s1)[2], const RwVec& X) {
    f32x2 a0 = s0[0] * X.q.lo; a0 = s0[1] * X.q.hi + a0; f32x2 a1 = s1[0] * X.q.lo; a1 = s1[1] * X.q.hi + a1;
    const float sa0 = -red16(a0.x + a0.y), sa1 = -red16(a1.x + a1.y);
    const f32x2 p0 = {sa0, sa0}, p1 = {sa1, sa1}, v0 = {X.vv.x, X.vv.x}, v1 = {X.vv.y, X.vv.y};
    s0[0] = s0[0] * X.w.lo + (p0 * X.e.lo + v0 * X.k.lo); s0[1] = s0[1] * X.w.hi + (p0 * X.e.hi + v0 * X.k.hi);
    s1[0] = s1[0] * X.w.lo + (p1 * X.e.lo + v1 * X.k.lo); s1[1] = s1[1] * X.w.hi + (p1 * X.e.hi + v1 * X.k.hi);
    f32x2 y0 = s0[0] * X.r.lo; y0 = s0[1] * X.r.hi + y0; f32x2 y1 = s1[0] * X.r.lo; y1 = s1[1] * X.r.hi + y1;
    return (f32x2){red16(y0.x + y0.y), red16(y1.x + y1.y)};
}
__device__ __forceinline__ void rwkv_unit(LAS unsigned char* lds, const MArgs& a, int tid_in, int l, int seq, int h, int half, int mode) {
    SEQ_SETUP
    const int tid = tid_in, lane = tid & 63, wave = __builtin_amdgcn_readfirstlane(tid >> 6);
    const bf16* PROJ = (const bf16*)(a.ws + WS_BIG); bf16* BR = (bf16*)(a.ws + WS_BR);
    LAS bf16* WUPT = (LAS bf16*)(lds + 65664); LAS bf16* AUPT = WUPT + 64 * 72; LAS bf16* GUPT = AUPT + 64 * 72;
    LAS bf16* LRB = (LAS bf16*)(lds + 65664 + 35840);
    LAS float* LWA = (LAS float*)(lds + 65664 + 52736);
    LAS float* SR = (LAS float*)(lds + 0); LAS float* SW = SR + 2048; LAS float* SK = SW + 2048; LAS float* SKK = SK + 2048; LAS float* SKA = SKK + 2048;
    LAS float* SV = SKA + 2048; LAS float* SG = SV + 2048; LAS float* SY = SG + 2048; LAS float* SB = SY + 2048;
    const int st = tid >> 4, sub = tid & 15, c4 = sub * 4, hc = h * 64 + c4;
    const float* mu = INP(I_MU) + l * 1792;
    const float* shs = INP(I_SSH) + (size_t)(l * 128 + (smp ? bs : 0)) * 1792;
    RwPre P;
    P.lc0 = (v4u){0u, 0u, 0u, 0u}; P.lc1 = P.lc0; P.lp0 = P.lc0; P.lp1 = P.lc0; P.rc = (v2u){0u, 0u}; P.kc = P.rc; P.vc = P.rc; P.rp = P.rc; P.kp = P.rc; P.vp = P.rc;
    if (st < T) rwkv_prefetch(P, PROJ, shs, smp, row0, st, sub, hc);
    RW_PF_WAIT(P);
    { const int j = tid >> 3, c8 = (tid & 7) * 8;
      const float* p = INP(I_WUP) + ((size_t)l * 64 + j) * 512 + h * 64 + c8; f32x4 x0 = *(const f32x4*)p, x1 = *(const f32x4*)(p + 4);
#pragma unroll
      for (int i = 0; i < 4; ++i) { WUPT[(c8 + i) * 72 + j] = (bf16)(cvt_pk_bf16(x0[i], 0.f) & 0xffffu); WUPT[(c8 + 4 + i) * 72 + j] = (bf16)(cvt_pk_bf16(x1[i], 0.f) & 0xffffu); }
      p = INP(I_AUP) + ((size_t)l * 64 + j) * 512 + h * 64 + c8; x0 = *(const f32x4*)p; x1 = *(const f32x4*)(p + 4);
#pragma unroll
      for (int i = 0; i < 4; ++i) { AUPT[(c8 + i) * 72 + j] = (bf16)(cvt_pk_bf16(x0[i], 0.f) & 0xffffu); AUPT[(c8 + 4 + i) * 72 + j] = (bf16)(cvt_pk_bf16(x1[i], 0.f) & 0xffffu); }
#pragma unroll
      for (int r = 0; r < 2; ++r) { const int jj = j + 64 * r; p = INP(I_GUP) + ((size_t)l * 128 + jj) * 512 + h * 64 + c8; x0 = *(const f32x4*)p; x1 = *(const f32x4*)(p + 4);
#pragma unroll
          for (int i = 0; i < 4; ++i) { GUPT[(c8 + i) * 136 + jj] = (bf16)(cvt_pk_bf16(x0[i], 0.f) & 0xffffu); GUPT[(c8 + 4 + i) * 136 + jj] = (bf16)(cvt_pk_bf16(x1[i], 0.f) & 0xffffu); } } }
    const bool both = smp;
    const int hsel = both ? (tid >> 8) : half;
    const int sv = hsel * 32 + ((tid >> 4) & 15) * 2, ks = tid & 15;
    f32x2 s0[2], s1[2];
    if (smp) { const float* sp = INP(I_SRW) + ((size_t)(l * 128 + bs) * 8 + h) * 4096 + sv * 64 + ks * 4; const f32x4 x0 = *(const f32x4*)sp, x1 = *(const f32x4*)(sp + 64);
        s0[0] = x0.lo; s0[1] = x0.hi; s1[0] = x1.lo; s1[1] = x1.hi; }
    else { s0[0] = (f32x2){0.f, 0.f}; s0[1] = s0[0]; s1[0] = s0[0]; s1[1] = s0[0]; }
    f32x4 pw0, pa0, pkk, pka, prk, plg, plb;
    { pw0 = *(const f32x4*)(INP(I_W0) + l * 512 + hc); pa0 = *(const f32x4*)(INP(I_A0) + l * 512 + hc); pkk = *(const f32x4*)(INP(I_KK) + l * 512 + hc); pka = *(const f32x4*)(INP(I_KA) + l * 512 + hc);
      prk = *(const f32x4*)(INP(I_RK) + l * 512 + hc); plg = *(const f32x4*)(INP(I_LNG) + l * 512 + hc); plb = *(const f32x4*)(INP(I_LNB) + l * 512 + hc); }
    VM_DRAIN_KNOWN();
    for (int t0 = 0; t0 < T; t0 += 32) {
        const int tc = (T - t0) < 32 ? (T - t0) : 32;
        const int grow = row0 + t0 + st;
        const RwPre C = P;
        if (st < tc && !(mode & 4)) { const int j0 = sub * 16;
#pragma unroll
            for (int hh = 0; hh < 2; ++hh) { float xc[8], xp[8]; unpack8(hh ? C.lc1 : C.lc0, xc); unpack8(hh ? C.lp1 : C.lp0, xp);
                const f32x4 m0 = *(const f32x4*)(mu + 1536 + j0 + 8 * hh), m1 = *(const f32x4*)(mu + 1536 + j0 + 8 * hh + 4);
                float o[8];
#pragma unroll
                for (int i = 0; i < 8; ++i) { float x = xc[i] + (xp[i] - xc[i]) * (i < 4 ? m0[i] : m1[i - 4]); o[i] = j0 < 64 ? tanh_(x) : (j0 < 128 ? x : sigm(x)); }
                *(LAS v4u*)(LRB + st * 264 + j0 + 8 * hh) = pack8(o); } }
        LDS_BARRIER();
        { const int mt = wave >> 2, nt = wave & 3, fr = lane & 15, fq = lane >> 4;
          if (mt * 16 < tc && !(mode & 4)) {
              f32x4 cw = {0.f, 0.f, 0.f, 0.f}, ca = {0.f, 0.f, 0.f, 0.f}, cgt = {0.f, 0.f, 0.f, 0.f};
              const LAS bf16* ar = LRB + (mt * 16 + fr) * 264 + fq * 8;
#pragma unroll
              for (int kk = 0; kk < 2; ++kk) {
                  cw = __builtin_amdgcn_mfma_f32_16x16x32_bf16(*(const LAS pg8::bf16x8*)(ar + kk * 32), *(const LAS pg8::bf16x8*)(WUPT + (nt * 16 + fr) * 72 + kk * 32 + fq * 8), cw, 0, 0, 0);
                  ca = __builtin_amdgcn_mfma_f32_16x16x32_bf16(*(const LAS pg8::bf16x8*)(ar + 64 + kk * 32), *(const LAS pg8::bf16x8*)(AUPT + (nt * 16 + fr) * 72 + kk * 32 + fq * 8), ca, 0, 0, 0); }
#pragma unroll
              for (int kk = 0; kk < 4; ++kk)
                  cgt = __builtin_amdgcn_mfma_f32_16x16x32_bf16(*(const LAS pg8::bf16x8*)(ar + 128 + kk * 32), *(const LAS pg8::bf16x8*)(GUPT + (nt * 16 + fr) * 136 + kk * 32 + fq * 8), cgt, 0, 0, 0);
#pragma unroll
              for (int j = 0; j < 4; ++j) { const int o = (mt * 16 + fq * 4 + j) * 64 + nt * 16 + fr; LWA[o] = cw[j]; LWA[2048 + o] = ca[j]; LWA[4096 + o] = cgt[j]; } } }
        LDS_BARRIER();
        if (st < tc && !(mode & 4)) {
            const f32x4 lw = *(const LAS f32x4*)(LWA + st * 64 + c4), la = *(const LAS f32x4*)(LWA + 2048 + st * 64 + c4), lg = *(const LAS f32x4*)(LWA + 4096 + st * 64 + c4);
            float r4[4], k4[4], v4[4];
            { float rc[4], kc[4], vc[4], rp[4], kp[4], vp[4]; unpack4(C.rc, rc); unpack4(C.kc, kc); unpack4(C.vc, vc); unpack4(C.rp, rp); unpack4(C.kp, kp); unpack4(C.vp, vp);
              const f32x4 mr = *(const f32x4*)(mu + hc), mk = *(const f32x4*)(mu + 512 + hc), mv = *(const f32x4*)(mu + 1024 + hc);
#pragma unroll
              for (int i = 0; i < 4; ++i) { r4[i] = rc[i] + (rp[i] - rc[i]) * mr[i]; k4[i] = kc[i] + (kp[i] - kc[i]) * mk[i]; v4[i] = vc[i] + (vp[i] - vc[i]) * mv[i]; } }
            float wd[4], av[4], kkr[4]; float ssq = 0.f;
#pragma unroll
            for (int i = 0; i < 4; ++i) { wd[i] = __expf(-0.606531f * sigm(pw0[i] + lw[i])); av[i] = sigm(pa0[i] + la[i]); kkr[i] = k4[i] * pkk[i]; ssq += kkr[i] * kkr[i]; }
            ssq = red16(ssq); const float inv = 1.f / fmaxf(sqrtf(ssq), 1e-12f);
            float bon = 0.f; float k2[4], kkv[4], kav[4];
#pragma unroll
            for (int i = 0; i < 4; ++i) { kkv[i] = kkr[i] * inv; k2[i] = k4[i] * (1.f + (av[i] - 1.f) * pka[i]); kav[i] = kkv[i] * av[i]; bon += r4[i] * k2[i] * prk[i]; }
            *(LAS f32x4*)(SR + st * 64 + c4) = (f32x4){r4[0], r4[1], r4[2], r4[3]}; *(LAS f32x4*)(SW + st * 64 + c4) = (f32x4){wd[0], wd[1], wd[2], wd[3]};
            *(LAS f32x4*)(SK + st * 64 + c4) = (f32x4){k2[0], k2[1], k2[2], k2[3]}; *(LAS f32x4*)(SKK + st * 64 + c4) = (f32x4){kkv[0], kkv[1], kkv[2], kkv[3]};
            *(LAS f32x4*)(SKA + st * 64 + c4) = (f32x4){kav[0], kav[1], kav[2], kav[3]}; *(LAS f32x4*)(SV + st * 64 + c4) = (f32x4){v4[0], v4[1], v4[2], v4[3]};
            *(LAS f32x4*)(SG + st * 64 + c4) = lg;
            bon = red16(bon); if (sub == 0) SB[st] = bon;
        }
        if (t0 + 32 + st < T) rwkv_prefetch(P, PROJ, shs, smp, row0, t0 + 32 + st, sub, hc);
        LDS_BARRIER();
        if ((both || tid < 256) && !(mode & 2)) { const LAS float* b0 = SR + ks * 4; const LAS float* pv = SV + sv;
          RwVec A, B; rw_load(A, b0, pv);
          for (int t = 0; t < tc; t += 2) {
              rw_load(B, b0 + (t + 1) * 64, pv + (t + 1) * 64);
              const f32x2 ya = rw_step2(s0, s1, A);
              if (ks == 0) *(LAS f32x2*)(SY + t * 64 + sv) = ya;
              if (t + 2 < tc) rw_load(A, b0 + (t + 2) * 64, pv + (t + 2) * 64);
              const f32x2 yb = rw_step2(s0, s1, B);
              if (ks == 0) *(LAS f32x2*)(SY + (t + 1) * 64 + sv) = yb;
          } }
        RW_PF_WAIT(P);
        LDS_BARRIER();
        if (st < tc && (both || (sub >> 3) == half) && !(mode & 1)) {
            const f32x4 y4 = *(const LAS f32x4*)(SY + st * 64 + c4);
            const float sy = red8((y4[0] + y4[1]) + (y4[2] + y4[3])), sq = red8((y4[0] * y4[0] + y4[1] * y4[1]) + (y4[2] * y4[2] + y4[3] * y4[3]));
            if ((sub & 7) == 0) *(f32x2*)((float*)(a.ws + WS_RST) + (size_t)grow * 32 + h * 4 + (sub >> 3) * 2) = (f32x2){sy, sq};
            const float bon = SB[st];
            const f32x4 vv4 = *(const LAS f32x4*)(SV + st * 64 + c4), gg4 = *(const LAS f32x4*)(SG + st * 64 + c4);
            float c1[4], c2[4];
#pragma unroll
            for (int i = 0; i < 4; ++i) { c1[i] = plg[i] * gg4[i]; c2[i] = (plb[i] + bon * vv4[i]) * gg4[i]; }
            *(v2u*)(BR + (size_t)grow * 2048 + 512 + hc) = pack4(y4[0], y4[1], y4[2], y4[3]);
            bf16* GC = (bf16*)(a.ws + WS_G) + (size_t)grow * 1024;
            *(v2u*)(GC + hc) = pack4(c1[0], c1[1], c1[2], c1[3]); *(v2u*)(GC + 512 + hc) = pack4(c2[0], c2[1], c2[2], c2[3]);
        }
    }
    if ((both || tid < 256) && !(mode & 1)) { float* so = a.out + (smp ? O_RW_S : O_RW_P) + ((size_t)(l * Bg + bo) * 8 + h) * 4096 + sv * 64 + ks * 4;
      *(f32x4*)so = (f32x4){s0[0].x, s0[0].y, s0[1].x, s0[1].y}; *(f32x4*)(so + 64) = (f32x4){s1[0].x, s1[0].y, s1[1].x, s1[1].y}; }
    { float* sh = a.out + (smp ? O_SH_S : O_SH_P) + (size_t)(l * Bg + bo) * 1792; const bf16* pl = PROJ + (size_t)(row0 + T - 1) * INC + 2048;
      if ((both || half == 0) && tid < 64 && !(mode & 1)) { sh[h * 64 + tid] = bf2f(pl[h * 64 + tid]); sh[512 + h * 64 + tid] = bf2f(pl[512 + h * 64 + tid]); sh[1024 + h * 64 + tid] = bf2f(pl[1024 + h * 64 + tid]); }
      if ((both || half == 0) && h == 0 && tid >= 256 && !(mode & 1)) sh[1536 + tid - 256] = bf2f(pl[1536 + tid - 256]); }
    __syncthreads();
}

__device__ __forceinline__ void rw_load16(RwVec& X, const LAS float* b, const LAS float* pv) {
    X.r = *(const LAS f32x4*)b; X.w = *(const LAS f32x4*)(b + 1024); X.k = *(const LAS f32x4*)(b + 2048); X.q = *(const LAS f32x4*)(b + 3072); X.e = *(const LAS f32x4*)(b + 4096); X.vv = *(const LAS f32x2*)pv;
}
#define RW_SCAN16(TLO, THI) do { const LAS float* b0_ = Sc + ks * 4; const LAS float* pv_ = Sc + 5120 + sv; LAS float* sy_ = SY + (c & 1) * 1024 + sv; \
        RwVec A_, B_; rw_load16(A_, b0_ + (TLO) * 64, pv_ + (TLO) * 64); \
        for (int t = (TLO); t < (THI); t += 2) { rw_load16(B_, b0_ + (t + 1) * 64, pv_ + (t + 1) * 64); \
            const f32x2 ya_ = rw_step2(s0, s1, A_); if (ks == 0) *(LAS f32x2*)(sy_ + t * 64) = ya_; \
            if (t + 2 < (THI)) rw_load16(A_, b0_ + (t + 2) * 64, pv_ + (t + 2) * 64); \
            const f32x2 yb_ = rw_step2(s0, s1, B_); if (ks == 0) *(LAS f32x2*)(sy_ + (t + 1) * 64) = yb_; } } while (0)
__device__ __forceinline__ void rwkv_unit_pc(LAS unsigned char* lds, const MArgs& a, int tid_in, int l, int seq, int h, int half) {
    constexpr int T = 2048, NC = T / 16;
    const int row0 = seq * 2048;
    const int tid = tid_in, lane = tid & 63, wave = __builtin_amdgcn_readfirstlane(tid >> 6);
    const bool prod = wave >= 4;
    const bf16* PROJ = (const bf16*)(a.ws + WS_BIG); bf16* BR = (bf16*)(a.ws + WS_BR);
    LAS float* SS = (LAS float*)lds;
    LAS float* SY = (LAS float*)(lds + 57344);
    LAS float* SB = (LAS float*)(lds + 65536);
    LAS bf16* WUPT = (LAS bf16*)(lds + 65664); LAS bf16* AUPT = WUPT + 64 * 72; LAS bf16* GUPT = AUPT + 64 * 72;
    LAS bf16* LRB = (LAS bf16*)(lds + 101504);
    LAS float* LWA = (LAS float*)(lds + 109952);
    const int st = (tid & 255) >> 4, sub = tid & 15, c4 = sub * 4, hc = h * 64 + c4;
    const float* mu = INP(I_MU) + l * 1792;
    RwPre P;
    P.lc0 = (v4u){0u, 0u, 0u, 0u}; P.lc1 = P.lc0; P.lp0 = P.lc0; P.lp1 = P.lc0; P.rc = (v2u){0u, 0u}; P.kc = P.rc; P.vc = P.rc; P.rp = P.rc; P.kp = P.rc; P.vp = P.rc;
    if (prod) { rwkv_prefetch(P, PROJ, mu, false, row0, st, sub, hc); RW_PF_WAIT(P); }
    { const int j = tid >> 3, c8 = (tid & 7) * 8;
      const float* p = INP(I_WUP) + ((size_t)l * 64 + j) * 512 + h * 64 + c8; f32x4 x0 = *(const f32x4*)p, x1 = *(const f32x4*)(p + 4);
#pragma unroll
      for (int i = 0; i < 4; ++i) { WUPT[(c8 + i) * 72 + j] = (bf16)(cvt_pk_bf16(x0[i], 0.f) & 0xffffu); WUPT[(c8 + 4 + i) * 72 + j] = (bf16)(cvt_pk_bf16(x1[i], 0.f) & 0xffffu); }
      p = INP(I_AUP) + ((size_t)l * 64 + j) * 512 + h * 64 + c8; x0 = *(const f32x4*)p; x1 = *(const f32x4*)(p + 4);
#pragma unroll
      for (int i = 0; i < 4; ++i) { AUPT[(c8 + i) * 72 + j] = (bf16)(cvt_pk_bf16(x0[i], 0.f) & 0xffffu); AUPT[(c8 + 4 + i) * 72 + j] = (bf16)(cvt_pk_bf16(x1[i], 0.f) & 0xffffu); }
#pragma unroll
      for (int r = 0; r < 2; ++r) { const int jj = j + 64 * r; p = INP(I_GUP) + ((size_t)l * 128 + jj) * 512 + h * 64 + c8; x0 = *(const f32x4*)p; x1 = *(const f32x4*)(p + 4);
#pragma unroll
          for (int i = 0; i < 4; ++i) { GUPT[(c8 + i) * 136 + jj] = (bf16)(cvt_pk_bf16(x0[i], 0.f) & 0xffffu); GUPT[(c8 + 4 + i) * 136 + jj] = (bf16)(cvt_pk_bf16(x1[i], 0.f) & 0xffffu); } } }
    const int sv = half * 32 + ((tid >> 4) & 15) * 2, ks = tid & 15;
    f32x2 s0[2], s1[2];
    s0[0] = (f32x2){0.f, 0.f}; s0[1] = s0[0]; s1[0] = s0[0]; s1[1] = s0[0];
    const f32x4 pw0 = *(const f32x4*)(INP(I_W0) + l * 512 + hc), pa0 = *(const f32x4*)(INP(I_A0) + l * 512 + hc), pkk = *(const f32x4*)(INP(I_KK) + l * 512 + hc), pka = *(const f32x4*)(INP(I_KA) + l * 512 + hc);
    const f32x4 prk = *(const f32x4*)(INP(I_RK) + l * 512 + hc), plg = *(const f32x4*)(INP(I_LNG) + l * 512 + hc), plb = *(const f32x4*)(INP(I_LNB) + l * 512 + hc);
    const f32x4 mr = *(const f32x4*)(mu + hc), mk = *(const f32x4*)(mu + 512 + hc), mv = *(const f32x4*)(mu + 1024 + hc);
    f32x4 ml[4];
#pragma unroll
    for (int i = 0; i < 4; ++i) ml[i] = *(const f32x4*)(mu + 1536 + sub * 16 + 4 * i);
    VM_DRAIN_KNOWN();
    LDS_BARRIER();
    for (int c = -1; c < NC; ++c) {
        const int pc = c + 1;
        LAS float* Sp = SS + (pc & 1) * 7168; const LAS float* Sc = SS + (c & 1) * 7168;
        const RwPre C = P;
        if (prod) {
            if (pc < NC) { const int j0 = sub * 16;
#pragma unroll
                for (int hh = 0; hh < 2; ++hh) { float xc[8], xp[8]; unpack8(hh ? C.lc1 : C.lc0, xc); unpack8(hh ? C.lp1 : C.lp0, xp);
                    float o[8];
#pragma unroll
                    for (int i = 0; i < 8; ++i) { const float m_ = ml[2 * hh + (i >> 2)][i & 3]; float x = xc[i] + (xp[i] - xc[i]) * m_; o[i] = j0 < 64 ? tanh_(x) : (j0 < 128 ? x : sigm(x)); }
                    *(LAS v4u*)(LRB + st * 264 + j0 + 8 * hh) = pack8(o); } }
        } else {
            if (c >= 1 && (sub >> 3) == half) {
                const int cc = c - 1, grow = row0 + cc * 16 + st; const LAS float* Sq = SS + (cc & 1) * 7168;
                const f32x4 y4 = *(const LAS f32x4*)(SY + (cc & 1) * 1024 + st * 64 + c4);
                const float sy = red8((y4[0] + y4[1]) + (y4[2] + y4[3])), sq = red8((y4[0] * y4[0] + y4[1] * y4[1]) + (y4[2] * y4[2] + y4[3] * y4[3]));
                if ((sub & 7) == 0) *(f32x2*)((float*)(a.ws + WS_RST) + (size_t)grow * 32 + h * 4 + half * 2) = (f32x2){sy, sq};
                const float bon = SB[(cc & 1) * 16 + st];
                const f32x4 vv4 = *(const LAS f32x4*)(Sq + 5120 + st * 64 + c4), gg4 = *(const LAS f32x4*)(Sq + 6144 + st * 64 + c4);
                float c1[4], c2[4];
#pragma unroll
                for (int i = 0; i < 4; ++i) { c1[i] = plg[i] * gg4[i]; c2[i] = (plb[i] + bon * vv4[i]) * gg4[i]; }
                *(v2u*)(BR + (size_t)grow * 2048 + 512 + hc) = pack4(y4[0], y4[1], y4[2], y4[3]);
                bf16* GC = (bf16*)(a.ws + WS_G) + (size_t)grow * 1024;
                *(v2u*)(GC + hc) = pack4(c1[0], c1[1], c1[2], c1[3]); *(v2u*)(GC + 512 + hc) = pack4(c2[0], c2[1], c2[2], c2[3]);
            }
            if (c >= 0) RW_SCAN16(0, 6);
        }
        LDS_BARRIER();
        if (prod) {
            if (pc < NC) { const int nt = wave - 4, fr = lane & 15, fq = lane >> 4;
                f32x4 cw = {0.f, 0.f, 0.f, 0.f}, ca = {0.f, 0.f, 0.f, 0.f}, cgt = {0.f, 0.f, 0.f, 0.f};
                const LAS bf16* ar = LRB + fr * 264 + fq * 8;
#pragma unroll
                for (int kk = 0; kk < 2; ++kk) {
                    cw = __builtin_amdgcn_mfma_f32_16x16x32_bf16(*(const LAS pg8::bf16x8*)(ar + kk * 32), *(const LAS pg8::bf16x8*)(WUPT + (nt * 16 + fr) * 72 + kk * 32 + fq * 8), cw, 0, 0, 0);
                    ca = __builtin_amdgcn_mfma_f32_16x16x32_bf16(*(const LAS pg8::bf16x8*)(ar + 64 + kk * 32), *(const LAS pg8::bf16x8*)(AUPT + (nt * 16 + fr) * 72 + kk * 32 + fq * 8), ca, 0, 0, 0); }
#pragma unroll
                for (int kk = 0; kk < 4; ++kk)
                    cgt = __builtin_amdgcn_mfma_f32_16x16x32_bf16(*(const LAS pg8::bf16x8*)(ar + 128 + kk * 32), *(const LAS pg8::bf16x8*)(GUPT + (nt * 16 + fr) * 136 + kk * 32 + fq * 8), cgt, 0, 0, 0);
#pragma unroll
                for (int j = 0; j < 4; ++j) { const int o = (fq * 4 + j) * 64 + nt * 16 + fr; LWA[o] = cw[j]; LWA[1024 + o] = ca[j]; LWA[2048 + o] = cgt[j]; } }
        } else if (c >= 0) RW_SCAN16(6, 12);
        LDS_BARRIER();
        if (prod) {
            if (pc < NC) {
                const f32x4 lw = *(const LAS f32x4*)(LWA + st * 64 + c4), la = *(const LAS f32x4*)(LWA + 1024 + st * 64 + c4), lg = *(const LAS f32x4*)(LWA + 2048 + st * 64 + c4);
                float r4[4], k4[4], v4[4];
                { float rc[4], kc[4], vc[4], rp[4], kp[4], vp[4]; unpack4(C.rc, rc); unpack4(C.kc, kc); unpack4(C.vc, vc); unpack4(C.rp, rp); unpack4(C.kp, kp); unpack4(C.vp, vp);
#pragma unroll
                  for (int i = 0; i < 4; ++i) { r4[i] = rc[i] + (rp[i] - rc[i]) * mr[i]; k4[i] = kc[i] + (kp[i] - kc[i]) * mk[i]; v4[i] = vc[i] + (vp[i] - vc[i]) * mv[i]; } }
                float wd[4], av[4], kkr[4]; float ssq = 0.f;
#pragma unroll
                for (int i = 0; i < 4; ++i) { wd[i] = __expf(-0.606531f * sigm(pw0[i] + lw[i])); av[i] = sigm(pa0[i] + la[i]); kkr[i] = k4[i] * pkk[i]; ssq += kkr[i] * kkr[i]; }
                ssq = red16(ssq); const float inv = 1.f / fmaxf(sqrtf(ssq), 1e-12f);
                float bon = 0.f; float k2[4], kkv[4], kav[4];
#pragma unroll
                for (int i = 0; i < 4; ++i) { kkv[i] = kkr[i] * inv; k2[i] = k4[i] * (1.f + (av[i] - 1.f) * pka[i]); kav[i] = kkv[i] * av[i]; bon += r4[i] * k2[i] * prk[i]; }
                LAS float* d = Sp + st * 64 + c4;
                *(LAS f32x4*)d = (f32x4){r4[0], r4[1], r4[2], r4[3]}; *(LAS f32x4*)(d + 1024) = (f32x4){wd[0], wd[1], wd[2], wd[3]};
                *(LAS f32x4*)(d + 2048) = (f32x4){k2[0], k2[1], k2[2], k2[3]}; *(LAS f32x4*)(d + 3072) = (f32x4){kkv[0], kkv[1], kkv[2], kkv[3]};
                *(LAS f32x4*)(d + 4096) = (f32x4){kav[0], kav[1], kav[2], kav[3]}; *(LAS f32x4*)(d + 5120) = (f32x4){v4[0], v4[1], v4[2], v4[3]};
                *(LAS f32x4*)(d + 6144) = lg;
                bon = red16(bon); if (sub == 0) SB[(pc & 1) * 16 + st] = bon;
            }
            if (pc + 1 < NC) rwkv_prefetch(P, PROJ, mu, false, row0, (pc + 1) * 16 + st, sub, hc);
            RW_PF_WAIT(P);
        } else if (c >= 0) RW_SCAN16(12, 16);
        LDS_BARRIER();
    }
    if (!prod && (sub >> 3) == half) {
        const int cc = NC - 1, grow = row0 + cc * 16 + st; const LAS float* Sq = SS + (cc & 1) * 7168;
        const f32x4 y4 = *(const LAS f32x4*)(SY + (cc & 1) * 1024 + st * 64 + c4);
        const float sy = red8((y4[0] + y4[1]) + (y4[2] + y4[3])), sq = red8((y4[0] * y4[0] + y4[1] * y4[1]) + (y4[2] * y4[2] + y4[3] * y4[3]));
        if ((sub & 7) == 0) *(f32x2*)((float*)(a.ws + WS_RST) + (size_t)grow * 32 + h * 4 + half * 2) = (f32x2){sy, sq};
        const float bon = SB[(cc & 1) * 16 + st];
        const f32x4 vv4 = *(const LAS f32x4*)(Sq + 5120 + st * 64 + c4), gg4 = *(const LAS f32x4*)(Sq + 6144 + st * 64 + c4);
        float c1[4], c2[4];
#pragma unroll
        for (int i = 0; i < 4; ++i) { c1[i] = plg[i] * gg4[i]; c2[i] = (plb[i] + bon * vv4[i]) * gg4[i]; }
        *(v2u*)(BR + (size_t)grow * 2048 + 512 + hc) = pack4(y4[0], y4[1], y4[2], y4[3]);
        bf16* GC = (bf16*)(a.ws + WS_G) + (size_t)grow * 1024;
        *(v2u*)(GC + hc) = pack4(c1[0], c1[1], c1[2], c1[3]); *(v2u*)(GC + 512 + hc) = pack4(c2[0], c2[1], c2[2], c2[3]);
    }
    if (!prod) { float* so = a.out + O_RW_P + ((size_t)(l * 8 + seq) * 8 + h) * 4096 + sv * 64 + ks * 4;
      *(f32x4*)so = (f32x4){s0[0].x, s0[0].y, s0[1].x, s0[1].y}; *(f32x4*)(so + 64) = (f32x4){s1[0].x, s1[0].y, s1[1].x, s1[1].y}; }
    { float* sh = a.out + O_SH_P + (size_t)(l * 8 + seq) * 1792; const bf16* pl = PROJ + (size_t)(row0 + T - 1) * INC + 2048;
      if (half == 0 && tid < 64) { sh[h * 64 + tid] = bf2f(pl[h * 64 + tid]); sh[512 + h * 64 + tid] = bf2f(pl[512 + h * 64 + tid]); sh[1024 + h * 64 + tid] = bf2f(pl[1024 + h * 64 + tid]); }
      if (half == 0 && h == 0 && tid >= 256) sh[1536 + tid - 256] = bf2f(pl[1536 + tid - 256]); }
    __syncthreads();
}

struct LrPre { v2u x0, x1, x2, x3, g; };
#define LR_PF_WAIT(P) asm volatile("s_waitcnt vmcnt(0)" : "+v"(P.x0), "+v"(P.x1), "+v"(P.x2), "+v"(P.x3), "+v"(P.g) :: "memory")
__device__ __forceinline__ void lru_prefetch(LrPre& P, const bf16* PROJ, const float* cst, bool smp, int row0, int tg, int ch) {
    const bf16* p = PROJ + (size_t)(row0 + tg) * INC + 4864 + ch;
    P.g = gload8(p + 512); P.x3 = gload8(p);
    if (tg >= 3) { P.x2 = gload8(p - INC); P.x1 = gload8(p - 2 * INC); P.x0 = gload8(p - 3 * INC); }
    else {
        v2u* dst[3] = {&P.x2, &P.x1, &P.x0};
#pragma unroll
        for (int j = 0; j < 3; ++j) { const int ts = tg - 1 - j;
            if (ts >= 0) *dst[j] = gload8(p - (j + 1) * INC);
            else if (smp) { const float* q = cst + (3 + ts) * 512 + ch; *dst[j] = pack4(q[0], q[1], q[2], q[3]); }
            else *dst[j] = (v2u){0u, 0u}; } }
}
__device__ __forceinline__ void lru_unit(LAS unsigned char* lds, const MArgs& a, int tid_in, int l, int seq, int n) {
    SEQ_SETUP
    const int tid = tid_in, lane = tid & 63, wave = __builtin_amdgcn_readfirstlane(tid >> 6);
    const bf16* PROJ = (const bf16*)(a.ws + WS_BIG); bf16* BR = (bf16*)(a.ws + WS_BR);
    LAS bf16* WAT = (LAS bf16*)lds; LAS bf16* WXT = WAT + 64 * 72; LAS bf16* XCB = WXT + 64 * 72;
    LAS float* RA = (LAS float*)(lds + 23040); LAS float* RI = RA + 2048; LAS float* AA = RI + 2048; LAS float* BB = AA + 2048; LAS float* HS = BB + 2048;
    const int st = tid >> 4, sub = tid & 15, d4 = sub * 4, ch = n * 64 + d4;
    const float* cst = INP(I_SLC) + (size_t)(l * 128 + (smp ? bs : 0)) * 3 * 512;
    LrPre P; P.x0 = (v2u){0u, 0u}; P.x1 = P.x0; P.x2 = P.x0; P.x3 = P.x0; P.g = P.x0;
    if (st < T) lru_prefetch(P, PROJ, cst, smp, row0, st, ch);
    LR_PF_WAIT(P);
    { const int c = tid >> 3, d8 = (tid & 7) * 8;
      const float* p = INP(I_LWA) + (size_t)(l * 8 + n) * 4096 + c * 64 + d8; f32x4 x0 = *(const f32x4*)p, x1 = *(const f32x4*)(p + 4);
#pragma unroll
      for (int i = 0; i < 4; ++i) { WAT[(d8 + i) * 72 + c] = (bf16)(cvt_pk_bf16(x0[i], 0.f) & 0xffffu); WAT[(d8 + 4 + i) * 72 + c] = (bf16)(cvt_pk_bf16(x1[i], 0.f) & 0xffffu); }
      p = INP(I_LWX) + (size_t)(l * 8 + n) * 4096 + c * 64 + d8; x0 = *(const f32x4*)p; x1 = *(const f32x4*)(p + 4);
#pragma unroll
      for (int i = 0; i < 4; ++i) { WXT[(d8 + i) * 72 + c] = (bf16)(cvt_pk_bf16(x0[i], 0.f) & 0xffffu); WXT[(d8 + 4 + i) * 72 + c] = (bf16)(cvt_pk_bf16(x1[i], 0.f) & 0xffffu); } }
    float hprev = (smp && wave == 0) ? INP(I_SLH)[(size_t)(l * 128 + bs) * 512 + n * 64 + lane] : 0.f;
    float cw[4][4], cb[4], ba[4], bx[4], sp[4];
#pragma unroll
    for (int i = 0; i < 4; ++i) {
#pragma unroll
        for (int j = 0; j < 4; ++j) cw[j][i] = INP(I_LCW)[(l * 4 + j) * 512 + ch + i];
        cb[i] = INP(I_LCB)[l * 512 + ch + i]; ba[i] = INP(I_LBA)[l * 512 + ch + i]; bx[i] = INP(I_LBX)[l * 512 + ch + i];
        const float lam = INP(I_LAM)[l * 512 + ch + i]; sp[i] = log1pf(__expf(-lam)); }
    VM_DRAIN_KNOWN();
    for (int t0 = 0; t0 < T; t0 += 32) {
        const int tc = (T - t0) < 32 ? (T - t0) : 32;
        const int grow = row0 + t0 + st;
        const LrPre C = P;
        float xc[4], gl[4];
        if (st < tc) { float x0[4], x1[4], x2[4], x3[4]; unpack4(C.x0, x0); unpack4(C.x1, x1); unpack4(C.x2, x2); unpack4(C.x3, x3); unpack4(C.g, gl);
#pragma unroll
            for (int i = 0; i < 4; ++i) xc[i] = cb[i] + cw[0][i] * x0[i] + cw[1][i] * x1[i] + cw[2][i] * x2[i] + cw[3][i] * x3[i];
            *(LAS v2u*)(XCB + st * 72 + d4) = pack4(xc[0], xc[1], xc[2], xc[3]); }
        LDS_BARRIER();
        { const int mt = wave >> 2, nq = wave & 3, fr = lane & 15, fq = lane >> 4;
          if (mt * 16 < tc) {
              f32x4 ca = {0.f, 0.f, 0.f, 0.f}, cx = {0.f, 0.f, 0.f, 0.f};
#pragma unroll
              for (int kk = 0; kk < 2; ++kk) { const pg8::bf16x8 av = *(const LAS pg8::bf16x8*)(XCB + (mt * 16 + fr) * 72 + kk * 32 + fq * 8);
                  ca = __builtin_amdgcn_mfma_f32_16x16x32_bf16(av, *(const LAS pg8::bf16x8*)(WAT + (nq * 16 + fr) * 72 + kk * 32 + fq * 8), ca, 0, 0, 0);
                  cx = __builtin_amdgcn_mfma_f32_16x16x32_bf16(av, *(const LAS pg8::bf16x8*)(WXT + (nq * 16 + fr) * 72 + kk * 32 + fq * 8), cx, 0, 0, 0); }
#pragma unroll
              for (int j = 0; j < 4; ++j) { const int o = (mt * 16 + fq * 4 + j) * 64 + nq * 16 + fr; RA[o] = ca[j]; RI[o] = cx[j]; } } }
        LDS_BARRIER();
        if (st < tc) {
            const f32x4 ra = *(const LAS f32x4*)(RA + st * 64 + d4), ri = *(const LAS f32x4*)(RI + st * 64 + d4);
            float av[4], bv[4];
#pragma unroll
            for (int i = 0; i < 4; ++i) { const float rg = sigm(ra[i] + ba[i]), ig = sigm(ri[i] + bx[i]); const float la = -8.f * rg * sp[i]; av[i] = __expf(la); bv[i] = sqrtf(1.f - __expf(2.f * la)) * (ig * xc[i]); }
            *(LAS f32x4*)(AA + st * 64 + d4) = (f32x4){av[0], av[1], av[2], av[3]}; *(LAS f32x4*)(BB + st * 64 + d4) = (f32x4){bv[0], bv[1], bv[2], bv[3]};
        }
        if (t0 + 32 + st < T) lru_prefetch(P, PROJ, cst, smp, row0, t0 + 32 + st, ch);
        LDS_BARRIER();
        if (wave == 0) { float ar[32], br[32];
#pragma unroll
            for (int t = 0; t < 32; ++t) { ar[t] = AA[t * 64 + lane]; br[t] = BB[t * 64 + lane]; }
            float hh = hprev;
#pragma unroll
            for (int t = 0; t < 32; ++t) { if (t < tc) { hh = ar[t] * hh + br[t]; br[t] = hh; } }
#pragma unroll
            for (int t = 0; t < 32; ++t) HS[t * 64 + lane] = br[t];
            hprev = hh; }
        LDS_BARRIER();
        if (st < tc) { const f32x4 hs = *(const LAS f32x4*)(HS + st * 64 + d4);
            *(v2u*)(BR + (size_t)grow * 2048 + 1536 + ch) = pack4(hs[0] * gl[0], hs[1] * gl[1], hs[2] * gl[2], hs[3] * gl[3]); }
        LR_PF_WAIT(P);
    }
    if (wave == 0) a.out[(smp ? O_LH_S : O_LH_P) + (size_t)(l * Bg + bo) * 512 + n * 64 + lane] = hprev;
    if (tid < 192) { const int i = tid >> 6, c = tid & 63; a.out[(smp ? O_LC_S : O_LC_P) + ((size_t)(l * Bg + bo) * 3 + i) * 512 + n * 64 + c] = bf2f(PROJ[(size_t)(row0 + T - 3 + i) * INC + 4864 + n * 64 + c]); }
    __syncthreads();
}

template <int TC> __device__ __forceinline__ void cf_unit(LAS unsigned char* lds, const MArgs& a, int tid_in, int l, int seq, int t0, int tc) {
    SEQ_SETUP
    const int tid = tid_in, lane = tid & 63, wave = tid >> 6, c = tid;
    const bf16* PROJ = (const bf16*)(a.ws + WS_BIG); bf16* BR = (bf16*)(a.ws + WS_BR);
    LAS float* U = (LAS float*)lds;
    const float* cst = INP(I_SCV) + (size_t)(l * 128 + (smp ? bs : 0)) * 30 * 512;
    constexpr int NR = TC + 30, NP = (NR + 7) / 8;
    { v4u va[NP], vg[NP];
#pragma unroll
      for (int k = 0; k < NP; ++k) { const int i = wave + 8 * k, tt = t0 - 30 + i;
          if (i < tc + 30 && tt >= 0) { const bf16* p = PROJ + (size_t)(row0 + tt) * INC + 3840 + lane * 8; va[k] = *(const v4u*)p; vg[k] = *(const v4u*)(p + 512); } }
#pragma unroll
      for (int k = 0; k < NP; ++k) { const int i = wave + 8 * k, tt = t0 - 30 + i;
          if (i < tc + 30) { float u[8];
              if (tt >= 0) { float x[8], g[8]; unpack8(va[k], x); unpack8(vg[k], g);
#pragma unroll
                  for (int j = 0; j < 8; ++j) u[j] = x[j] * g[j]; }
              else if (smp) { const float* q = cst + (30 + tt) * 512 + lane * 8; const f32x4 q0 = *(const f32x4*)q, q1 = *(const f32x4*)(q + 4);
                  u[0] = q0[0]; u[1] = q0[1]; u[2] = q0[2]; u[3] = q0[3]; u[4] = q1[0]; u[5] = q1[1]; u[6] = q1[2]; u[7] = q1[3]; }
              else {
#pragma unroll
                  for (int j = 0; j < 8; ++j) u[j] = 0.f; }
              *(LAS f32x4*)(U + i * 512 + lane * 8) = (f32x4){u[0], u[1], u[2], u[3]}; *(LAS f32x4*)(U + i * 512 + lane * 8 + 4) = (f32x4){u[4], u[5], u[6], u[7]}; } } }
    float w[31];
#pragma unroll
    for (int j = 0; j < 31; ++j) w[j] = INP(I_CFDW)[(size_t)(l * 31 + j) * 512 + c];
    const float bias = INP(I_CFDWB)[l * 512 + c];
    __syncthreads();
    { float acc[TC];
#pragma unroll
      for (int t = 0; t < TC; ++t) acc[t] = bias;
#pragma unroll
      for (int i = 0; i < NR; ++i) { const float u = U[i * 512 + c];
#pragma unroll
          for (int t = 0; t < TC; ++t) { if (i - t >= 0 && i - t <= 30) acc[t] += u * w[i - t]; } }
#pragma unroll
      for (int t = 0; t < TC; ++t) { if (t < tc) U[t * 512 + c] = acc[t]; } }
    if (t0 + tc == T) { float* so = a.out + (smp ? O_CV_S : O_CV_P) + (size_t)(l * Bg + bo) * 30 * 512 + c;
#pragma unroll 6
        for (int i = 0; i < 30; ++i) so[i * 512] = U[(tc + i) * 512 + c]; }
    __syncthreads();
    for (int t = wave; t < tc; t += 8) {
        const f32x4 x0 = *(const LAS f32x4*)(U + t * 512 + lane * 8), x1 = *(const LAS f32x4*)(U + t * 512 + lane * 8 + 4);
        const float mean = wave_sum((x0[0] + x0[1]) + (x0[2] + x0[3]) + (x1[0] + x1[1]) + (x1[2] + x1[3])) * (1.f / 512.f);
        float d[8] = {x0[0] - mean, x0[1] - mean, x0[2] - mean, x0[3] - mean, x1[0] - mean, x1[1] - mean, x1[2] - mean, x1[3] - mean};
        float q = 0.f;
#pragma unroll
        for (int j = 0; j < 8; ++j) q += d[j] * d[j];
        const float rstd = rsqrtf(wave_sum(q) * (1.f / 512.f) + 1e-5f);
        const float* g = INP(I_CFLG) + l * 512 + lane * 8; const float* b = INP(I_CFLB) + l * 512 + lane * 8;
#pragma unroll
        for (int j = 0; j < 8; ++j) d[j] = silu_(d[j] * rstd * g[j] + b[j]);
        *(v4u*)(BR + (size_t)(row0 + t0 + t) * 2048 + 1024 + lane * 8) = pack8(d);
    }
    __syncthreads();
}

__device__ __forceinline__ void phase_mixers(const Args& a, int l, LAS unsigned char* lds, int rep = 0, int ulo = 0, int uhi = 3968, int mode = 0) {
    unsigned* ctr = (unsigned*)(a.ws + WS_CTL) + 64 * (1 + l + 2 * rep);
    volatile LAS unsigned* slot = (volatile LAS unsigned*)(lds + MISC_OFF);
    for (;;) {
        if (threadIdx.x == 0) slot[0] = atomicAdd(ctr, 1u);
        __syncthreads();
        const int u = (int)slot[0] + ulo;
        __syncthreads();
        if (u >= uhi) break;
        int kind, seq, p1, p2 = 0;
        if (u < 128) { kind = 0; seq = u >> 4; p1 = (u >> 1) & 7; p2 = u & 1; }
        else if (u < 192) { const int v = u - 128; kind = 1; seq = v >> 3; p1 = (v >> 1) & 3; p2 = v & 1; }
        else if (u < 256) { const int v = u - 192; kind = 2; seq = v >> 3; p1 = v & 7; }
        else if (u < 768) { const int v = u - 256; kind = 3; seq = v >> 6; p1 = (v & 63) * 32; p2 = 32; }
        else if (u < 1792) { const int v = u - 768; kind = 1; seq = 8 + (v >> 3); p1 = (v >> 1) & 3; p2 = v & 1; }
        else if (u < 2816) { const int v = u - 1792; kind = 0; seq = 8 + (v >> 3); p1 = v & 7; p2 = 0; }
        else if (u < 3840) { const int v = u - 2816; kind = 2; seq = 8 + (v >> 3); p1 = v & 7; }
        else { const int v = u - 3840; kind = 3; seq = 8 + v; p1 = 0; p2 = 8; }
        MArgs m; m.out = a.out; m.ws = a.ws; int ll = l;
        int tl = threadIdx.x;
        int md = mode;
        asm volatile("" : "+s"(m.out), "+s"(m.ws), "+s"(ll), "+v"(tl), "+s"(md));
        if (kind == 0) { if (seq < 8) rwkv_unit_pc(lds, m, tl, ll, seq, p1, p2); else rwkv_unit(lds, m, tl, ll, seq, p1, p2, md); }
        else if (kind == 1) hg_unit(lds, m, tl, ll, seq, p1, p2, md);
        else if (kind == 2) lru_unit(lds, m, tl, ll, seq, p1);
        else cf_unit<32>(lds, m, tl, ll, seq, p1, p2);
    }
}

#define XB_TMO      128
#define XB_XCNT(j)  (256  + 64 * (j))
#define XB_XSUB(j)  (1280 + 64 * (j))
#define XB_XGEN(j)  (2304 + 64 * (j))
#define XB_TOP      3328
#define XB_TOPGEN   3392
#define XCD_BAR_WORDS 3456
#define XB_SPIN_CAP (1u << 18)

__device__ __forceinline__ unsigned xb_ld(unsigned* p)              { return __hip_atomic_load(p, __ATOMIC_RELAXED, __HIP_MEMORY_SCOPE_AGENT); }
__device__ __forceinline__ unsigned xb_add(unsigned* p, unsigned v) { return __hip_atomic_fetch_add(p, v, __ATOMIC_RELAXED, __HIP_MEMORY_SCOPE_AGENT); }
__device__ __forceinline__ unsigned xb_xcc_id() { return (unsigned)__builtin_amdgcn_s_getreg((3 << 11) | 20) & 0xFu; }
#define XB_SPIN(cond, bar) do { unsigned _sp = 0; while (cond) { __builtin_amdgcn_s_sleep(1); \
    if ((++_sp & 255u) == 0u) { if (xb_ld(&(bar)[XB_TMO])) break; if (_sp > XB_SPIN_CAP) { atomicAdd(&(bar)[XB_TMO], 1u); break; } } } } while (0)

struct XcdBarrier {
    unsigned* bar; unsigned x;
    volatile LAS unsigned* st;
};

__device__ __forceinline__ XcdBarrier xcd_barrier_post(unsigned* bar, volatile LAS unsigned* st) {
    XcdBarrier b; b.bar = bar; b.x = xb_xcc_id(); b.st = st;
    if (threadIdx.x == 0) (void)xb_add(&bar[XB_XCNT(b.x)], 1u);
    return b;
}
__device__ __forceinline__ void xcd_barrier_complete(unsigned* bar, unsigned x, unsigned& nloc, unsigned& nx) {
    const unsigned G = gridDim.x * gridDim.y * gridDim.z;
    unsigned sum, cnt, mine, sp = 0u;
    for (;;) {
        sum = 0u; cnt = 0u; mine = 0u;
#pragma unroll
        for (unsigned j = 0; j < 16; ++j) { const unsigned c = xb_ld(&bar[XB_XCNT(j)]); sum += c; cnt += (c > 0u) ? 1u : 0u; mine = (j == x) ? c : mine; }
        if (sum == G) break;
        __builtin_amdgcn_s_sleep(1);
        if ((++sp & 255u) == 0u) { if (xb_ld(&bar[XB_TMO])) break; if (sp > XB_SPIN_CAP) { atomicAdd(&bar[XB_TMO], 1u); break; } }
    }
    nloc = mine > 0u ? mine : 1u; nx = cnt > 0u ? cnt : 1u;
}

__device__ __forceinline__ void xcd_barrier(const XcdBarrier& b) {
    asm volatile("s_waitcnt vmcnt(0)" ::: "memory");
    __syncthreads();
    if (threadIdx.x == 0) {
        unsigned* bar = b.bar;
        __builtin_amdgcn_s_waitcnt(0);
        unsigned nloc = b.st[0], nx = b.st[1];
        if (nloc == 0u) { xcd_barrier_complete(bar, b.x, nloc, nx); b.st[0] = nloc; b.st[1] = nx; }
        const unsigned old = xb_add(&bar[XB_XSUB(b.x)], 1u);
        const unsigned gen = old / nloc;
        if (old + 1u == (gen + 1u) * nloc) {
            __builtin_amdgcn_fence(__ATOMIC_RELEASE, "agent");
            asm volatile("s_waitcnt vmcnt(0)" ::: "memory");
            const unsigned og = xb_add(&bar[XB_TOP], 1u);
            const unsigned tg = og / nx;
            if (og + 1u == (tg + 1u) * nx) xb_add(&bar[XB_TOPGEN], 1u);
            else XB_SPIN(xb_ld(&bar[XB_TOPGEN]) == tg, bar);
            __builtin_amdgcn_fence(__ATOMIC_ACQUIRE, "agent");
            xb_add(&bar[XB_XGEN(b.x)], 1u);
            asm volatile("s_waitcnt vmcnt(0)" ::: "memory");
        } else {
            XB_SPIN(xb_ld(&bar[XB_XGEN(b.x)]) == gen, bar);
            __builtin_amdgcn_fence(__ATOMIC_ACQUIRE, "agent");
            asm volatile("s_waitcnt vmcnt(0)" ::: "memory");
        }
    }
    __syncthreads();
}

constexpr int N_PHASES = 21;
#define IN(k) (a.ph_lo <= (k) && (k) < a.ph_hi)
#define SEAM(k) do { if (IN(k) && IN((k) + 1)) { if (a.ph_hi == 0x7fffffff) cg::this_grid().sync(); xcd_barrier(xbar); } } while (0)
template <int l> __device__ __forceinline__ void layer_phases(const Args& a, LAS unsigned char* lds, int G, int gw, int NGW, int wave, int lane, const XcdBarrier& xbar) {
    constexpr int P = 2 + 9 * l;
    const bf16* H = (const bf16*)(a.ws + WS_H);
    const float* MODL = (const float*)(a.ws + WS_MOD) + l * 6144;
    if (IN(P + 0)) { if (l == 1) phase_conv_layer(a, 1, lds, gw, NGW, wave, lane, G > 80 ? 6528 : 0, 10624); phase_norm(a, l, 0, gw, NGW, lane); }
    SEAM(P + 0);
    const bool fuse13 = G == 256 && IN(P + 1) && IN(P + 3) && IN(P + 4);
    if (IN(P + 1)) {
        pg8::Gemm g{H, (const pg8::bf16_t*)(a.ws + WS_WIN), NTOK, INC, 1024}; pg8::StaticOrder S; S.init(NTOK, INC, G, (int)blockIdx.x);
        pg8::EpiProj E{(pg8::bf16_t*)(a.ws + WS_BIG), INP(I_HGL), l};
        pg8::gemm_phase<pg8::EpiProj, pg8::StaticOrder, true, true>(lds, g, S, E);
        if (fuse13 && (int)blockIdx.x >= 28 && (int)blockIdx.x < 92) {
            pg8::Gemm g2{H + (size_t)NPR * 1024, (const pg8::bf16_t*)(a.ws + WS_WG), NTOK - NPR, 4096, 1024}; pg8::StaticOrder S2; S2.init(NTOK - NPR, 4096, 64, (int)blockIdx.x - 28);
            pg8::EpiGate E2{(pg8::bf16_t*)(a.ws + WS_GS), INP(I_BGATE) + l * 4096};
            pg8::gemm_phase<pg8::EpiGate, pg8::StaticOrder, true, true>(lds, g2, S2, E2);
        }
    }
    SEAM(P + 1);
#ifdef PROBE_MIX
    if (IN(P + 2)) { phase_mixers(a, l, lds); xcd_barrier(xbar); phase_mixers(a, l, lds, 1, PROBE_LO, PROBE_HI, PROBE_MODE); }
#else
    if (IN(P + 2)) phase_mixers(a, l, lds);
#endif
    SEAM(P + 2);
    if (IN(P + 3)) {
        phase_hg_post(a, gw, NGW, lane);
        const int Mg = fuse13 ? NPR : NTOK;
        pg8::Gemm g{H, (const pg8::bf16_t*)(a.ws + WS_WG), Mg, 4096, 1024}; pg8::StaticOrder S; S.init(Mg, 4096, G, (int)blockIdx.x);
        pg8::EpiGate E{(pg8::bf16_t*)(a.ws + WS_BIG), INP(I_BGATE) + l * 4096};
        pg8::gemm_phase<pg8::EpiGate, pg8::StaticOrder, true, true>(lds, g, S, E);
    }
    SEAM(P + 3);
    if (IN(P + 4)) {
        pg8::Gemm g{(const pg8::bf16_t*)(a.ws + WS_BR), (const pg8::bf16_t*)(a.ws + WS_WB), NTOK, 1024, 2048}; pg8::StaticOrder S; S.init(NTOK, 1024, G, (int)blockIdx.x);
        pg8::EpiBranch E{(pg8::bf16_t*)(a.ws + WS_G), (const pg8::bf16_t*)(a.ws + WS_BIG), fuse13 ? (const pg8::bf16_t*)(a.ws + WS_GS) - (size_t)NPR * 4096 : (const pg8::bf16_t*)(a.ws + WS_BIG)};
        pg8::gemm_phase<pg8::EpiBranch, pg8::StaticOrder, true, true>(lds, g, S, E);
    }
    SEAM(P + 4);
    if (IN(P + 5)) {
        pg8::Gemm g{(const pg8::bf16_t*)(a.ws + WS_G), (const pg8::bf16_t*)(a.ws + WS_WO), NTOK, 1024, 1024}; pg8::StaticOrder S; S.init(NTOK, 1024, G, (int)blockIdx.x);
        pg8::EpiRes E{a.out, l == 0 ? INP(I_XP) : a.out, l == 0 ? INP(I_XS) : a.out + (size_t)NPR * 1024, MODL + 2048, 0};
        pg8::gemm_phase<pg8::EpiRes, pg8::StaticOrder, true, true>(lds, g, S, E);
    }
    SEAM(P + 5);
    const bool fuse67 = G > 64 && IN(P + 6) && IN(P + 7) && IN(P + 8);
    if (IN(P + 6)) {
        if (fuse67) {
            phase_norm(a, l, 1, gw, NGW, lane, NPR, NTOK);
            xcd_barrier(xbar);
            if ((int)blockIdx.x < 64) {
                pg8::Gemm g{H + (size_t)NPR * 1024, (const pg8::bf16_t*)(a.ws + WS_W1), NTOK - NPR, 4096, 1024}; pg8::StaticOrder S; S.init(NTOK - NPR, 4096, 64, (int)blockIdx.x);
                pg8::EpiRelu2 E{(pg8::bf16_t*)(a.ws + WS_BIG) + (size_t)NPR * 4096};
                pg8::gemm_phase<pg8::EpiRelu2, pg8::StaticOrder, true, true>(lds, g, S, E);
            } else phase_norm(a, l, 1, ((int)blockIdx.x - 64) * 8 + wave, (G - 64) * 8, lane, 0, NPR);
        } else phase_norm(a, l, 1, gw, NGW, lane);
    }
    SEAM(P + 6);
    if (IN(P + 7)) {
        const pg8::bf16_t* W1 = (const pg8::bf16_t*)(a.ws + WS_W1); pg8::bf16_t* U = (pg8::bf16_t*)(a.ws + WS_BIG);
        if (G > 16 && IN(P + 8)) {
            if (!fuse67) {
              { pg8::Gemm g{H + (size_t)NPR * 1024, W1, NTOK - NPR, 4096, 1024}; pg8::StaticOrder S; S.init(NTOK - NPR, 4096, G, (int)blockIdx.x);
                pg8::EpiRelu2 E{U + (size_t)NPR * 4096};
                pg8::gemm_phase<pg8::EpiRelu2, pg8::StaticOrder, true, true>(lds, g, S, E); }
              xcd_barrier(xbar);
            }
            if ((int)blockIdx.x < 16) {
                pg8::Gemm g{U + (size_t)NPR * 4096, (const pg8::bf16_t*)(a.ws + WS_W2), NTOK - NPR, 1024, 4096}; pg8::StaticOrder S; S.init(NTOK - NPR, 1024, 16, (int)blockIdx.x);
                pg8::EpiRes E{a.out, a.out, a.out + (size_t)NPR * 1024, MODL + 5120, NPR};
                pg8::gemm_phase<pg8::EpiRes, pg8::StaticOrder, true, true>(lds, g, S, E);
            } else {
                pg8::Gemm g{H, W1, NPR, 4096, 1024}; pg8::StaticOrder S; S.init(NPR, 4096, G - 16, (int)blockIdx.x - 16);
                pg8::EpiRelu2 E{U};
                pg8::gemm_phase<pg8::EpiRelu2, pg8::StaticOrder, true, true>(lds, g, S, E);
                if (l == 0 && (int)blockIdx.x >= 80 && G > 80)
                    phase_conv_layer(a, 1, lds, ((int)blockIdx.x - 80) * 8 + wave, (G - 80) * 8, wave, lane, 0, 6528);
            }
        } else {
            pg8::Gemm g{H, W1, NTOK, 4096, 1024}; pg8::StaticOrder S; S.init(NTOK, 4096, G, (int)blockIdx.x);
            pg8::EpiRelu2 E{U};
            pg8::gemm_phase<pg8::EpiRelu2, pg8::StaticOrder, true, true>(lds, g, S, E);
        }
    }
    SEAM(P + 7);
    if (IN(P + 8)) {
        const int Mrows = (G > 16 && IN(P + 7)) ? NPR : NTOK;
        pg8::Gemm g{(const pg8::bf16_t*)(a.ws + WS_BIG), (const pg8::bf16_t*)(a.ws + WS_W2), Mrows, 1024, 4096}; pg8::StaticOrder S; S.init(Mrows, 1024, G, (int)blockIdx.x);
        pg8::EpiRes E{a.out, a.out, a.out + (size_t)NPR * 1024, MODL + 5120, 0};
        pg8::gemm_phase<pg8::EpiRes, pg8::StaticOrder, true, true>(lds, g, S, E);
    }
    SEAM(P + 8);
}
__global__ void __launch_bounds__(512, 2) mega(Args a) {
    LAS unsigned char* lds = (LAS unsigned char*)lds_raw;
    const int tid = threadIdx.x, lane = tid & 63, wave = __builtin_amdgcn_readfirstlane(tid >> 6);
    const int G = gridDim.x, gw = blockIdx.x * 8 + wave, NGW = G * 8;
    if (tid == 0) {
#pragma unroll
        for (int i = 0; i < 46; ++i) *(LAS unsigned long long*)(lds + TAB_OFF + 8 * i) = (unsigned long long)a.in[i];
        *(LAS unsigned*)(lds + MISC_OFF + 32) = 0u; *(LAS unsigned*)(lds + MISC_OFF + 36) = 0u;
    }
    __syncthreads();
    XcdBarrier xbar; xbar.bar = (unsigned*)(a.ws + WS_CTL) + 4096; xbar.x = 0; xbar.st = (volatile LAS unsigned*)(lds + MISC_OFF + 32);
    if (a.ph_hi - a.ph_lo > 1) xbar = xcd_barrier_post((unsigned*)(a.ws + WS_CTL) + 4096, (volatile LAS unsigned*)(lds + MISC_OFF + 32));
    if (IN(0)) phase_conv_ada(a, lds, gw, NGW, wave, lane);
    SEAM(0);
    if (IN(1)) {
        pg8::Gemm g{(const pg8::bf16_t*)(a.ws + WS_CA), (const pg8::bf16_t*)(a.ws + WS_BIG), 256, 12288, 1024}; pg8::StaticOrder S; S.init(256, 12288, G, (int)blockIdx.x);
        pg8::EpiMod E{(float*)(a.ws + WS_MOD), INP(I_ADAB)};
        pg8::gemm_phase<pg8::EpiMod, pg8::StaticOrder, true, true>(lds, g, S, E);
        if ((int)blockIdx.x >= 48 && G > 48)
            phase_conv_layer(a, 0, lds, ((int)blockIdx.x - 48) * 8 + wave, (G - 48) * 8, wave, lane, 0, 10624);
        else if (G <= 48) phase_conv_layer(a, 0, lds, gw, NGW, wave, lane, 0, 10624);
    }
    SEAM(1);
    layer_phases<0>(a, lds, G, gw, NGW, wave, lane, xbar);
    layer_phases<1>(a, lds, G, gw, NGW, wave, lane, xbar);
#ifdef PROBE_SYNC
    for (int i = 0; i < 40; ++i) xcd_barrier(xbar);
#endif
    if (IN(20)) phase_final(a, gw, NGW, lane);
}

extern "C" void kernel_launch(void* const* d_in, const int* in_sizes, int n_in, void* d_out, int out_size, void* d_ws, size_t ws_size, hipStream_t stream) {
    static int grid = 0;
    if (grid == 0) {
        if (n_in != 46 || ws_size < WS_END) { fprintf(stderr, "kernel_launch: bad n_in %d or ws %zu (< %zu)\n", n_in, ws_size, (size_t)WS_END); grid = -1; return; }
        (void)hipFuncSetAttribute((const void*)mega, hipFuncAttributeMaxDynamicSharedMemorySize, LDS_BYTES);
        int dev = 0, cus = 0, per_cu = 0;
        (void)hipGetDevice(&dev); (void)hipDeviceGetAttribute(&cus, hipDeviceAttributeMultiprocessorCount, dev);
        (void)hipOccupancyMaxActiveBlocksPerMultiprocessor(&per_cu, (const void*)mega, 512, LDS_BYTES);
        if (per_cu < 1) fprintf(stderr, "kernel_launch: occupancy query says %d\n", per_cu);
        (void)hipGetLastError();
        grid = cus > 0 ? cus : 256;
    }
    if (grid < 0) return;
    (void)hipMemsetAsync((char*)d_ws + WS_CTL, 0, CTL_BYTES, stream);
    Args a{};
    for (int i = 0; i < 46; ++i) a.in[i] = (const float*)d_in[i];
    a.out = (float*)d_out; a.ws = (unsigned char*)d_ws;
#if MK_SINGLE
    a.ph_lo = 0; a.ph_hi = N_PHASES;
    void* args[] = {&a};
    hipError_t e = hipLaunchCooperativeKernel((const void*)mega, dim3(grid), dim3(512), args, LDS_BYTES, stream);
    if (e != hipSuccess) fprintf(stderr, "cooperative launch failed: %s (grid %d)\n", hipGetErrorString(e), grid);
#else
    for (int ph = 0; ph < N_PHASES; ++ph) { a.ph_lo = ph; a.ph_hi = ph + 1; hipLaunchKernelGGL(mega, dim3(grid), dim3(512), LDS_BYTES, stream, a); }
#endif
}
```

```cpp
#include <hip/hip_runtime.h>
#include <hip/hip_cooperative_groups.h>
#include <cstdio>
#include <cstdint>
namespace cg = cooperative_groups;
namespace pg8 {
#define PG8_LAS __attribute__((address_space(3)))
typedef unsigned short bf16_t;
typedef short bf16x8 __attribute__((ext_vector_type(8)));
typedef float f32x4 __attribute__((ext_vector_type(4)));
typedef unsigned u32x4 __attribute__((ext_vector_type(4)));
constexpr int BM = 256, BK = 64, HALF = 128, HTB = HALF * BK * 2  , STAGE_BYTES = 8 * HTB, NXCD = 8, WGM = 8;

__host__ __device__ __forceinline__ int lds_byte(int r, int c) { const int st = (r >> 4) * 2 + (c >> 5), rr = r & 15, cc = c & 31, ob = rr * 64 + cc * 2; return st * 1024 + (ob ^ (((ob >> 9) & 1) << 5)); }
__host__ __device__ __forceinline__ void stage_rc(int b, int& R, int& C) { const int st = b / 1024, sb = b % 1024, swz = sb ^ (((sb >> 9) & 1) << 5); R = (st >> 1) * 16 + swz / 64; C = (st & 1) * 32 + (swz % 64) / 2; }
__host__ __device__ __forceinline__ int perm32(int rho) { const int n = rho >> 4, i = rho & 15; return 8 * (i >> 2) + 4 * n + (i & 3); }

struct Unit { int pm, pn; };
struct Gemm { const bf16_t* A; const bf16_t* Bt; int M, N, K; };

struct StaticOrder {
    int nM, nN, nwg, G, c;
    __host__ __device__ void init(int M, int N, int G_, int c_) { nM = M / BM; nN = N / BM; nwg = nM * nN; G = G_; c = c_; }
    __host__ __device__ bool next(int i, Unit& u) const {
        const long L = (long)i * G + c; if (L >= nwg) return false;
        int wgid = (int)L; { const int q = nwg / NXCD, r = nwg % NXCD, xcd = wgid % NXCD, off = wgid / NXCD; wgid = (xcd < r ? xcd * (q + 1) : r * (q + 1) + (xcd - r) * q) + off; }
        const int nig = WGM * nN, gid = wgid / nig, fm = gid * WGM, gsz = (nM - fm) < WGM ? (nM - fm) : WGM;
        u.pm = fm + ((wgid % nig) % gsz); u.pn = (wgid % nig) / gsz; return true;
    }
    __device__ __forceinline__ void a_ready(const Unit&) const {}
    __device__ __forceinline__ void done(const Unit&) const {}
};

__device__ __forceinline__ unsigned cvt_pk_bf16(float lo, float hi) { unsigned r; asm volatile("v_cvt_pk_bf16_f32 %0, %1, %2" : "=v"(r) : "v"(lo), "v"(hi)); return r; }
__device__ __forceinline__ float sigm(float x) { return __builtin_amdgcn_rcpf(1.f + __expf(-x)); }
__device__ __forceinline__ float silu_(float x) { return x * sigm(x); }
__device__ __forceinline__ float tanh_(float u) { return 1.f - 2.f * __builtin_amdgcn_rcpf(__expf(2.f * u) + 1.f); }
__device__ __forceinline__ float gelu_tanh(float x) { const float u = 0.7978845608f * (x + 0.044715f * x * x * x); return 0.5f * x * (1.f + tanh_(u)); }
__device__ __forceinline__ int cond_of_row(int row) { return row < 16384 ? (row >> 11) : 8 + ((row - 16384) >> 3); }
__device__ __forceinline__ void unpack8(const u32x4 w, float (&f)[8]) {
    f[0] = __uint_as_float(w.x << 16); f[1] = __uint_as_float(w.x & 0xffff0000u); f[2] = __uint_as_float(w.y << 16); f[3] = __uint_as_float(w.y & 0xffff0000u);
    f[4] = __uint_as_float(w.z << 16); f[5] = __uint_as_float(w.z & 0xffff0000u); f[6] = __uint_as_float(w.w << 16); f[7] = __uint_as_float(w.w & 0xffff0000u);
}
__device__ __forceinline__ u32x4 pack8(const float (&f)[8]) { u32x4 w; w.x = cvt_pk_bf16(f[0], f[1]); w.y = cvt_pk_bf16(f[2], f[3]); w.z = cvt_pk_bf16(f[4], f[5]); w.w = cvt_pk_bf16(f[6], f[7]); return w; }

#define EPI_LOOP_BEGIN \
    _Pragma("unroll") for (int ai = 0; ai < 2; ++ai) _Pragma("unroll") for (int m = 0; m < 4; ++m) { const int row = u.pm * BM + ai * HALF + wr * 64 + m * 16 + fr; \
    _Pragma("unroll") for (int bj = 0; bj < 2; ++bj) { const int colb = u.pn * BM + bj * HALF; const int col = colb + wc * 32 + 8 * fq; \
        float v[8]; v[0] = acc[ai][bj][m][0][0]; v[1] = acc[ai][bj][m][0][1]; v[2] = acc[ai][bj][m][0][2]; v[3] = acc[ai][bj][m][0][3]; \
        v[4] = acc[ai][bj][m][1][0]; v[5] = acc[ai][bj][m][1][1]; v[6] = acc[ai][bj][m][1][2]; v[7] = acc[ai][bj][m][1][3];
#define EPI_LOOP_END } }

struct EpiProj {
    static constexpr bool PERM = true, AFTER_DRAIN = false, HOOK = false;
    bf16_t* O; const float* hgl; int layer;
    __device__ __forceinline__ void operator()(const f32x4 (&acc)[2][2][4][2], const Unit& u, int wr, int wc, int fr, int fq) const {
        EPI_LOOP_BEGIN
            const int sec = colb >> 7;
            if (sec < 4 || (sec >= 12 && sec < 16)) {
#pragma unroll
                for (int j = 0; j < 8; ++j) v[j] = silu_(v[j]);
            } else if (sec < 8) {
#pragma unroll
                for (int j = 0; j < 8; ++j) { const int c = col - 512 + j; const float lb = layer == 0 ? 0.f : __builtin_amdgcn_rcpf(1.f + __expf(hgl[c] - hgl[512 + c])); v[j] = (1.f - lb) * sigm(-v[j]); }
            } else if (sec >= 34 && sec < 38) {
#pragma unroll
                for (int j = 0; j < 8; ++j) v[j] = sigm(v[j]);
            } else if (sec >= 42) {
#pragma unroll
                for (int j = 0; j < 8; ++j) v[j] = gelu_tanh(v[j]);
            }
            *(u32x4*)(O + (size_t)row * 5888 + col) = pack8(v);
        EPI_LOOP_END
    }
};
struct EpiGate {
    static constexpr bool PERM = true, AFTER_DRAIN = false, HOOK = false;
    bf16_t* O; const float* bias;
    __device__ __forceinline__ void operator()(const f32x4 (&acc)[2][2][4][2], const Unit& u, int wr, int wc, int fr, int fq) const {
        EPI_LOOP_BEGIN
            const f32x4 b0 = *(const f32x4*)(bias + col), b1 = *(const f32x4*)(bias + col + 4);
            v[0] = sigm(v[0] + b0[0]); v[1] = sigm(v[1] + b0[1]); v[2] = sigm(v[2] + b0[2]); v[3] = sigm(v[3] + b0[3]);
            v[4] = sigm(v[4] + b1[0]); v[5] = sigm(v[5] + b1[1]); v[6] = sigm(v[6] + b1[2]); v[7] = sigm(v[7] + b1[3]);
            *(u32x4*)(O + (size_t)row * 4096 + col) = pack8(v);
        EPI_LOOP_END
    }
};
struct EpiMod {
    static constexpr bool PERM = true, AFTER_DRAIN = false, HOOK = false;
    float* O; const float* bias;
    __device__ __forceinline__ void operator()(const f32x4 (&acc)[2][2][4][2], const Unit& u, int wr, int wc, int fr, int fq) const {
        EPI_LOOP_BEGIN
            const f32x4 b0 = *(const f32x4*)(bias + col), b1 = *(const f32x4*)(bias + col + 4);
            *(f32x4*)(O + (size_t)row * 12288 + col) = (f32x4){v[0] + b0[0], v[1] + b0[1], v[2] + b0[2], v[3] + b0[3]};
            *(f32x4*)(O + (size_t)row * 12288 + col + 4) = (f32x4){v[4] + b1[0], v[5] + b1[1], v[6] + b1[2], v[7] + b1[3]};
        EPI_LOOP_END
    }
};
struct EpiBranch {
    static constexpr bool PERM = true, AFTER_DRAIN = false, HOOK = true;
    bf16_t* O; const bf16_t* G; const bf16_t* G2;
    __device__ __forceinline__ void hook(f32x4 (&acc)[2][2][4][2], const Unit& u, int kb, int wr, int wc, int fr, int fq) const {
        __builtin_amdgcn_sched_barrier(0);
#pragma unroll
        for (int ai = 0; ai < 2; ++ai)
#pragma unroll
            for (int m = 0; m < 4; ++m) { const int row = u.pm * BM + ai * HALF + wr * 64 + m * 16 + fr;
#pragma unroll
                for (int bj = 0; bj < 2; ++bj) { const int col = u.pn * BM + bj * HALF + wc * 32 + 8 * fq;
                    const bf16_t* gp = (row < 16384 ? G : G2) + (size_t)row * 4096 + kb * 1024 + col;
                    float g0[8], g1[8]; unpack8(*(const u32x4*)gp, g0); unpack8(*(const u32x4*)(gp + 1024), g1);
#pragma unroll
                    for (int j = 0; j < 4; ++j) { acc[ai][bj][m][0][j] *= g0[j] * __builtin_amdgcn_rcpf(g1[j]); acc[ai][bj][m][1][j] *= g0[4 + j] * __builtin_amdgcn_rcpf(g1[4 + j]); }
                }
                __builtin_amdgcn_sched_barrier(0); }
    }
    __device__ __forceinline__ void operator()(const f32x4 (&acc)[2][2][4][2], const Unit& u, int wr, int wc, int fr, int fq) const {
        EPI_LOOP_BEGIN
            float g[8]; unpack8(*(const u32x4*)((row < 16384 ? G : G2) + (size_t)row * 4096 + 3072 + col), g);
#pragma unroll
            for (int j = 0; j < 8; ++j) v[j] *= g[j];
            *(u32x4*)(O + (size_t)row * 1024 + col) = pack8(v);
        EPI_LOOP_END
    }
};
struct EpiRes {
    static constexpr bool PERM = true, AFTER_DRAIN = false, HOOK = false;
    float* X; const float* res0; const float* res1; const float* gmod; int row0;
    __device__ __forceinline__ void operator()(const f32x4 (&acc)[2][2][4][2], const Unit& u, int wr, int wc, int fr, int fq) const {
        EPI_LOOP_BEGIN
            const int grow = row + row0;
            const float* rp = (grow < 16384 ? res0 + (size_t)grow * 1024 : res1 + (size_t)(grow - 16384) * 1024) + col;
            const float* gp = gmod + (size_t)cond_of_row(grow) * 12288 + col;
            const f32x4 r0 = *(const f32x4*)rp, r1 = *(const f32x4*)(rp + 4), g0 = *(const f32x4*)gp, g1 = *(const f32x4*)(gp + 4);
            *(f32x4*)(X + (size_t)grow * 1024 + col) = (f32x4){r0[0] + g0[0] * v[0], r0[1] + g0[1] * v[1], r0[2] + g0[2] * v[2], r0[3] + g0[3] * v[3]};
            *(f32x4*)(X + (size_t)grow * 1024 + col + 4) = (f32x4){r1[0] + g1[0] * v[4], r1[1] + g1[1] * v[5], r1[2] + g1[2] * v[6], r1[3] + g1[3] * v[7]};
        EPI_LOOP_END
    }
};
struct EpiRelu2 {
    static constexpr bool PERM = true, AFTER_DRAIN = false, HOOK = false;
    bf16_t* O;
    __device__ __forceinline__ void operator()(const f32x4 (&acc)[2][2][4][2], const Unit& u, int wr, int wc, int fr, int fq) const {
        EPI_LOOP_BEGIN
#pragma unroll
            for (int j = 0; j < 8; ++j) { const float r = fmaxf(v[j], 0.f); v[j] = r * r; }
            *(u32x4*)(O + (size_t)row * 4096 + col) = pack8(v);
        EPI_LOOP_END
    }
};
template <class Epi, class Sched, bool ALIGN_EPI = false, bool SP2 = false>
__device__ __forceinline__ void gemm_phase(PG8_LAS unsigned char* lds, const Gemm g, const Sched& S, const Epi& E) {
    const int tid = threadIdx.x, wid = __builtin_amdgcn_readfirstlane(tid >> 6), lane = tid & 63, wr = wid >> 2, wc = wid & 3, fr = lane & 15, fq = lane >> 4;
    const int K = g.K, nt = K / BK;
    unsigned voffA[2], voffB[2];
#pragma unroll
    for (int i = 0; i < 2; ++i) { int R, C; stage_rc(tid * 16 + i * 8192, R, C); const int Rb = Epi::PERM ? ((R & ~31) + perm32(R & 31)) : R;
        voffA[i] = (unsigned)(R * K + C) * 2u; voffB[i] = (unsigned)(Rb * K + C) * 2u; }
    const size_t kstep = (size_t)(BK * 2);
    const size_t hstep = (size_t)HALF * K * 2;
    const size_t tstep = 2 * hstep;
    const unsigned ldsw = (unsigned)wid * 1024u;
    const int aoff = lds_byte(wr * 64 + fr, fq * 8), boff = lds_byte(wc * 32 + fr, fq * 8);
#define PG8_SA(b, h) (((b) * 2 + (h)) * HTB)
#define PG8_SB(b, h) ((4 + (b) * 2 + (h)) * HTB)
#define PG8_STAGE(bufoff, gbase, voff) do { _Pragma("unroll") for (int _i = 0; _i < 2; ++_i) \
        __builtin_amdgcn_global_load_lds((const unsigned*)((const char*)(gbase) + (voff)[_i]), (PG8_LAS unsigned*)(lds + (bufoff) + ldsw + _i * 8192), 16, 0, 0); } while (0)
#define PG8_LDA(dst, b, h) do { _Pragma("unroll") for (int m = 0; m < 4; ++m) _Pragma("unroll") for (int k = 0; k < 2; ++k) dst[m][k] = *(const PG8_LAS bf16x8*)(lds + PG8_SA(b, h) + aoff + m * 2048 + k * 1024); } while (0)
#define PG8_LDB(dst, b, h) do { _Pragma("unroll") for (int n = 0; n < 2; ++n) _Pragma("unroll") for (int k = 0; k < 2; ++k) dst[n][k] = *(const PG8_LAS bf16x8*)(lds + PG8_SB(b, h) + boff + n * 2048 + k * 1024); } while (0)
#define PG8_MMA(ai, bj, At, Bt) do { __builtin_amdgcn_s_setprio(1); _Pragma("unroll") for (int m = 0; m < 4; ++m) _Pragma("unroll") for (int n = 0; n < 2; ++n) _Pragma("unroll") for (int k = 0; k < 2; ++k) \
        acc[ai][bj][m][n] = __builtin_amdgcn_mfma_f32_16x16x32_bf16(Bt[n][k], At[m][k], acc[ai][bj][m][n], 0, 0, 0); __builtin_amdgcn_s_setprio(0); } while (0)
#define PG8_WAIT_V(n) asm volatile("s_waitcnt vmcnt(" #n ")" ::: "memory")
#define PG8_WAIT_L(n) asm volatile("s_waitcnt lgkmcnt(" #n ")" ::: "memory")
#define PG8_BAR __builtin_amdgcn_s_barrier()
#define PG8_SCHED __builtin_amdgcn_sched_barrier(0)
    Unit cur, nxt; int ui = 0;
    if (!S.next(0, cur)) return;
    f32x4 acc[2][2][4][2];
#pragma unroll
    for (int a = 0; a < 2; ++a)
#pragma unroll
        for (int b = 0; b < 2; ++b)
#pragma unroll
            for (int m = 0; m < 4; ++m)
#pragma unroll
                for (int n = 0; n < 2; ++n) acc[a][b][m][n] = (f32x4){0.f, 0.f, 0.f, 0.f};
    bf16x8 At[4][2], B0[2][2], B1[2][2];
    const char* cA = (const char*)g.A + (size_t)cur.pm * tstep; const char* cB = (const char*)g.Bt + (size_t)cur.pn * tstep;
    S.a_ready(cur);
    if constexpr (SP2) {
        PG8_STAGE(PG8_SB(0, 0), cB, voffB); PG8_STAGE(PG8_SB(0, 1), cB + hstep, voffB); PG8_STAGE(PG8_SA(0, 0), cA, voffA); PG8_STAGE(PG8_SA(0, 1), cA + hstep, voffA);
        if (wr == 1) PG8_BAR;
        PG8_WAIT_V(2); PG8_BAR;
        PG8_STAGE(PG8_SB(1, 0), cB + kstep, voffB); PG8_STAGE(PG8_SA(1, 0), cA + kstep, voffA); PG8_STAGE(PG8_SB(1, 1), cB + hstep + kstep, voffB);
        PG8_WAIT_V(6); PG8_BAR;
    } else {
        PG8_STAGE(PG8_SB(0, 0), cB, voffB); PG8_STAGE(PG8_SA(0, 0), cA, voffA); PG8_STAGE(PG8_SB(0, 1), cB + hstep, voffB); PG8_STAGE(PG8_SA(0, 1), cA + hstep, voffA);
        if (wr == 1) PG8_BAR;
        PG8_WAIT_V(4); PG8_BAR;
        PG8_STAGE(PG8_SB(1, 0), cB + kstep, voffB); PG8_STAGE(PG8_SA(1, 0), cA + kstep, voffA); PG8_STAGE(PG8_SB(1, 1), cB + hstep + kstep, voffB);
        PG8_WAIT_V(6); PG8_BAR;
    }
    for (;;) {
        const bool has_next = S.next(ui + 1, nxt);
        const char* nA = has_next ? (const char*)g.A + (size_t)nxt.pm * tstep : cA; const char* nB = has_next ? (const char*)g.Bt + (size_t)nxt.pn * tstep : cB;
        for (int t = 0; t < nt; t += 2) {
            const bool last = (t == nt - 2);
            const char* a1 = cA + (size_t)(t + 1) * kstep;
            const char* a2 = last ? nA : cA + (size_t)(t + 2) * kstep; const char* b2 = last ? nB : cB + (size_t)(t + 2) * kstep;
            const char* a3 = a2 + kstep; const char* b3 = b2 + kstep;
            if (last && has_next) S.a_ready(nxt);
            if constexpr (SP2) {
            PG8_LDB(B0, 0, 0); PG8_LDB(B1, 0, 1); PG8_SCHED; PG8_LDA(At, 0, 0); PG8_STAGE(PG8_SA(1, 1), a1 + hstep, voffA);
            PG8_WAIT_V(8); PG8_WAIT_L(0); PG8_BAR; PG8_MMA(0, 0, At, B0); PG8_MMA(0, 1, At, B1); PG8_BAR; PG8_SCHED;
            PG8_LDA(At, 0, 1); PG8_STAGE(PG8_SB(0, 0), b2, voffB); PG8_STAGE(PG8_SB(0, 1), b2 + hstep, voffB); PG8_STAGE(PG8_SA(0, 0), a2, voffA);
            PG8_WAIT_V(8); PG8_WAIT_L(0); PG8_BAR; PG8_MMA(1, 0, At, B0); PG8_MMA(1, 1, At, B1); PG8_BAR; PG8_SCHED;
            PG8_LDB(B0, 1, 0); PG8_LDB(B1, 1, 1); PG8_SCHED; PG8_LDA(At, 1, 0); PG8_STAGE(PG8_SA(0, 1), a2 + hstep, voffA);
            PG8_WAIT_V(8); PG8_WAIT_L(0); PG8_BAR; PG8_MMA(0, 0, At, B0); PG8_MMA(0, 1, At, B1); PG8_BAR; PG8_SCHED;
            PG8_LDA(At, 1, 1); PG8_STAGE(PG8_SB(1, 0), b3, voffB); PG8_STAGE(PG8_SB(1, 1), b3 + hstep, voffB); PG8_STAGE(PG8_SA(1, 0), a3, voffA);
            PG8_WAIT_V(8); PG8_WAIT_L(0); PG8_BAR; PG8_MMA(1, 0, At, B0); PG8_MMA(1, 1, At, B1); PG8_BAR; PG8_SCHED;
            } else {
            PG8_LDB(B0, 0, 0); PG8_SCHED; PG8_LDA(At, 0, 0); PG8_STAGE(PG8_SA(1, 1), a1 + hstep, voffA);
            PG8_WAIT_L(8); PG8_BAR; PG8_WAIT_L(0); PG8_MMA(0, 0, At, B0); PG8_BAR; PG8_SCHED;
            PG8_LDB(B1, 0, 1); PG8_STAGE(PG8_SB(0, 0), b2, voffB);
            PG8_BAR; PG8_WAIT_L(0); PG8_MMA(0, 1, At, B1); PG8_BAR;
            PG8_LDA(At, 0, 1); PG8_STAGE(PG8_SA(0, 0), a2, voffA);
            PG8_BAR; PG8_WAIT_L(0); PG8_MMA(1, 0, At, B0); PG8_BAR; PG8_SCHED;
            PG8_STAGE(PG8_SB(0, 1), b2 + hstep, voffB);
            PG8_WAIT_V(6); PG8_BAR; PG8_MMA(1, 1, At, B1); PG8_BAR;
            PG8_LDB(B0, 1, 0); PG8_SCHED; PG8_LDA(At, 1, 0); PG8_STAGE(PG8_SA(0, 1), a2 + hstep, voffA);
            PG8_WAIT_L(8); PG8_BAR; PG8_WAIT_L(0); PG8_MMA(0, 0, At, B0); PG8_BAR; PG8_SCHED;
            PG8_LDB(B1, 1, 1); PG8_STAGE(PG8_SB(1, 0), b3, voffB);
            PG8_BAR; PG8_WAIT_L(0); PG8_MMA(0, 1, At, B1); PG8_BAR;
            PG8_LDA(At, 1, 1); PG8_STAGE(PG8_SA(1, 0), a3, voffA);
            PG8_BAR; PG8_WAIT_L(0); PG8_MMA(1, 0, At, B0); PG8_BAR; PG8_SCHED;
            PG8_STAGE(PG8_SB(1, 1), b3 + hstep, voffB);
            PG8_WAIT_V(6); PG8_BAR; PG8_MMA(1, 1, At, B1); PG8_BAR;
            }
            if constexpr (Epi::HOOK) { if ((((t + 2) & 7) == 0) && !last) E.hook(acc, cur, ((t + 2) >> 3) - 1, wr, wc, fr, fq); }
        }
        if constexpr (ALIGN_EPI) { if (wr == 0) PG8_BAR; }
        if constexpr (!Epi::AFTER_DRAIN) { E(acc, cur, wr, wc, fr, fq); S.done(cur); }
        if (!has_next) break;
#pragma unroll
        for (int a = 0; a < 2; ++a)
#pragma unroll
            for (int b = 0; b < 2; ++b)
#pragma unroll
                for (int m = 0; m < 4; ++m)
#pragma unroll
                    for (int n = 0; n < 2; ++n) acc[a][b][m][n] = (f32x4){0.f, 0.f, 0.f, 0.f};
        cur = nxt; cA = nA; cB = nB; ++ui;
        if constexpr (ALIGN_EPI) { if (wr == 1) PG8_BAR; }
    }
    PG8_WAIT_V(0);
    if constexpr (!ALIGN_EPI) { if (wr == 0) PG8_BAR; }
    PG8_BAR;
    if constexpr (Epi::AFTER_DRAIN) { E.fused(acc, cur, wr, wc, fr, fq, lds, wid, lane); S.done(cur); }
#undef PG8_SA
#undef PG8_SB
#undef PG8_STAGE
#undef PG8_LDA
#undef PG8_LDB
#undef PG8_MMA
#undef PG8_WAIT_V
#undef PG8_WAIT_L
#undef PG8_BAR
#undef PG8_SCHED
}
}
#ifndef MK_SINGLE
#define MK_SINGLE 1
#endif
#define LAS __attribute__((address_space(3)))
typedef unsigned short bf16;
typedef unsigned v4u __attribute__((ext_vector_type(4)));
typedef unsigned v2u __attribute__((ext_vector_type(2)));
typedef float f32x4 __attribute__((ext_vector_type(4)));
using pg8::sigm; using pg8::silu_; using pg8::tanh_; using pg8::cvt_pk_bf16; using pg8::unpack8; using pg8::pack8; using pg8::cond_of_row;

constexpr int NTOK = 17408, NPR = 16384, DM = 1024, BW = 512, INC = 5888;
constexpr int LDS_BYTES = 147456, MISC_OFF = 144 * 1024 - 1024, TAB_OFF = MISC_OFF + 64;
constexpr size_t MiB = 1u << 20;
constexpr size_t WS_CTL = 0, CTL_BYTES = 65536;
constexpr size_t WS_MOD = 1 * MiB;
constexpr size_t WS_CA = 13 * MiB;
constexpr size_t WS_WIN = 14 * MiB;
constexpr size_t WS_WG = WS_WIN + 5888u * 1024 * 2;
constexpr size_t WS_WB = WS_WG + 8 * MiB;
constexpr size_t WS_WO = WS_WB + 4 * MiB;
constexpr size_t WS_W1 = WS_WO + 2 * MiB;
constexpr size_t WS_W2 = WS_W1 + 8 * MiB;
constexpr size_t WS_H = 56 * MiB;
constexpr size_t WS_BR = 90 * MiB;
constexpr size_t WS_G = 158 * MiB;
constexpr size_t WS_BIG = 192 * MiB;
constexpr size_t WS_SSP = WS_BIG + (size_t)NTOK * INC * 2;
constexpr size_t WS_RST = WS_SSP + (size_t)NTOK * 16 * 4;
constexpr size_t WS_GS = WS_RST + (size_t)NTOK * 32 * 4;
constexpr size_t WS_END = WS_GS + (size_t)(NTOK - NPR) * 4096 * 2;
static_assert(WS_W2 + 8 * MiB <= WS_H, "ws map");
constexpr size_t O_HG_P = 17825792, O_RW_P = 18874368, O_SH_P = 19398656, O_CV_P = 19427328, O_LH_P = 19673088, O_LC_P = 19681280;
constexpr size_t O_HG_S = 19705856, O_RW_S = 36483072, O_SH_S = 44871680, O_CV_S = 45330432, O_LH_S = 49262592, O_LC_S = 49393664;
enum { I_XP = 0, I_XS, I_SHG, I_SRW, I_SSH, I_SCV, I_SLH, I_SLC, I_CP, I_CS, I_ADAW, I_ADAB, I_NMIX, I_NMLP, I_NFIN, I_WIN, I_HGL, I_HGN, I_MU, I_W0, I_WUP, I_A0, I_AUP, I_GUP,
       I_KK, I_KA, I_RK, I_LNG, I_LNB, I_CFDW, I_CFDWB, I_CFLG, I_CFLB, I_LCW, I_LCB, I_LWA, I_LBA, I_LWX, I_LBX, I_LAM, I_WBR, I_WGATE, I_BGATE, I_WOUT, I_WM1, I_WM2 };

struct Args { const float* in[46]; float* out; unsigned char* ws; int ph_lo, ph_hi; };
struct MArgs { float* out; unsigned char* ws; };
extern __shared__ __attribute__((aligned(16))) unsigned char lds_raw[];
__device__ __forceinline__ const float* inp_(int i) {
    const LAS unsigned* t = (const LAS unsigned*)((LAS unsigned char*)lds_raw + TAB_OFF) + 2 * i;
    const unsigned lo = __builtin_amdgcn_readfirstlane(t[0]), hi = __builtin_amdgcn_readfirstlane(t[1]);
    return (const float*)(((unsigned long long)hi << 32) | lo);
}
#define INP(i) inp_(i)

template <int CTRL> __device__ __forceinline__ float dppf(float v) { return __builtin_bit_cast(float, __builtin_amdgcn_update_dpp(0, __builtin_bit_cast(int, v), CTRL, 0xF, 0xF, true)); }
__device__ __forceinline__ float red4(float v) { v += dppf<0xB1>(v); v += dppf<0x4E>(v); return v; }
__device__ __forceinline__ float red8(float v) { v = red4(v); v += dppf<0x141>(v); return v; }
__device__ __forceinline__ float red16(float v) { v = red8(v); v += dppf<0x140>(v); return v; }
__device__ __forceinline__ float wave_sum(float v) {
#pragma unroll
    for (int o = 1; o < 64; o <<= 1) v += __shfl_xor(v, o);
    return v;
}
__device__ __forceinline__ float bf2f(bf16 b) { return __uint_as_float((unsigned)b << 16); }
__device__ __forceinline__ void unpack4(const v2u w, float (&f)[4]) { f[0] = __uint_as_float(w.x << 16); f[1] = __uint_as_float(w.x & 0xffff0000u); f[2] = __uint_as_float(w.y << 16); f[3] = __uint_as_float(w.y & 0xffff0000u); }
__device__ __forceinline__ v2u pack4(float a, float b, float c, float d) { v2u w; w.x = cvt_pk_bf16(a, b); w.y = cvt_pk_bf16(c, d); return w; }
#define LDS_WAIT() asm volatile("s_waitcnt lgkmcnt(0)" ::: "memory")

__device__ __forceinline__ v4u gload16(const void* p) { v4u r; asm volatile("global_load_dwordx4 %0, %1, off" : "=v"(r) : "v"(p) : "memory"); return r; }
__device__ __forceinline__ v2u gload8(const void* p) { v2u r; asm volatile("global_load_dwordx2 %0, %1, off" : "=v"(r) : "v"(p) : "memory"); return r; }
__device__ __forceinline__ unsigned gload4(const void* p) { unsigned r; asm volatile("global_load_dword %0, %1, off" : "=v"(r) : "v"(p) : "memory"); return r; }
#define LDS_BARRIER() asm volatile("s_waitcnt lgkmcnt(0)\n\ts_barrier" ::: "memory")
#define VM_DRAIN_KNOWN() __builtin_amdgcn_s_waitcnt(0x0F70)
__device__ __forceinline__ void tr_item(const float* W, int K, int N, bf16* WT, int ldt, int row_off, int col_off, LAS float* scr, int item, int lane) {
    const int nblk = N / 32, kb = item / nblk, nb = item % nblk, k0 = 64 * kb, n0 = 32 * nb;
#pragma unroll 8
    for (int i = 0; i < 32; ++i) { const int kk = 2 * i + (lane >> 5); scr[kk * 33 + (lane & 31)] = W[(size_t)(k0 + kk) * N + n0 + (lane & 31)]; }
    LDS_WAIT(); asm volatile("" ::: "memory");
    const int c = lane & 7;
#pragma unroll
    for (int j = 0; j < 4; ++j) { const int n = (lane >> 3) + 8 * j; const LAS float* s = scr + (8 * c) * 33 + n;
        v4u o; o.x = cvt_pk_bf16(s[0 * 33], s[1 * 33]); o.y = cvt_pk_bf16(s[2 * 33], s[3 * 33]); o.z = cvt_pk_bf16(s[4 * 33], s[5 * 33]); o.w = cvt_pk_bf16(s[6 * 33], s[7 * 33]);
        *(v4u*)(WT + (size_t)(row_off + n0 + n) * ldt + col_off + k0 + 8 * c) = o; }
    LDS_WAIT(); asm volatile("" ::: "memory");
}

__device__ __forceinline__ void phase_conv_ada(const Args& a, LAS unsigned char* lds, int gw, int NGW, int wave, int lane) {
    LAS float* scr = (LAS float*)(lds + wave * 16384);
    bf16* ADAT = (bf16*)(a.ws + WS_BIG);
    constexpr int IPL = 16 * 192;
    for (int it = gw; it < 2 * IPL; it += NGW) { const int l = it / IPL; tr_item(INP(I_ADAW) + (size_t)l * 1024 * 6144, 1024, 6144, ADAT, 1024, l * 6144, 0, scr, it % IPL, lane); }
    bf16* CA = (bf16*)(a.ws + WS_CA);
    for (int r = gw; r < 256; r += NGW) {
        const float* cp = r < 8 ? INP(I_CP) + r * 1024 : INP(I_CS) + (r - 8) * 1024;
#pragma unroll
        for (int j = 0; j < 4; ++j) { const int c = (lane + 64 * j) * 4; f32x4 v = (f32x4){0.f, 0.f, 0.f, 0.f}; if (r < 136) { v = *(const f32x4*)(cp + c); v[0] = silu_(v[0]); v[1] = silu_(v[1]); v[2] = silu_(v[2]); v[3] = silu_(v[3]); }
            *(v2u*)(CA + r * 1024 + c) = pack4(v[0], v[1], v[2], v[3]); }
    }
}
__device__ __forceinline__ void phase_conv_layer(const Args& a, int l, LAS unsigned char* lds, int gw, int NGW, int wave, int lane, int it_lo, int it_hi) {
    LAS float* scr = (LAS float*)(lds + wave * 16384);
    constexpr int I_IN = 16 * 184, I_G = 16 * 128, I_B = 4 * 256, I_O = 16 * 32, I_1 = 16 * 128, I_2 = 64 * 32, NIT = I_IN + I_G + I_B + I_O + I_1 + I_2;
    static_assert(NIT == 10624 && NIT - I_2 == 8576, "item map");
    for (int it = it_lo + gw; it < it_hi; it += NGW) {
        int r = it;
        if (r < I_IN) { tr_item(INP(I_WIN) + (size_t)l * 1024 * 5888, 1024, 5888, (bf16*)(a.ws + WS_WIN), 1024, 0, 0, scr, r, lane); continue; } r -= I_IN;
        if (r < I_G) { tr_item(INP(I_WGATE) + (size_t)l * 1024 * 4096, 1024, 4096, (bf16*)(a.ws + WS_WG), 1024, 0, 0, scr, r, lane); continue; } r -= I_G;
        if (r < I_B) { const int k = r >> 8; tr_item(INP(I_WBR) + (size_t)(l * 4 + k) * 512 * 1024, 512, 1024, (bf16*)(a.ws + WS_WB), 2048, 0, k * 512, scr, r & 255, lane); continue; } r -= I_B;
        if (r < I_O) { tr_item(INP(I_WOUT) + (size_t)l * 1024 * 1024, 1024, 1024, (bf16*)(a.ws + WS_WO), 1024, 0, 0, scr, r, lane); continue; } r -= I_O;
        if (r < I_1) { tr_item(INP(I_WM1) + (size_t)l * 1024 * 4096, 1024, 4096, (bf16*)(a.ws + WS_W1), 1024, 0, 0, scr, r, lane); continue; } r -= I_1;
        tr_item(INP(I_WM2) + (size_t)l * 4096 * 1024, 4096, 1024, (bf16*)(a.ws + WS_W2), 4096, 0, 0, scr, r, lane);
    }
}
__device__ __forceinline__ void phase_norm(const Args& a, int l, int sel, int gw, int NGW, int lane, int row_lo = 0, int row_hi = NTOK) {
    const float* MOD = (const float*)(a.ws + WS_MOD); bf16* H = (bf16*)(a.ws + WS_H);
    const float* gn = (sel == 0 ? INP(I_NMIX) : INP(I_NMLP)) + l * 1024;
    for (int row = row_lo + gw; row < row_hi; row += NGW) {
        const float* xr = (l == 0 && sel == 0) ? (row < NPR ? INP(I_XP) + (size_t)row * 1024 : INP(I_XS) + (size_t)(row - NPR) * 1024) : a.out + (size_t)row * 1024;
        f32x4 v[4]; float ss = 0.f;
#pragma unroll
        for (int j = 0; j < 4; ++j) { v[j] = *(const f32x4*)(xr + (lane + 64 * j) * 4); ss += (v[j][0] * v[j][0] + v[j][1] * v[j][1]) + (v[j][2] * v[j][2] + v[j][3] * v[j][3]); }
        const float rstd = rsqrtf(wave_sum(ss) * (1.f / 1024.f) + 1e-6f);
        const float* mp = MOD + (size_t)cond_of_row(row) * 12288 + l * 6144 + sel * 3072;
#pragma unroll
        for (int j = 0; j < 4; ++j) { const int c = (lane + 64 * j) * 4; const f32x4 g = *(const f32x4*)(gn + c), sh = *(const f32x4*)(mp + c), sc = *(const f32x4*)(mp + 1024 + c);
            float o[4];
#pragma unroll
            for (int i = 0; i < 4; ++i) o[i] = v[j][i] * rstd * g[i] * (1.f + sc[i]) + sh[i];
            *(v2u*)(H + (size_t)row * 1024 + c) = pack4(o[0], o[1], o[2], o[3]); }
    }
}
__device__ __forceinline__ void phase_final(const Args& a, int gw, int NGW, int lane) {
    const float* gn = INP(I_NFIN);
    for (int row = gw; row < NTOK; row += NGW) {
        float* xr = a.out + (size_t)row * 1024;
        f32x4 v[4]; float ss = 0.f;
#pragma unroll
        for (int j = 0; j < 4; ++j) { v[j] = *(const f32x4*)(xr + (lane + 64 * j) * 4); ss += (v[j][0] * v[j][0] + v[j][1] * v[j][1]) + (v[j][2] * v[j][2] + v[j][3] * v[j][3]); }
        const float rstd = rsqrtf(wave_sum(ss) * (1.f / 1024.f) + 1e-6f);
#pragma unroll
        for (int j = 0; j < 4; ++j) { const int c = (lane + 64 * j) * 4; const f32x4 g = *(const f32x4*)(gn + c);
            *(f32x4*)(xr + c) = (f32x4){v[j][0] * rstd * g[0], v[j][1] * rstd * g[1], v[j][2] * rstd * g[2], v[j][3] * rstd * g[3]}; }
    }
}
__device__ __forceinline__ void phase_hg_post(const Args& a, int gw, int NGW, int lane) {
    bf16* BR = (bf16*)(a.ws + WS_BR); const float* SSP = (const float*)(a.ws + WS_SSP); const float* RST = (const float*)(a.ws + WS_RST); const bf16* GC = (const bf16*)(a.ws + WS_G);
    for (int row = gw; row < NTOK; row += NGW) {
        { const int h = lane >> 4; const f32x4 s4 = *(const f32x4*)(SSP + (size_t)row * 16 + h * 4);
          const float rstd = rsqrtf(((s4[0] + s4[1]) + (s4[2] + s4[3])) * (1.f / 128.f) + 1e-6f);
          bf16* p = BR + (size_t)row * 2048 + lane * 8; float v[8]; unpack8(*(const v4u*)p, v);
#pragma unroll
          for (int j = 0; j < 8; ++j) v[j] *= rstd;
          *(v4u*)p = pack8(v); }
        { const int h = lane >> 3; const f32x4 s4 = *(const f32x4*)(RST + (size_t)row * 32 + h * 4);
          const float mean = (s4[0] + s4[2]) * (1.f / 64.f), var = fmaxf((s4[1] + s4[3]) * (1.f / 64.f) - mean * mean, 0.f), rstd = rsqrtf(var + 64e-5f);
          bf16* p = BR + (size_t)row * 2048 + 512 + lane * 8; float y[8], c1[8], c2[8]; unpack8(*(const v4u*)p, y);
          unpack8(*(const v4u*)(GC + (size_t)row * 1024 + lane * 8), c1); unpack8(*(const v4u*)(GC + (size_t)row * 1024 + 512 + lane * 8), c2);
#pragma unroll
          for (int j = 0; j < 8; ++j) y[j] = (y[j] - mean) * rstd * c1[j] + c2[j];
          *(v4u*)p = pack8(y); }
    }
}

#define SEQ_SETUP const bool smp = seq >= 8; const int T = smp ? 8 : 2048; const int row0 = smp ? NPR + (seq - 8) * 8 : seq * 2048; const int bs = seq - 8; \
    const int Bg = smp ? 128 : 8; const int bo = smp ? bs : seq; (void)Bg; (void)bo; (void)bs;

typedef float f32x2 __attribute__((ext_vector_type(2)));
struct HgVec { f32x4 q0, q1, k0, k1, v4; };
__device__ __forceinline__ void hg_load(HgVec& X, const LAS float* b, const LAS float* pv) {
    X.q0 = *(const LAS f32x4*)b; X.q1 = *(const LAS f32x4*)(b + 4); X.k0 = *(const LAS f32x4*)(b + 8192); X.k1 = *(const LAS f32x4*)(b + 8192 + 4); X.v4 = *(const LAS f32x4*)pv;
}
__device__ __forceinline__ float hg_step1(f32x2 (&s)[4], const HgVec& X, float vv) {
    const f32x2 v2 = {vv, vv};
    s[0] = s[0] + X.k0.lo * (v2 - s[0]); s[1] = s[1] + X.k0.hi * (v2 - s[1]); s[2] = s[2] + X.k1.lo * (v2 - s[2]); s[3] = s[3] + X.k1.hi * (v2 - s[3]);
    f32x2 o = s[0] * X.q0.lo; o = s[1] * X.q0.hi + o; f32x2 p = s[2] * X.q1.lo; p = s[3] * X.q1.hi + p; o = o + p;
    return red16(o.x + o.y);
}
struct HgPre { v4u q, k, v; v2u og; };
#define HG_PF_WAIT(P) asm volatile("s_waitcnt vmcnt(0)" : "+v"(P.q), "+v"(P.k), "+v"(P.v), "+v"(P.og) :: "memory")
__device__ __forceinline__ void hg_prefetch(HgPre& P, const bf16* PROJ, int rowc, int tleft, int tid, int h, int vh) {
    const int t = tid >> 4;
    if (t < tleft) { const bf16* p = PROJ + (size_t)(rowc + t) * INC + h * 128; P.q = gload16(p + (tid & 15) * 8); P.k = gload16(p + 512 + (tid & 15) * 8); P.og = gload8(p + 1536 + vh * 64 + (tid & 15) * 4); }
    if (tid < 256 && (tid >> 3) < tleft) P.v = gload16(PROJ + (size_t)(rowc + (tid >> 3)) * INC + 1024 + h * 128 + vh * 64 + (tid & 7) * 8);
}
__device__ __forceinline__ void hg_unit(LAS unsigned char* lds, const MArgs& a, int tid_in, int l, int seq, int h, int vh, int mode) {
    SEQ_SETUP
    const int tid = tid_in, ds = tid & 15, v = ((tid >> 4) & 15) * 4;
    const bf16* PROJ = (const bf16*)(a.ws + WS_BIG); bf16* BR = (bf16*)(a.ws + WS_BR); float* SSP = (float*)(a.ws + WS_SSP);
    LAS float* SQ = (LAS float*)lds; LAS float* SK = SQ + 8192; LAS float* SV = SK + 8192; LAS float* SO = SV + 4096;
    HgPre P0, P1; P0.q = (v4u){0u, 0u, 0u, 0u}; P0.k = P0.q; P0.v = P0.q; P0.og = (v2u){0u, 0u}; P1 = P0;
    hg_prefetch(P0, PROJ, row0, T, tid, h, vh); hg_prefetch(P1, PROJ, row0 + 32, T - 32, tid, h, vh);
    f32x2 sc[4][4];
    if (smp && tid < 256) { const float* sp = INP(I_SHG) + ((size_t)(l * 128 + bs) * 4 + h) * 16384 + vh * 64 + v;
#pragma unroll
        for (int j = 0; j < 4; ++j) { const f32x4 x0 = *(const f32x4*)(sp + (ds * 8 + 2 * j) * 128), x1 = *(const f32x4*)(sp + (ds * 8 + 2 * j + 1) * 128);
#pragma unroll
            for (int c = 0; c < 4; ++c) sc[c][j] = (f32x2){x0[c], x1[c]}; } }
    else {
#pragma unroll
        for (int c = 0; c < 4; ++c)
#pragma unroll
            for (int j = 0; j < 4; ++j) sc[c][j] = (f32x2){0.f, 0.f}; }
    const f32x4 hg4 = *(const f32x4*)(INP(I_HGN) + l * 512 + h * 128 + vh * 64 + (tid & 15) * 4);
    VM_DRAIN_KNOWN();
    HG_PF_WAIT(P0); HG_PF_WAIT(P1);
    for (int t0 = 0; t0 < T; t0 += 64) {
        const int tc = (T - t0) < 64 ? (T - t0) : 64;
        const HgPre C0 = P0, C1 = P1;
        if (!(mode & 4)) {
#pragma unroll
          for (int hh = 0; hh < 2; ++hh) { const HgPre& C = hh ? C1 : C0; const int t = (tid >> 4) + 32 * hh, d8 = (tid & 15) * 8;
            if (t < tc) { float q[8], k[8]; unpack8(C.q, q); unpack8(C.k, k);
              *(LAS f32x4*)(SQ + t * 128 + d8) = (f32x4){q[0], q[1], q[2], q[3]}; *(LAS f32x4*)(SQ + t * 128 + d8 + 4) = (f32x4){q[4], q[5], q[6], q[7]};
              *(LAS f32x4*)(SK + t * 128 + d8) = (f32x4){k[0], k[1], k[2], k[3]}; *(LAS f32x4*)(SK + t * 128 + d8 + 4) = (f32x4){k[4], k[5], k[6], k[7]}; }
            if (tid < 256) { const int t2 = (tid >> 3) + 32 * hh, c8 = (tid & 7) * 8;
              if (t2 < tc) { float x[8]; unpack8(C.v, x);
                  *(LAS f32x4*)(SV + t2 * 64 + c8) = (f32x4){x[0], x[1], x[2], x[3]}; *(LAS f32x4*)(SV + t2 * 64 + c8 + 4) = (f32x4){x[4], x[5], x[6], x[7]}; } } } }
        if (t0 + 64 < T) { hg_prefetch(P0, PROJ, row0 + t0 + 64, T - t0 - 64, tid, h, vh); hg_prefetch(P1, PROJ, row0 + t0 + 96, T - t0 - 96, tid, h, vh); }
        LDS_BARRIER();
        if (tid < 256 && !(mode & 2)) { const LAS float* bq = SQ + ds * 8; const LAS float* pv = SV + v;
          HgVec A, B; hg_load(A, bq, pv);
          for (int t = 0; t < tc; t += 2) {
              hg_load(B, bq + (t + 1) * 128, pv + (t + 1) * 64);
              { const f32x4 o = {hg_step1(sc[0], A, A.v4[0]), hg_step1(sc[1], A, A.v4[1]), hg_step1(sc[2], A, A.v4[2]), hg_step1(sc[3], A, A.v4[3])}; if (ds == 0) *(LAS f32x4*)(SO + t * 64 + v) = o; }
              if (t + 2 < tc) hg_load(A, bq + (t + 2) * 128, pv + (t + 2) * 64);
              { const f32x4 o = {hg_step1(sc[0], B, B.v4[0]), hg_step1(sc[1], B, B.v4[1]), hg_step1(sc[2], B, B.v4[2]), hg_step1(sc[3], B, B.v4[3])}; if (ds == 0) *(LAS f32x4*)(SO + (t + 1) * 64 + v) = o; }
          } }
        LDS_BARRIER();
#pragma unroll
        for (int hh = 0; hh < 2; ++hh) { const HgPre& C = hh ? C1 : C0; const int t = (tid >> 4) + 32 * hh, c4 = (tid & 15) * 4;
          if (t < tc && !(mode & 1)) { const int row = row0 + t0 + t; const f32x4 o4 = *(const LAS f32x4*)(SO + t * 64 + c4);
              const float ssq = red8((o4[0] * o4[0] + o4[1] * o4[1]) + (o4[2] * o4[2] + o4[3] * o4[3]));
              if ((tid & 7) == 0) SSP[(size_t)row * 16 + h * 4 + vh * 2 + ((tid & 15) >> 3)] = ssq;
              float g[4]; unpack4(C.og, g);
              *(v2u*)(BR + (size_t)row * 2048 + h * 128 + vh * 64 + c4) = pack4(o4[0] * g[0] * hg4[0], o4[1] * g[1] * hg4[1], o4[2] * g[2] * hg4[2], o4[3] * g[3] * hg4[3]); } }
        HG_PF_WAIT(P0); HG_PF_WAIT(P1);
    }
    if (tid < 256 && !(mode & 1)) { float* so = a.out + (smp ? O_HG_S : O_HG_P) + ((size_t)(l * Bg + bo) * 4 + h) * 16384 + vh * 64 + v;
#pragma unroll
        for (int j = 0; j < 4; ++j) { *(f32x4*)(so + (ds * 8 + 2 * j) * 128) = (f32x4){sc[0][j].x, sc[1][j].x, sc[2][j].x, sc[3][j].x}; *(f32x4*)(so + (ds * 8 + 2 * j + 1) * 128) = (f32x4){sc[0][j].y, sc[1][j].y, sc[2][j].y, sc[3][j].y}; } }
    __syncthreads();
}

struct RwPre { v4u lc0, lc1, lp0, lp1; v2u rc, kc, vc, rp, kp, vp; };
__device__ __forceinline__ void rwkv_prefetch(RwPre& P, const bf16* PROJ, const float* shs, bool smp, int row0, int tg, int sub, int hc) {
    const bf16* pc = PROJ + (size_t)(row0 + tg) * INC + 2048;
    P.lc0 = gload16(pc + 1536 + sub * 16); P.lc1 = gload16(pc + 1536 + sub * 16 + 8);
    P.rc = gload8(pc + hc); P.kc = gload8(pc + 512 + hc); P.vc = gload8(pc + 1024 + hc);
    if (tg > 0) { P.lp0 = gload16(pc - INC + 1536 + sub * 16); P.lp1 = gload16(pc - INC + 1536 + sub * 16 + 8);
        P.rp = gload8(pc - INC + hc); P.kp = gload8(pc - INC + 512 + hc); P.vp = gload8(pc - INC + 1024 + hc); }
    else if (smp) {
        const float* q = shs + 1536 + sub * 16; float t8[8];
#pragma unroll
        for (int i = 0; i < 8; ++i) t8[i] = q[i];
        P.lp0 = pack8(t8);
#pragma unroll
        for (int i = 0; i < 8; ++i) t8[i] = q[8 + i];
        P.lp1 = pack8(t8);
        P.rp = pack4(shs[hc], shs[hc + 1], shs[hc + 2], shs[hc + 3]); P.kp = pack4(shs[512 + hc], shs[512 + hc + 1], shs[512 + hc + 2], shs[512 + hc + 3]);
        P.vp = pack4(shs[1024 + hc], shs[1024 + hc + 1], shs[1024 + hc + 2], shs[1024 + hc + 3]); }
    else { P.lp0 = (v4u){0u, 0u, 0u, 0u}; P.lp1 = P.lp0; P.rp = (v2u){0u, 0u}; P.kp = P.rp; P.vp = P.rp; }
}
#define RW_PF_WAIT(P) asm volatile("s_waitcnt vmcnt(0)" : "+v"(P.lc0), "+v"(P.lc1), "+v"(P.lp0), "+v"(P.lp1), "+v"(P.rc), "+v"(P.kc), "+v"(P.vc), "+v"(P.rp), "+v"(P.kp), "+v"(P.vp) :: "memory")
struct RwVec { f32x4 r, w, k, q, e; f32x2 vv; };
__device__ __forceinline__ void rw_load(RwVec& X, const LAS float* b, const LAS float* pv) {
    X.r = *(const LAS f32x4*)b; X.w = *(const LAS f32x4*)(b + 2048); X.k = *(const LAS f32x4*)(b + 4096); X.q = *(const LAS f32x4*)(b + 6144); X.e = *(const LAS f32x4*)(b + 8192); X.vv = *(const LAS f32x2*)pv;
}
__device__ __forceinline__ f32x2 rw_step2(f32x2 (&s0)[2], f32x2 (&s1)[2], const RwVec& X) {
    f32x2 a0 = s0[0] * X.q.lo; a0 = s0[1] * X.q.hi + a0; f32x2 a1 = s1[0] * X.q.lo; a1 = s1[1] * X.q.hi + a1;
    const float sa0 = -red16(a0.x + a0.y), sa1 = -red16(a1.x + a1.y);
    const f32x2 p0 = {sa0, sa0}, p1 = {sa1, sa1}, v0 = {X.vv.x, X.vv.x}, v1 = {X.vv.y, X.vv.y};
    s0[0] = s0[0] * X.w.lo + (p0 * X.e.lo + v0 * X.k.lo); s0[1] = s0[1] * X.w.hi + (p0 * X.e.hi + v0 * X.k.hi);
    s1[0] = s1[0] * X.w.lo + (p1 * X.e.lo + v1 * X.k.lo); s1[1] = s1[1] * X.w.hi + (p1 * X.e.hi + v1 * X.k.hi);
    f32x2 y0 = s0[0] * X.r.lo; y0 = s0[1] * X.r.hi + y0; f32x2 y1 = s1[0] * X.r.lo; y1 = s1[1] * X.r.hi + y1;
    return (f32x2){red16(y0.x + y0.y), red16(y1.x + y1.y)};
}
__device__ __forceinline__ void rwkv_unit(LAS unsigned char* lds, const MArgs& a, int tid_in, int l, int seq, int h, int half, int mode) {
    SEQ_SETUP
    const int tid = tid_in, lane = tid & 63, wave = __builtin_amdgcn_readfirstlane(tid >> 6);
    const bf16* PROJ = (const bf16*)(a.ws + WS_BIG); bf16* BR = (bf16*)(a.ws + WS_BR);
    LAS bf16* WUPT = (LAS bf16*)(lds + 65664); LAS bf16* AUPT = WUPT + 64 * 72; LAS bf16* GUPT = AUPT + 64 * 72;
    LAS bf16* LRB = (LAS bf16*)(lds + 65664 + 35840);
    LAS float* LWA = (LAS float*)(lds + 65664 + 52736);
    LAS float* SR = (LAS float*)(lds + 0); LAS float* SW = SR + 2048; LAS float* SK = SW + 2048; LAS float* SKK = SK + 2048; LAS float* SKA = SKK + 2048;
    LAS float* SV = SKA + 2048; LAS float* SG = SV + 2048; LAS float* SY = SG + 2048; LAS float* SB = SY + 2048;
    const int st = tid >> 4, sub = tid & 15, c4 = sub * 4, hc = h * 64 + c4;
    const float* mu = INP(I_MU) + l * 1792;
    const float* shs = INP(I_SSH) + (size_t)(l * 128 + (smp ? bs : 0)) * 1792;
    RwPre P;
    P.lc0 = (v4u){0u, 0u, 0u, 0u}; P.lc1 = P.lc0; P.lp0 = P.lc0; P.lp1 = P.lc0; P.rc = (v2u){0u, 0u}; P.kc = P.rc; P.vc = P.rc; P.rp = P.rc; P.kp = P.rc; P.vp = P.rc;
    if (st < T) rwkv_prefetch(P, PROJ, shs, smp, row0, st, sub, hc);
    RW_PF_WAIT(P);
    { const int j = tid >> 3, c8 = (tid & 7) * 8;
      const float* p = INP(I_WUP) + ((size_t)l * 64 + j) * 512 + h * 64 + c8; f32x4 x0 = *(const f32x4*)p, x1 = *(const f32x4*)(p + 4);
#pragma unroll
      for (int i = 0; i < 4; ++i) { WUPT[(c8 + i) * 72 + j] = (bf16)(cvt_pk_bf16(x0[i], 0.f) & 0xffffu); WUPT[(c8 + 4 + i) * 72 + j] = (bf16)(cvt_pk_bf16(x1[i], 0.f) & 0xffffu); }
      p = INP(I_AUP) + ((size_t)l * 64 + j) * 512 + h * 64 + c8; x0 = *(const f32x4*)p; x1 = *(const f32x4*)(p + 4);
#pragma unroll
      for (int i = 0; i < 4; ++i) { AUPT[(c8 + i) * 72 + j] = (bf16)(cvt_pk_bf16(x0[i], 0.f) & 0xffffu); AUPT[(c8 + 4 + i) * 72 + j] = (bf16)(cvt_pk_bf16(x1[i], 0.f) & 0xffffu); }
#pragma unroll
      for (int r = 0; r < 2; ++r) { const int jj = j + 64 * r; p = INP(I_GUP) + ((size_t)l * 128 + jj) * 512 + h * 64 + c8; x0 = *(const f32x4*)p; x1 = *(const f32x4*)(p + 4);
#pragma unroll
          for (int i = 0; i < 4; ++i) { GUPT[(c8 + i) * 136 + jj] = (bf16)(cvt_pk_bf16(x0[i], 0.f) & 0xffffu); GUPT[(c8 + 4 + i) * 136 + jj] = (bf16)(cvt_pk_bf16(x1[i], 0.f) & 0xffffu); } } }
    const bool both = smp;
    const int hsel = both ? (tid >> 8) : half;
    const int sv = hsel * 32 + ((tid >> 4) & 15) * 2, ks = tid & 15;
    f32x2 s0[2], s1[2];
    if (smp) { const float* sp = INP(I_SRW) + ((size_t)(l * 128 + bs) * 8 + h) * 4096 + sv * 64 + ks * 4; const f32x4 x0 = *(const f32x4*)sp, x1 = *(const f32x4*)(sp + 64);
        s0[0] = x0.lo; s0[1] = x0.hi; s1[0] = x1.lo; s1[1] = x1.hi; }
    else { s0[0] = (f32x2){0.f, 0.f}; s0[1] = s0[0]; s1[0] = s0[0]; s1[1] = s0[0]; }
    f32x4 pw0, pa0, pkk, pka, prk, plg, plb;
    { pw0 = *(const f32x4*)(INP(I_W0) + l * 512 + hc); pa0 = *(const f32x4*)(INP(I_A0) + l * 512 + hc); pkk = *(const f32x4*)(INP(I_KK) + l * 512 + hc); pka = *(const f32x4*)(INP(I_KA) + l * 512 + hc);
      prk = *(const f32x4*)(INP(I_RK) + l * 512 + hc); plg = *(const f32x4*)(INP(I_LNG) + l * 512 + hc); plb = *(const f32x4*)(INP(I_LNB) + l * 512 + hc); }
    VM_DRAIN_KNOWN();
    for (int t0 = 0; t0 < T; t0 += 32) {
        const int tc = (T - t0) < 32 ? (T - t0) : 32;
        const int grow = row0 + t0 + st;
        const RwPre C = P;
        if (st < tc && !(mode & 4)) { const int j0 = sub * 16;
#pragma unroll
            for (int hh = 0; hh < 2; ++hh) { float xc[8], xp[8]; unpack8(hh ? C.lc1 : C.lc0, xc); unpack8(hh ? C.lp1 : C.lp0, xp);
                const f32x4 m0 = *(const f32x4*)(mu + 1536 + j0 + 8 * hh), m1 = *(const f32x4*)(mu + 1536 + j0 + 8 * hh + 4);
                float o[8];
#pragma unroll
                for (int i = 0; i < 8; ++i) { float x = xc[i] + (xp[i] - xc[i]) * (i < 4 ? m0[i] : m1[i - 4]); o[i] = j0 < 64 ? tanh_(x) : (j0 < 128 ? x : sigm(x)); }
                *(LAS v4u*)(LRB + st * 264 + j0 + 8 * hh) = pack8(o); } }
        LDS_BARRIER();
        { const int mt = wave >> 2, nt = wave & 3, fr = lane & 15, fq = lane >> 4;
          if (mt * 16 < tc && !(mode & 4)) {
              f32x4 cw = {0.f, 0.f, 0.f, 0.f}, ca = {0.f, 0.f, 0.f, 0.f}, cgt = {0.f, 0.f, 0.f, 0.f};
              const LAS bf16* ar = LRB + (mt * 16 + fr) * 264 + fq * 8;
#pragma unroll
              for (int kk = 0; kk < 2; ++kk) {
                  cw = __builtin_amdgcn_mfma_f32_16x16x32_bf16(*(const LAS pg8::bf16x8*)(ar + kk * 32), *(const LAS pg8::bf16x8*)(WUPT + (nt * 16 + fr) * 72 + kk * 32 + fq * 8), cw, 0, 0, 0);
                  ca = __builtin_amdgcn_mfma_f32_16x16x32_bf16(*(const LAS pg8::bf16x8*)(ar + 64 + kk * 32), *(const LAS pg8::bf16x8*)(AUPT + (nt * 16 + fr) * 72 + kk * 32 + fq * 8), ca, 0, 0, 0); }
#pragma unroll
              for (int kk = 0; kk < 4; ++kk)
                  cgt = __builtin_amdgcn_mfma_f32_16x16x32_bf16(*(const LAS pg8::bf16x8*)(ar + 128 + kk * 32), *(const LAS pg8::bf16x8*)(GUPT + (nt * 16 + fr) * 136 + kk * 32 + fq * 8), cgt, 0, 0, 0);
#pragma unroll
              for (int j = 0; j < 4; ++j) { const int o = (mt * 16 + fq * 4 + j) * 64 + nt * 16 + fr; LWA[o] = cw[j]; LWA[2048 + o] = ca[j]; LWA[4096 + o] = cgt[j]; } } }
        LDS_BARRIER();
        if (st < tc && !(mode & 4)) {
            const f32x4 lw = *(const LAS f32x4*)(LWA + st * 64 + c4), la = *(const LAS f32x4*)(LWA + 2048 + st * 64 + c4), lg = *(const LAS f32x4*)(LWA + 4096 + st * 64 + c4);
            float r4[4], k4[4], v4[4];
            { float rc[4], kc[4], vc[4], rp[4], kp[4], vp[4]; unpack4(C.rc, rc); unpack4(C.kc, kc); unpack4(C.vc, vc); unpack4(C.rp, rp); unpack4(C.kp, kp); unpack4(C.vp, vp);
              const f32x4 mr = *(const f32x4*)(mu + hc), mk = *(const f32x4*)(mu + 512 + hc), mv = *(const f32x4*)(mu + 1024 + hc);
#pragma unroll
              for (int i = 0; i < 4; ++i) { r4[i] = rc[i] + (rp[i] - rc[i]) * mr[i]; k4[i] = kc[i] + (kp[i] - kc[i]) * mk[i]; v4[i] = vc[i] + (vp[i] - vc[i]) * mv[i]; } }
            float wd[4], av[4], kkr[4]; float ssq = 0.f;
#pragma unroll
            for (int i = 0; i < 4; ++i) { wd[i] = __expf(-0.606531f * sigm(pw0[i] + lw[i])); av[i] = sigm(pa0[i] + la[i]); kkr[i] = k4[i] * pkk[i]; ssq += kkr[i] * kkr[i]; }
            ssq = red16(ssq); const float inv = 1.f / fmaxf(sqrtf(ssq), 1e-12f);
            float bon = 0.f; float k2[4], kkv[4], kav[4];
#pragma unroll
            for (int i = 0; i < 4; ++i) { kkv[i] = kkr[i] * inv; k2[i] = k4[i] * (1.f + (av[i] - 1.f) * pka[i]); kav[i] = kkv[i] * av[i]; bon += r4[i] * k2[i] * prk[i]; }
            *(LAS f32x4*)(SR + st * 64 + c4) = (f32x4){r4[0], r4[1], r4[2], r4[3]}; *(LAS f32x4*)(SW + st * 64 + c4) = (f32x4){wd[0], wd[1], wd[2], wd[3]};
            *(LAS f32x4*)(SK + st * 64 + c4) = (f32x4){k2[0], k2[1], k2[2], k2[3]}; *(LAS f32x4*)(SKK + st * 64 + c4) = (f32x4){kkv[0], kkv[1], kkv[2], kkv[3]};
            *(LAS f32x4*)(SKA + st * 64 + c4) = (f32x4){kav[0], kav[1], kav[2], kav[3]}; *(LAS f32x4*)(SV + st * 64 + c4) = (f32x4){v4[0], v4[1], v4[2], v4[3]};
            *(LAS f32x4*)(SG + st * 64 + c4) = lg;
            bon = red16(bon); if (sub == 0) SB[st] = bon;
        }
        if (t0 + 32 + st < T) rwkv_prefetch(P, PROJ, shs, smp, row0, t0 + 32 + st, sub, hc);
        LDS_BARRIER();
        if ((both || tid < 256) && !(mode & 2)) { const LAS float* b0 = SR + ks * 4; const LAS float* pv = SV + sv;
          RwVec A, B; rw_load(A, b0, pv);
          for (int t = 0; t < tc; t += 2) {
              rw_load(B, b0 + (t + 1) * 64, pv + (t + 1) * 64);
              const f32x2 ya = rw_step2(s0, s1, A);
              if (ks == 0) *(LAS f32x2*)(SY + t * 64 + sv) = ya;
              if (t + 2 < tc) rw_load(A, b0 + (t + 2) * 64, pv + (t + 2) * 64);
              const f32x2 yb = rw_step2(s0, s1, B);
              if (ks == 0) *(LAS f32x2*)(SY + (t + 1) * 64 + sv) = yb;
          } }
        RW_PF_WAIT(P);
        LDS_BARRIER();
        if (st < tc && (both || (sub >> 3) == half) && !(mode & 1)) {
            const f32x4 y4 = *(const LAS f32x4*)(SY + st * 64 + c4);
            const float sy = red8((y4[0] + y4[1]) + (y4[2] + y4[3])), sq = red8((y4[0] * y4[0] + y4[1] * y4[1]) + (y4[2] * y4[2] + y4[3] * y4[3]));
            if ((sub & 7) == 0) *(f32x2*)((float*)(a.ws + WS_RST) + (size_t)grow * 32 + h * 4 + (sub >> 3) * 2) = (f32x2){sy, sq};
            const float bon = SB[st];
            const f32x4 vv4 = *(const LAS f32x4*)(SV + st * 64 + c4), gg4 = *(const LAS f32x4*)(SG + st * 64 + c4);
            float c1[4], c2[4];
#pragma unroll
            for (int i = 0; i < 4; ++i) { c1[i] = plg[i] * gg4[i]; c2[i] = (plb[i] + bon * vv4[i]) * gg4[i]; }
            *(v2u*)(BR + (size_t)grow * 2048 + 512 + hc) = pack4(y4[0], y4[1], y4[2], y4[3]);
            bf16* GC = (bf16*)(a.ws + WS_G) + (size_t)grow * 1024;
            *(v2u*)(GC + hc) = pack4(c1[0], c1[1], c1[2], c1[3]); *(v2u*)(GC + 512 + hc) = pack4(c2[0], c2[1], c2[2], c2[3]);
        }
    }
    if ((both || tid < 256) && !(mode & 1)) { float* so = a.out + (smp ? O_RW_S : O_RW_P) + ((size_t)(l * Bg + bo) * 8 + h) * 4096 + sv * 64 + ks * 4;
      *(f32x4*)so = (f32x4){s0[0].x, s0[0].y, s0[1].x, s0[1].y}; *(f32x4*)(so + 64) = (f32x4){s1[0].x, s1[0].y, s1[1].x, s1[1].y}; }
    { float* sh = a.out + (smp ? O_SH_S : O_SH_P) + (size_t)(l * Bg + bo) * 1792; const bf16* pl = PROJ + (size_t)(row0 + T - 1) * INC + 2048;
      if ((both || half == 0) && tid < 64 && !(mode & 1)) { sh[h * 64 + tid] = bf2f(pl[h * 64 + tid]); sh[512 + h * 64 + tid] = bf2f(pl[512 + h * 64 + tid]); sh[1024 + h * 64 + tid] = bf2f(pl[1024 + h * 64 + tid]); }
      if ((both || half == 0) && h == 0 && tid >= 256 && !(mode & 1)) sh[1536 + tid - 256] = bf2f(pl[1536 + tid - 256]); }
    __syncthreads();
}

__device__ __forceinline__ void rw_load16(RwVec& X, const LAS float* b, const LAS float* pv) {
    X.r = *(const LAS f32x4*)b; X.w = *(const LAS f32x4*)(b + 1024); X.k = *(const LAS f32x4*)(b + 2048); X.q = *(const LAS f32x4*)(b + 3072); X.e = *(const LAS f32x4*)(b + 4096); X.vv = *(const LAS f32x2*)pv;
}
#define RW_SCAN16(TLO, THI) do { const LAS float* b0_ = Sc + ks * 4; const LAS float* pv_ = Sc + 5120 + sv; LAS float* sy_ = SY + (c & 1) * 1024 + sv; \
        RwVec A_, B_; rw_load16(A_, b0_ + (TLO) * 64, pv_ + (TLO) * 64); \
        for (int t = (TLO); t < (THI); t += 2) { rw_load16(B_, b0_ + (t + 1) * 64, pv_ + (t + 1) * 64); \
            const f32x2 ya_ = rw_step2(s0, s1, A_); if (ks == 0) *(LAS f32x2*)(sy_ + t * 64) = ya_; \
            if (t + 2 < (THI)) rw_load16(A_, b0_ + (t + 2) * 64, pv_ + (t + 2) * 64); \
            const f32x2 yb_ = rw_step2(s0, s1, B_); if (ks == 0) *(LAS f32x2*)(sy_ + (t + 1) * 64) = yb_; } } while (0)
#define RWPC_PF_LR(P, pcp) do { P.lc0 = gload16((pcp) + 1536 + sub * 16); P.lc1 = gload16((pcp) + 1536 + sub * 16 + 8); P.lp0 = gload16((pcp) - INC + 1536 + sub * 16); P.lp1 = gload16((pcp) - INC + 1536 + sub * 16 + 8); } while (0)
#define RWPC_PF_RKV(P, pcp) do { P.rc = gload8((pcp) + hc); P.kc = gload8((pcp) + 512 + hc); P.vc = gload8((pcp) + 1024 + hc); P.rp = gload8((pcp) - INC + hc); P.kp = gload8((pcp) - INC + 512 + hc); P.vp = gload8((pcp) - INC + 1024 + hc); } while (0)
#define RWPC_WAIT_LR(P) asm volatile("s_waitcnt vmcnt(0)" : "+v"(P.lc0), "+v"(P.lc1), "+v"(P.lp0), "+v"(P.lp1) :: "memory")
#define RWPC_WAIT_RKV(P) asm volatile("s_waitcnt vmcnt(4)" : "+v"(P.rc), "+v"(P.kc), "+v"(P.vc), "+v"(P.rp), "+v"(P.kp), "+v"(P.vp) :: "memory")
__device__ __forceinline__ void rwkv_unit_pc(LAS unsigned char* lds, const MArgs& a, int tid_in, int l, int seq, int h, int half) {
    constexpr int T = 2048, NC = T / 16;
    const int row0 = seq * 2048;
    const int tid = tid_in, lane = tid & 63, wave = __builtin_amdgcn_readfirstlane(tid >> 6);
    const bool prod = wave >= 4;
    const bf16* PROJ = (const bf16*)(a.ws + WS_BIG); bf16* BR = (bf16*)(a.ws + WS_BR);
    LAS float* SS = (LAS float*)lds;
    LAS float* SY = (LAS float*)(lds + 57344);
    LAS float* SB = (LAS float*)(lds + 65536);
    LAS bf16* WUPT = (LAS bf16*)(lds + 65664); LAS bf16* AUPT = WUPT + 64 * 72; LAS bf16* GUPT = AUPT + 64 * 72;
    LAS bf16* LRB = (LAS bf16*)(lds + 101504);
    LAS float* LWA = (LAS float*)(lds + 109952);
    const int st = (tid & 255) >> 4, sub = tid & 15, c4 = sub * 4, hc = h * 64 + c4;
    const float* mu = INP(I_MU) + l * 1792;
    RwPre P;
    P.lc0 = (v4u){0u, 0u, 0u, 0u}; P.lc1 = P.lc0; P.lp0 = P.lc0; P.lp1 = P.lc0; P.rc = (v2u){0u, 0u}; P.kc = P.rc; P.vc = P.rc; P.rp = P.rc; P.kp = P.rc; P.vp = P.rc;
    if (prod) { rwkv_prefetch(P, PROJ, mu, false, row0, st, sub, hc); RW_PF_WAIT(P); }
    { const int j = tid >> 3, c8 = (tid & 7) * 8;
      const float* p = INP(I_WUP) + ((size_t)l * 64 + j) * 512 + h * 64 + c8; f32x4 x0 = *(const f32x4*)p, x1 = *(const f32x4*)(p + 4);
#pragma unroll
      for (int i = 0; i < 4; ++i) { WUPT[(c8 + i) * 72 + j] = (bf16)(cvt_pk_bf16(x0[i], 0.f) & 0xffffu); WUPT[(c8 + 4 + i) * 72 + j] = (bf16)(cvt_pk_bf16(x1[i], 0.f) & 0xffffu); }
      p = INP(I_AUP) + ((size_t)l * 64 + j) * 512 + h * 64 + c8; x0 = *(const f32x4*)p; x1 = *(const f32x4*)(p + 4);
#pragma unroll
      for (int i = 0; i < 4; ++i) { AUPT[(c8 + i) * 72 + j] = (bf16)(cvt_pk_bf16(x0[i], 0.f) & 0xffffu); AUPT[(c8 + 4 + i) * 72 + j] = (bf16)(cvt_pk_bf16(x1[i], 0.f) & 0xffffu); }
#pragma unroll
      for (int r = 0; r < 2; ++r) { const int jj = j + 64 * r; p = INP(I_GUP) + ((size_t)l * 128 + jj) * 512 + h * 64 + c8; x0 = *(const f32x4*)p; x1 = *(const f32x4*)(p + 4);
#pragma unroll
          for (int i = 0; i < 4; ++i) { GUPT[(c8 + i) * 136 + jj] = (bf16)(cvt_pk_bf16(x0[i], 0.f) & 0xffffu); GUPT[(c8 + 4 + i) * 136 + jj] = (bf16)(cvt_pk_bf16(x1[i], 0.f) & 0xffffu); } } }
    const int sv = half * 32 + ((tid >> 4) & 15) * 2, ks = tid & 15;
    f32x2 s0[2], s1[2];
    s0[0] = (f32x2){0.f, 0.f}; s0[1] = s0[0]; s1[0] = s0[0]; s1[1] = s0[0];
    const f32x4 pw0 = *(const f32x4*)(INP(I_W0) + l * 512 + hc), pa0 = *(const f32x4*)(INP(I_A0) + l * 512 + hc), pkk = *(const f32x4*)(INP(I_KK) + l * 512 + hc), pka = *(const f32x4*)(INP(I_KA) + l * 512 + hc);
    const f32x4 prk = *(const f32x4*)(INP(I_RK) + l * 512 + hc), plg = *(const f32x4*)(INP(I_LNG) + l * 512 + hc), plb = *(const f32x4*)(INP(I_LNB) + l * 512 + hc);
    const f32x4 mr = *(const f32x4*)(mu + hc), mk = *(const f32x4*)(mu + 512 + hc), mv = *(const f32x4*)(mu + 1024 + hc);
    f32x4 ml[4];
#pragma unroll
    for (int i = 0; i < 4; ++i) ml[i] = *(const f32x4*)(mu + 1536 + sub * 16 + 4 * i);
    VM_DRAIN_KNOWN();
    LDS_BARRIER();
    for (int c = -1; c < NC; ++c) {
        const int pc = c + 1;
        LAS float* Sp = SS + (pc & 1) * 7168; const LAS float* Sc = SS + (c & 1) * 7168;
        if (prod && pc < NC) { const bf16* pcp = PROJ + (size_t)(row0 + pc * 16 + st) * INC + 2048; RWPC_PF_RKV(P, pcp); }
        if (prod) {
            if (pc < NC) { const int j0 = sub * 16;
#pragma unroll
                for (int hh = 0; hh < 2; ++hh) { float xc[8], xp[8]; unpack8(hh ? P.lc1 : P.lc0, xc); unpack8(hh ? P.lp1 : P.lp0, xp);
                    float o[8];
#pragma unroll
                    for (int i = 0; i < 8; ++i) { const float m_ = ml[2 * hh + (i >> 2)][i & 3]; float x = xc[i] + (xp[i] - xc[i]) * m_; o[i] = j0 < 64 ? tanh_(x) : (j0 < 128 ? x : sigm(x)); }
                    *(LAS v4u*)(LRB + st * 264 + j0 + 8 * hh) = pack8(o); } }
            if (pc + 1 < NC) { const bf16* pcp = PROJ + (size_t)(row0 + (pc + 1) * 16 + st) * INC + 2048; RWPC_PF_LR(P, pcp); }
        } else {
            if (c >= 1 && (sub >> 3) == half) {
                const int cc = c - 1, grow = row0 + cc * 16 + st; const LAS float* Sq = SS + (cc & 1) * 7168;
                const f32x4 y4 = *(const LAS f32x4*)(SY + (cc & 1) * 1024 + st * 64 + c4);
                const float sy = red8((y4[0] + y4[1]) + (y4[2] + y4[3])), sq = red8((y4[0] * y4[0] + y4[1] * y4[1]) + (y4[2] * y4[2] + y4[3] * y4[3]));
                if ((sub & 7) == 0) *(f32x2*)((float*)(a.ws + WS_RST) + (size_t)grow * 32 + h * 4 + half * 2) = (f32x2){sy, sq};
                const float bon = SB[(cc & 1) * 16 + st];
                const f32x4 vv4 = *(const LAS f32x4*)(Sq + 5120 + st * 64 + c4), gg4 = *(const LAS f32x4*)(Sq + 6144 + st * 64 + c4);
                float c1[4], c2[4];
#pragma unroll
                for (int i = 0; i < 4; ++i) { c1[i] = plg[i] * gg4[i]; c2[i] = (plb[i] + bon * vv4[i]) * gg4[i]; }
                *(v2u*)(BR + (size_t)grow * 2048 + 512 + hc) = pack4(y4[0], y4[1], y4[2], y4[3]);
                bf16* GC = (bf16*)(a.ws + WS_G) + (size_t)grow * 1024;
                *(v2u*)(GC + hc) = pack4(c1[0], c1[1], c1[2], c1[3]); *(v2u*)(GC + 512 + hc) = pack4(c2[0], c2[1], c2[2], c2[3]);
            }
            if (c >= 0) RW_SCAN16(0, 6);
        }
        LDS_BARRIER();
        if (prod) {
            if (pc < NC) { const int nt = wave - 4, fr = lane & 15, fq = lane >> 4;
                f32x4 cw = {0.f, 0.f, 0.f, 0.f}, ca = {0.f, 0.f, 0.f, 0.f}, cgt = {0.f, 0.f, 0.f, 0.f};
                const LAS bf16* ar = LRB + fr * 264 + fq * 8;
#pragma unroll
                for (int kk = 0; kk < 2; ++kk) {
                    cw = __builtin_amdgcn_mfma_f32_16x16x32_bf16(*(const LAS pg8::bf16x8*)(ar + kk * 32), *(const LAS pg8::bf16x8*)(WUPT + (nt * 16 + fr) * 72 + kk * 32 + fq * 8), cw, 0, 0, 0);
                    ca = __builtin_amdgcn_mfma_f32_16x16x32_bf16(*(const LAS pg8::bf16x8*)(ar + 64 + kk * 32), *(const LAS pg8::bf16x8*)(AUPT + (nt * 16 + fr) * 72 + kk * 32 + fq * 8), ca, 0, 0, 0); }
#pragma unroll
                for (int kk = 0; kk < 4; ++kk)
                    cgt = __builtin_amdgcn_mfma_f32_16x16x32_bf16(*(const LAS pg8::bf16x8*)(ar + 128 + kk * 32), *(const LAS pg8::bf16x8*)(GUPT + (nt * 16 + fr) * 136 + kk * 32 + fq * 8), cgt, 0, 0, 0);
#pragma unroll
                for (int j = 0; j < 4; ++j) { const int o = (fq * 4 + j) * 64 + nt * 16 + fr; LWA[o] = cw[j]; LWA[1024 + o] = ca[j]; LWA[2048 + o] = cgt[j]; } }
        } else if (c >= 0) RW_SCAN16(6, 12);
        LDS_BARRIER();
        if (prod) {
            if (pc + 1 >= NC) asm volatile("s_waitcnt vmcnt(0)" ::: "memory");
            RWPC_WAIT_RKV(P);
            if (pc == 0 && st == 0) { P.rp = (v2u){0u, 0u}; P.kp = P.rp; P.vp = P.rp; }
            if (pc < NC) {
                const f32x4 lw = *(const LAS f32x4*)(LWA + st * 64 + c4), la = *(const LAS f32x4*)(LWA + 1024 + st * 64 + c4), lg = *(const LAS f32x4*)(LWA + 2048 + st * 64 + c4);
                float r4[4], k4[4], v4[4];
                { float rc[4], kc[4], vc[4], rp[4], kp[4], vp[4]; unpack4(P.rc, rc); unpack4(P.kc, kc); unpack4(P.vc, vc); unpack4(P.rp, rp); unpack4(P.kp, kp); unpack4(P.vp, vp);
#pragma unroll
                  for (int i = 0; i < 4; ++i) { r4[i] = rc[i] + (rp[i] - rc[i]) * mr[i]; k4[i] = kc[i] + (kp[i] - kc[i]) * mk[i]; v4[i] = vc[i] + (vp[i] - vc[i]) * mv[i]; } }
                float wd[4], av[4], kkr[4]; float ssq = 0.f;
#pragma unroll
                for (int i = 0; i < 4; ++i) { wd[i] = __expf(-0.606531f * sigm(pw0[i] + lw[i])); av[i] = sigm(pa0[i] + la[i]); kkr[i] = k4[i] * pkk[i]; ssq += kkr[i] * kkr[i]; }
                ssq = red16(ssq); const float inv = 1.f / fmaxf(sqrtf(ssq), 1e-12f);
                float bon = 0.f; float k2[4], kkv[4], kav[4];
#pragma unroll
                for (int i = 0; i < 4; ++i) { kkv[i] = kkr[i] * inv; k2[i] = k4[i] * (1.f + (av[i] - 1.f) * pka[i]); kav[i] = kkv[i] * av[i]; bon += r4[i] * k2[i] * prk[i]; }
                LAS float* d = Sp + st * 64 + c4;
                *(LAS f32x4*)d = (f32x4){r4[0], r4[1], r4[2], r4[3]}; *(LAS f32x4*)(d + 1024) = (f32x4){wd[0], wd[1], wd[2], wd[3]};
                *(LAS f32x4*)(d + 2048) = (f32x4){k2[0], k2[1], k2[2], k2[3]}; *(LAS f32x4*)(d + 3072) = (f32x4){kkv[0], kkv[1], kkv[2], kkv[3]};
                *(LAS f32x4*)(d + 4096) = (f32x4){kav[0], kav[1], kav[2], kav[3]}; *(LAS f32x4*)(d + 5120) = (f32x4){v4[0], v4[1], v4[2], v4[3]};
                *(LAS f32x4*)(d + 6144) = lg;
                bon = red16(bon); if (sub == 0) SB[(pc & 1) * 16 + st] = bon;
            }
            RWPC_WAIT_LR(P);
        } else if (c >= 0) RW_SCAN16(12, 16);
        LDS_BARRIER();
    }
    if (!prod && (sub >> 3) == half) {
        const int cc = NC - 1, grow = row0 + cc * 16 + st; const LAS float* Sq = SS + (cc & 1) * 7168;
        const f32x4 y4 = *(const LAS f32x4*)(SY + (cc & 1) * 1024 + st * 64 + c4);
        const float sy = red8((y4[0] + y4[1]) + (y4[2] + y4[3])), sq = red8((y4[0] * y4[0] + y4[1] * y4[1]) + (y4[2] * y4[2] + y4[3] * y4[3]));
        if ((sub & 7) == 0) *(f32x2*)((float*)(a.ws + WS_RST) + (size_t)grow * 32 + h * 4 + half * 2) = (f32x2){sy, sq};
        const float bon = SB[(cc & 1) * 16 + st];
        const f32x4 vv4 = *(const LAS f32x4*)(Sq + 5120 + st * 64 + c4), gg4 = *(const LAS f32x4*)(Sq + 6144 + st * 64 + c4);
        float c1[4], c2[4];
#pragma unroll
        for (int i = 0; i < 4; ++i) { c1[i] = plg[i] * gg4[i]; c2[i] = (plb[i] + bon * vv4[i]) * gg4[i]; }
        *(v2u*)(BR + (size_t)grow * 2048 + 512 + hc) = pack4(y4[0], y4[1], y4[2], y4[3]);
        bf16* GC = (bf16*)(a.ws + WS_G) + (size_t)grow * 1024;
        *(v2u*)(GC + hc) = pack4(c1[0], c1[1], c1[2], c1[3]); *(v2u*)(GC + 512 + hc) = pack4(c2[0], c2[1], c2[2], c2[3]);
    }
    if (!prod) { float* so = a.out + O_RW_P + ((size_t)(l * 8 + seq) * 8 + h) * 4096 + sv * 64 + ks * 4;
      *(f32x4*)so = (f32x4){s0[0].x, s0[0].y, s0[1].x, s0[1].y}; *(f32x4*)(so + 64) = (f32x4){s1[0].x, s1[0].y, s1[1].x, s1[1].y}; }
    { float* sh = a.out + O_SH_P + (size_t)(l * 8 + seq) * 1792; const bf16* pl = PROJ + (size_t)(row0 + T - 1) * INC + 2048;
      if (half == 0 && tid < 64) { sh[h * 64 + tid] = bf2f(pl[h * 64 + tid]); sh[512 + h * 64 + tid] = bf2f(pl[512 + h * 64 + tid]); sh[1024 + h * 64 + tid] = bf2f(pl[1024 + h * 64 + tid]); }
      if (half == 0 && h == 0 && tid >= 256) sh[1536 + tid - 256] = bf2f(pl[1536 + tid - 256]); }
    __syncthreads();
}

struct LrPre { v2u x0, x1, x2, x3, g; };
#define LR_PF_WAIT(P) asm volatile("s_waitcnt vmcnt(0)" : "+v"(P.x0), "+v"(P.x1), "+v"(P.x2), "+v"(P.x3), "+v"(P.g) :: "memory")
__device__ __forceinline__ void lru_prefetch(LrPre& P, const bf16* PROJ, const float* cst, bool smp, int row0, int tg, int ch) {
    const bf16* p = PROJ + (size_t)(row0 + tg) * INC + 4864 + ch;
    P.g = gload8(p + 512); P.x3 = gload8(p);
    if (tg >= 3) { P.x2 = gload8(p - INC); P.x1 = gload8(p - 2 * INC); P.x0 = gload8(p - 3 * INC); }
    else {
        v2u* dst[3] = {&P.x2, &P.x1, &P.x0};
#pragma unroll
        for (int j = 0; j < 3; ++j) { const int ts = tg - 1 - j;
            if (ts >= 0) *dst[j] = gload8(p - (j + 1) * INC);
            else if (smp) { const float* q = cst + (3 + ts) * 512 + ch; *dst[j] = pack4(q[0], q[1], q[2], q[3]); }
            else *dst[j] = (v2u){0u, 0u}; } }
}
__device__ __forceinline__ void lru_unit(LAS unsigned char* lds, const MArgs& a, int tid_in, int l, int seq, int n) {
    SEQ_SETUP
    const int tid = tid_in, lane = tid & 63, wave = __builtin_amdgcn_readfirstlane(tid >> 6);
    const bf16* PROJ = (const bf16*)(a.ws + WS_BIG); bf16* BR = (bf16*)(a.ws + WS_BR);
    LAS bf16* WAT = (LAS bf16*)lds; LAS bf16* WXT = WAT + 64 * 72; LAS bf16* XCB = WXT + 64 * 72;
    LAS float* RA = (LAS float*)(lds + 23040); LAS float* RI = RA + 2048; LAS float* AA = RI + 2048; LAS float* BB = AA + 2048; LAS float* HS = BB + 2048;
    const int st = tid >> 4, sub = tid & 15, d4 = sub * 4, ch = n * 64 + d4;
    const float* cst = INP(I_SLC) + (size_t)(l * 128 + (smp ? bs : 0)) * 3 * 512;
    LrPre P; P.x0 = (v2u){0u, 0u}; P.x1 = P.x0; P.x2 = P.x0; P.x3 = P.x0; P.g = P.x0;
    if (st < T) lru_prefetch(P, PROJ, cst, smp, row0, st, ch);
    LR_PF_WAIT(P);
    { const int c = tid >> 3, d8 = (tid & 7) * 8;
      const float* p = INP(I_LWA) + (size_t)(l * 8 + n) * 4096 + c * 64 + d8; f32x4 x0 = *(const f32x4*)p, x1 = *(const f32x4*)(p + 4);
#pragma unroll
      for (int i = 0; i < 4; ++i) { WAT[(d8 + i) * 72 + c] = (bf16)(cvt_pk_bf16(x0[i], 0.f) & 0xffffu); WAT[(d8 + 4 + i) * 72 + c] = (bf16)(cvt_pk_bf16(x1[i], 0.f) & 0xffffu); }
      p = INP(I_LWX) + (size_t)(l * 8 + n) * 4096 + c * 64 + d8; x0 = *(const f32x4*)p; x1 = *(const f32x4*)(p + 4);
#pragma unroll
      for (int i = 0; i < 4; ++i) { WXT[(d8 + i) * 72 + c] = (bf16)(cvt_pk_bf16(x0[i], 0.f) & 0xffffu); WXT[(d8 + 4 + i) * 72 + c] = (bf16)(cvt_pk_bf16(x1[i], 0.f) & 0xffffu); } }
    float hprev = (smp && wave == 0) ? INP(I_SLH)[(size_t)(l * 128 + bs) * 512 + n * 64 + lane] : 0.f;
    float cw[4][4], cb[4], ba[4], bx[4], sp[4];
#pragma unroll
    for (int i = 0; i < 4; ++i) {
#pragma unroll
        for (int j = 0; j < 4; ++j) cw[j][i] = INP(I_LCW)[(l * 4 + j) * 512 + ch + i];
        cb[i] = INP(I_LCB)[l * 512 + ch + i]; ba[i] = INP(I_LBA)[l * 512 + ch + i]; bx[i] = INP(I_LBX)[l * 512 + ch + i];
        const float lam = INP(I_LAM)[l * 512 + ch + i]; sp[i] = log1pf(__expf(-lam)); }
    VM_DRAIN_KNOWN();
    for (int t0 = 0; t0 < T; t0 += 32) {
        const int tc = (T - t0) < 32 ? (T - t0) : 32;
        const int grow = row0 + t0 + st;
        const LrPre C = P;
        float xc[4], gl[4];
        if (st < tc) { float x0[4], x1[4], x2[4], x3[4]; unpack4(C.x0, x0); unpack4(C.x1, x1); unpack4(C.x2, x2); unpack4(C.x3, x3); unpack4(C.g, gl);
#pragma unroll
            for (int i = 0; i < 4; ++i) xc[i] = cb[i] + cw[0][i] * x0[i] + cw[1][i] * x1[i] + cw[2][i] * x2[i] + cw[3][i] * x3[i];
            *(LAS v2u*)(XCB + st * 72 + d4) = pack4(xc[0], xc[1], xc[2], xc[3]); }
        LDS_BARRIER();
        { const int mt = wave >> 2, nq = wave & 3, fr = lane & 15, fq = lane >> 4;
          if (mt * 16 < tc) {
              f32x4 ca = {0.f, 0.f, 0.f, 0.f}, cx = {0.f, 0.f, 0.f, 0.f};
#pragma unroll
              for (int kk = 0; kk < 2; ++kk) { const pg8::bf16x8 av = *(const LAS pg8::bf16x8*)(XCB + (mt * 16 + fr) * 72 + kk * 32 + fq * 8);
                  ca = __builtin_amdgcn_mfma_f32_16x16x32_bf16(av, *(const LAS pg8::bf16x8*)(WAT + (nq * 16 + fr) * 72 + kk * 32 + fq * 8), ca, 0, 0, 0);
                  cx = __builtin_amdgcn_mfma_f32_16x16x32_bf16(av, *(const LAS pg8::bf16x8*)(WXT + (nq * 16 + fr) * 72 + kk * 32 + fq * 8), cx, 0, 0, 0); }
#pragma unroll
              for (int j = 0; j < 4; ++j) { const int o = (mt * 16 + fq * 4 + j) * 64 + nq * 16 + fr; RA[o] = ca[j]; RI[o] = cx[j]; } } }
        LDS_BARRIER();
        if (st < tc) {
            const f32x4 ra = *(const LAS f32x4*)(RA + st * 64 + d4), ri = *(const LAS f32x4*)(RI + st * 64 + d4);
            float av[4], bv[4];
#pragma unroll
            for (int i = 0; i < 4; ++i) { const float rg = sigm(ra[i] + ba[i]), ig = sigm(ri[i] + bx[i]); const float la = -8.f * rg * sp[i]; av[i] = __expf(la); bv[i] = sqrtf(1.f - __expf(2.f * la)) * (ig * xc[i]); }
            *(LAS f32x4*)(AA + st * 64 + d4) = (f32x4){av[0], av[1], av[2], av[3]}; *(LAS f32x4*)(BB + st * 64 + d4) = (f32x4){bv[0], bv[1], bv[2], bv[3]};
        }
        if (t0 + 32 + st < T) lru_prefetch(P, PROJ, cst, smp, row0, t0 + 32 + st, ch);
        LDS_BARRIER();
        if (wave == 0) { float ar[32], br[32];
#pragma unroll
            for (int t = 0; t < 32; ++t) { ar[t] = AA[t * 64 + lane]; br[t] = BB[t * 64 + lane]; }
            float hh = hprev;
#pragma unroll
            for (int t = 0; t < 32; ++t) { if (t < tc) { hh = ar[t] * hh + br[t]; br[t] = hh; } }
#pragma unroll
            for (int t = 0; t < 32; ++t) HS[t * 64 + lane] = br[t];
            hprev = hh; }
        LDS_BARRIER();
        if (st < tc) { const f32x4 hs = *(const LAS f32x4*)(HS + st * 64 + d4);
            *(v2u*)(BR + (size_t)grow * 2048 + 1536 + ch) = pack4(hs[0] * gl[0], hs[1] * gl[1], hs[2] * gl[2], hs[3] * gl[3]); }
        LR_PF_WAIT(P);
    }
    if (wave == 0) a.out[(smp ? O_LH_S : O_LH_P) + (size_t)(l * Bg + bo) * 512 + n * 64 + lane] = hprev;
    if (tid < 192) { const int i = tid >> 6, c = tid & 63; a.out[(smp ? O_LC_S : O_LC_P) + ((size_t)(l * Bg + bo) * 3 + i) * 512 + n * 64 + c] = bf2f(PROJ[(size_t)(row0 + T - 3 + i) * INC + 4864 + n * 64 + c]); }
    __syncthreads();
}

template <int TC> __device__ __forceinline__ void cf_unit(LAS unsigned char* lds, const MArgs& a, int tid_in, int l, int seq, int t0, int tc) {
    SEQ_SETUP
    const int tid = tid_in, lane = tid & 63, wave = tid >> 6, c = tid;
    const bf16* PROJ = (const bf16*)(a.ws + WS_BIG); bf16* BR = (bf16*)(a.ws + WS_BR);
    LAS float* U = (LAS float*)lds;
    const float* cst = INP(I_SCV) + (size_t)(l * 128 + (smp ? bs : 0)) * 30 * 512;
    constexpr int NR = TC + 30, NP = (NR + 7) / 8;
    { v4u va[NP], vg[NP];
#pragma unroll
      for (int k = 0; k < NP; ++k) { const int i = wave + 8 * k, tt = t0 - 30 + i;
          if (i < tc + 30 && tt >= 0) { const bf16* p = PROJ + (size_t)(row0 + tt) * INC + 3840 + lane * 8; va[k] = *(const v4u*)p; vg[k] = *(const v4u*)(p + 512); } }
#pragma unroll
      for (int k = 0; k < NP; ++k) { const int i = wave + 8 * k, tt = t0 - 30 + i;
          if (i < tc + 30) { float u[8];
              if (tt >= 0) { float x[8], g[8]; unpack8(va[k], x); unpack8(vg[k], g);
#pragma unroll
                  for (int j = 0; j < 8; ++j) u[j] = x[j] * g[j]; }
              else if (smp) { const float* q = cst + (30 + tt) * 512 + lane * 8; const f32x4 q0 = *(const f32x4*)q, q1 = *(const f32x4*)(q + 4);
                  u[0] = q0[0]; u[1] = q0[1]; u[2] = q0[2]; u[3] = q0[3]; u[4] = q1[0]; u[5] = q1[1]; u[6] = q1[2]; u[7] = q1[3]; }
              else {
#pragma unroll
                  for (int j = 0; j < 8; ++j) u[j] = 0.f; }
              *(LAS f32x4*)(U + i * 512 + lane * 8) = (f32x4){u[0], u[1], u[2], u[3]}; *(LAS f32x4*)(U + i * 512 + lane * 8 + 4) = (f32x4){u[4], u[5], u[6], u[7]}; } } }
    float w[31];
#pragma unroll
    for (int j = 0; j < 31; ++j) w[j] = INP(I_CFDW)[(size_t)(l * 31 + j) * 512 + c];
    const float bias = INP(I_CFDWB)[l * 512 + c];
    __syncthreads();
    { float acc[TC];
#pragma unroll
      for (int t = 0; t < TC; ++t) acc[t] = bias;
#pragma unroll
      for (int i = 0; i < NR; ++i) { const float u = U[i * 512 + c];
#pragma unroll
          for (int t = 0; t < TC; ++t) { if (i - t >= 0 && i - t <= 30) acc[t] += u * w[i - t]; } }
#pragma unroll
      for (int t = 0; t < TC; ++t) { if (t < tc) U[t * 512 + c] = acc[t]; } }
    if (t0 + tc == T) { float* so = a.out + (smp ? O_CV_S : O_CV_P) + (size_t)(l * Bg + bo) * 30 * 512 + c;
#pragma unroll 6
        for (int i = 0; i < 30; ++i) so[i * 512] = U[(tc + i) * 512 + c]; }
    __syncthreads();
    for (int t = wave; t < tc; t += 8) {
        const f32x4 x0 = *(const LAS f32x4*)(U + t * 512 + lane * 8), x1 = *(const LAS f32x4*)(U + t * 512 + lane * 8 + 4);
        const float mean = wave_sum((x0[0] + x0[1]) + (x0[2] + x0[3]) + (x1[0] + x1[1]) + (x1[2] + x1[3])) * (1.f / 512.f);
        float d[8] = {x0[0] - mean, x0[1] - mean, x0[2] - mean, x0[3] - mean, x1[0] - mean, x1[1] - mean, x1[2] - mean, x1[3] - mean};
        float q = 0.f;
#pragma unroll
        for (int j = 0; j < 8; ++j) q += d[j] * d[j];
        const float rstd = rsqrtf(wave_sum(q) * (1.f / 512.f) + 1e-5f);
        const float* g = INP(I_CFLG) + l * 512 + lane * 8; const float* b = INP(I_CFLB) + l * 512 + lane * 8;
#pragma unroll
        for (int j = 0; j < 8; ++j) d[j] = silu_(d[j] * rstd * g[j] + b[j]);
        *(v4u*)(BR + (size_t)(row0 + t0 + t) * 2048 + 1024 + lane * 8) = pack8(d);
    }
    __syncthreads();
}

__device__ __forceinline__ void phase_mixers(const Args& a, int l, LAS unsigned char* lds, int rep = 0, int ulo = 0, int uhi = 3968, int mode = 0) {
    unsigned* ctr = (unsigned*)(a.ws + WS_CTL) + 64 * (1 + l + 2 * rep);
    volatile LAS unsigned* slot = (volatile LAS unsigned*)(lds + MISC_OFF);
    for (;;) {
        if (threadIdx.x == 0) slot[0] = atomicAdd(ctr, 1u);
        __syncthreads();
        const int u = (int)slot[0] + ulo;
        __syncthreads();
        if (u >= uhi) break;
        int kind, seq, p1, p2 = 0;
        if (u < 128) { kind = 0; seq = u >> 4; p1 = (u >> 1) & 7; p2 = u & 1; }
        else if (u < 192) { const int v = u - 128; kind = 1; seq = v >> 3; p1 = (v >> 1) & 3; p2 = v & 1; }
        else if (u < 256) { const int v = u - 192; kind = 2; seq = v >> 3; p1 = v & 7; }
        else if (u < 768) { const int v = u - 256; kind = 3; seq = v >> 6; p1 = (v & 63) * 32; p2 = 32; }
        else if (u < 1792) { const int v = u - 768; kind = 1; seq = 8 + (v >> 3); p1 = (v >> 1) & 3; p2 = v & 1; }
        else if (u < 2816) { const int v = u - 1792; kind = 0; seq = 8 + (v >> 3); p1 = v & 7; p2 = 0; }
        else if (u < 3840) { const int v = u - 2816; kind = 2; seq = 8 + (v >> 3); p1 = v & 7; }
        else { const int v = u - 3840; kind = 3; seq = 8 + v; p1 = 0; p2 = 8; }
        MArgs m; m.out = a.out; m.ws = a.ws; int ll = l;
        int tl = threadIdx.x;
        int md = mode;
        asm volatile("" : "+s"(m.out), "+s"(m.ws), "+s"(ll), "+v"(tl), "+s"(md));
        if (kind == 0) { if (seq < 8) rwkv_unit_pc(lds, m, tl, ll, seq, p1, p2); else rwkv_unit(lds, m, tl, ll, seq, p1, p2, md); }
        else if (kind == 1) hg_unit(lds, m, tl, ll, seq, p1, p2, md);
        else if (kind == 2) lru_unit(lds, m, tl, ll, seq, p1);
        else cf_unit<32>(lds, m, tl, ll, seq, p1, p2);
    }
}

#define XB_TMO      128
#define XB_XCNT(j)  (256  + 64 * (j))
#define XB_XSUB(j)  (1280 + 64 * (j))
#define XB_XGEN(j)  (2304 + 64 * (j))
#define XB_TOP      3328
#define XB_TOPGEN   3392
#define XCD_BAR_WORDS 3456
#define XB_SPIN_CAP (1u << 18)

__device__ __forceinline__ unsigned xb_ld(unsigned* p)              { return __hip_atomic_load(p, __ATOMIC_RELAXED, __HIP_MEMORY_SCOPE_AGENT); }
__device__ __forceinline__ unsigned xb_add(unsigned* p, unsigned v) { return __hip_atomic_fetch_add(p, v, __ATOMIC_RELAXED, __HIP_MEMORY_SCOPE_AGENT); }
__device__ __forceinline__ unsigned xb_xcc_id() { return (unsigned)__builtin_amdgcn_s_getreg((3 << 11) | 20) & 0xFu; }
#define XB_SPIN(cond, bar) do { unsigned _sp = 0; while (cond) { __builtin_amdgcn_s_sleep(1); \
    if ((++_sp & 255u) == 0u) { if (xb_ld(&(bar)[XB_TMO])) break; if (_sp > XB_SPIN_CAP) { atomicAdd(&(bar)[XB_TMO], 1u); break; } } } } while (0)

struct XcdBarrier {
    unsigned* bar; unsigned x;
    volatile LAS unsigned* st;
};

__device__ __forceinline__ XcdBarrier xcd_barrier_post(unsigned* bar, volatile LAS unsigned* st) {
    XcdBarrier b; b.bar = bar; b.x = xb_xcc_id(); b.st = st;
    if (threadIdx.x == 0) (void)xb_add(&bar[XB_XCNT(b.x)], 1u);
    return b;
}
__device__ __forceinline__ void xcd_barrier_complete(unsigned* bar, unsigned x, unsigned& nloc, unsigned& nx) {
    const unsigned G = gridDim.x * gridDim.y * gridDim.z;
    unsigned sum, cnt, mine, sp = 0u;
    for (;;) {
        sum = 0u; cnt = 0u; mine = 0u;
#pragma unroll
        for (unsigned j = 0; j < 16; ++j) { const unsigned c = xb_ld(&bar[XB_XCNT(j)]); sum += c; cnt += (c > 0u) ? 1u : 0u; mine = (j == x) ? c : mine; }
        if (sum == G) break;
        __builtin_amdgcn_s_sleep(1);
        if ((++sp & 255u) == 0u) { if (xb_ld(&bar[XB_TMO])) break; if (sp > XB_SPIN_CAP) { atomicAdd(&bar[XB_TMO], 1u); break; } }
    }
    nloc = mine > 0u ? mine : 1u; nx = cnt > 0u ? cnt : 1u;
}

__device__ __forceinline__ void xcd_barrier(const XcdBarrier& b) {
    asm volatile("s_waitcnt vmcnt(0)" ::: "memory");
    __syncthreads();
    if (threadIdx.x == 0) {
        unsigned* bar = b.bar;
        __builtin_amdgcn_s_waitcnt(0);
        unsigned nloc = b.st[0], nx = b.st[1];
        if (nloc == 0u) { xcd_barrier_complete(bar, b.x, nloc, nx); b.st[0] = nloc; b.st[1] = nx; }
        const unsigned old = xb_add(&bar[XB_XSUB(b.x)], 1u);
        const unsigned gen = old / nloc;
        if (old + 1u == (gen + 1u) * nloc) {
            __builtin_amdgcn_fence(__ATOMIC_RELEASE, "agent");
            asm volatile("s_waitcnt vmcnt(0)" ::: "memory");
            const unsigned og = xb_add(&bar[XB_TOP], 1u);
            const unsigned tg = og / nx;
            if (og + 1u == (tg + 1u) * nx) xb_add(&bar[XB_TOPGEN], 1u);
            else XB_SPIN(xb_ld(&bar[XB_TOPGEN]) == tg, bar);
            __builtin_amdgcn_fence(__ATOMIC_ACQUIRE, "agent");
            xb_add(&bar[XB_XGEN(b.x)], 1u);
            asm volatile("s_waitcnt vmcnt(0)" ::: "memory");
        } else {
            XB_SPIN(xb_ld(&bar[XB_XGEN(b.x)]) == gen, bar);
            __builtin_amdgcn_fence(__ATOMIC_ACQUIRE, "agent");
            asm volatile("s_waitcnt vmcnt(0)" ::: "memory");
        }
    }
    __syncthreads();
}

constexpr int N_PHASES = 21;
#define IN(k) (a.ph_lo <= (k) && (k) < a.ph_hi)
#define SEAM(k) do { if (IN(k) && IN((k) + 1)) { if (a.ph_hi == 0x7fffffff) cg::this_grid().sync(); xcd_barrier(xbar); } } while (0)
template <int l> __device__ __forceinline__ void layer_phases(const Args& a, LAS unsigned char* lds, int G, int gw, int NGW, int wave, int lane, const XcdBarrier& xbar) {
    constexpr int P = 2 + 9 * l;
    const bf16* H = (const bf16*)(a.ws + WS_H);
    const float* MODL = (const float*)(a.ws + WS_MOD) + l * 6144;
    if (IN(P + 0)) { if (l == 1) phase_conv_layer(a, 1, lds, gw, NGW, wave, lane, G > 80 ? 6528 : 0, 10624); phase_norm(a, l, 0, gw, NGW, lane); }
    SEAM(P + 0);
    const bool fuse13 = G == 256 && IN(P + 1) && IN(P + 3) && IN(P + 4);
    if (IN(P + 1)) {
        pg8::Gemm g{H, (const pg8::bf16_t*)(a.ws + WS_WIN), NTOK, INC, 1024}; pg8::StaticOrder S; S.init(NTOK, INC, G, (int)blockIdx.x);
        pg8::EpiProj E{(pg8::bf16_t*)(a.ws + WS_BIG), INP(I_HGL), l};
        pg8::gemm_phase<pg8::EpiProj, pg8::StaticOrder, true, true>(lds, g, S, E);
        if (fuse13 && (int)blockIdx.x >= 28 && (int)blockIdx.x < 92) {
            pg8::Gemm g2{H + (size_t)NPR * 1024, (const pg8::bf16_t*)(a.ws + WS_WG), NTOK - NPR, 4096, 1024}; pg8::StaticOrder S2; S2.init(NTOK - NPR, 4096, 64, (int)blockIdx.x - 28);
            pg8::EpiGate E2{(pg8::bf16_t*)(a.ws + WS_GS), INP(I_BGATE) + l * 4096};
            pg8::gemm_phase<pg8::EpiGate, pg8::StaticOrder, true, true>(lds, g2, S2, E2);
        }
    }
    SEAM(P + 1);
#ifdef PROBE_MIX
    if (IN(P + 2)) { phase_mixers(a, l, lds); xcd_barrier(xbar); phase_mixers(a, l, lds, 1, PROBE_LO, PROBE_HI, PROBE_MODE); }
#else
    if (IN(P + 2)) phase_mixers(a, l, lds);
#endif
    SEAM(P + 2);
    if (IN(P + 3)) {
        phase_hg_post(a, gw, NGW, lane);
        const int Mg = fuse13 ? NPR : NTOK;
        pg8::Gemm g{H, (const pg8::bf16_t*)(a.ws + WS_WG), Mg, 4096, 1024}; pg8::StaticOrder S; S.init(Mg, 4096, G, (int)blockIdx.x);
        pg8::EpiGate E{(pg8::bf16_t*)(a.ws + WS_BIG), INP(I_BGATE) + l * 4096};
        pg8::gemm_phase<pg8::EpiGate, pg8::StaticOrder, true, true>(lds, g, S, E);
    }
    SEAM(P + 3);
    if (IN(P + 4)) {
        pg8::Gemm g{(const pg8::bf16_t*)(a.ws + WS_BR), (const pg8::bf16_t*)(a.ws + WS_WB), NTOK, 1024, 2048}; pg8::StaticOrder S; S.init(NTOK, 1024, G, (int)blockIdx.x);
        pg8::EpiBranch E{(pg8::bf16_t*)(a.ws + WS_G), (const pg8::bf16_t*)(a.ws + WS_BIG), fuse13 ? (const pg8::bf16_t*)(a.ws + WS_GS) - (size_t)NPR * 4096 : (const pg8::bf16_t*)(a.ws + WS_BIG)};
        pg8::gemm_phase<pg8::EpiBranch, pg8::StaticOrder, true, true>(lds, g, S, E);
    }
    SEAM(P + 4);
    if (IN(P + 5)) {
        pg8::Gemm g{(const pg8::bf16_t*)(a.ws + WS_G), (const pg8::bf16_t*)(a.ws + WS_WO), NTOK, 1024, 1024}; pg8::StaticOrder S; S.init(NTOK, 1024, G, (int)blockIdx.x);
        pg8::EpiRes E{a.out, l == 0 ? INP(I_XP) : a.out, l == 0 ? INP(I_XS) : a.out + (size_t)NPR * 1024, MODL + 2048, 0};
        pg8::gemm_phase<pg8::EpiRes, pg8::StaticOrder, true, true>(lds, g, S, E);
    }
    SEAM(P + 5);
    const bool fuse67 = G > 64 && IN(P + 6) && IN(P + 7) && IN(P + 8);
    if (IN(P + 6)) {
        if (fuse67) {
            phase_norm(a, l, 1, gw, NGW, lane, NPR, NTOK);
            xcd_barrier(xbar);
            if ((int)blockIdx.x < 64) {
                pg8::Gemm g{H + (size_t)NPR * 1024, (const pg8::bf16_t*)(a.ws + WS_W1), NTOK - NPR, 4096, 1024}; pg8::StaticOrder S; S.init(NTOK - NPR, 4096, 64, (int)blockIdx.x);
                pg8::EpiRelu2 E{(pg8::bf16_t*)(a.ws + WS_BIG) + (size_t)NPR * 4096};
                pg8::gemm_phase<pg8::EpiRelu2, pg8::StaticOrder, true, true>(lds, g, S, E);
            } else phase_norm(a, l, 1, ((int)blockIdx.x - 64) * 8 + wave, (G - 64) * 8, lane, 0, NPR);
        } else phase_norm(a, l, 1, gw, NGW, lane);
    }
    SEAM(P + 6);
    if (IN(P + 7)) {
        const pg8::bf16_t* W1 = (const pg8::bf16_t*)(a.ws + WS_W1); pg8::bf16_t* U = (pg8::bf16_t*)(a.ws + WS_BIG);
        if (G > 16 && IN(P + 8)) {
            if (!fuse67) {
              { pg8::Gemm g{H + (size_t)NPR * 1024, W1, NTOK - NPR, 4096, 1024}; pg8::StaticOrder S; S.init(NTOK - NPR, 4096, G, (int)blockIdx.x);
                pg8::EpiRelu2 E{U + (size_t)NPR * 4096};
                pg8::gemm_phase<pg8::EpiRelu2, pg8::StaticOrder, true, true>(lds, g, S, E); }
              xcd_barrier(xbar);
            }
            if ((int)blockIdx.x < 16) {
                pg8::Gemm g{U + (size_t)NPR * 4096, (const pg8::bf16_t*)(a.ws + WS_W2), NTOK - NPR, 1024, 4096}; pg8::StaticOrder S; S.init(NTOK - NPR, 1024, 16, (int)blockIdx.x);
                pg8::EpiRes E{a.out, a.out, a.out + (size_t)NPR * 1024, MODL + 5120, NPR};
                pg8::gemm_phase<pg8::EpiRes, pg8::StaticOrder, true, true>(lds, g, S, E);
            } else {
                pg8::Gemm g{H, W1, NPR, 4096, 1024}; pg8::StaticOrder S; S.init(NPR, 4096, G - 16, (int)blockIdx.x - 16);
                pg8::EpiRelu2 E{U};
                pg8::gemm_phase<pg8::EpiRelu2, pg8::StaticOrder, true, true>(lds, g, S, E);
                if (l == 0 && (int)blockIdx.x >= 80 && G > 80)
                    phase_conv_layer(a, 1, lds, ((int)blockIdx.x - 80) * 8 + wave, (G - 80) * 8, wave, lane, 0, 6528);
            }
        } else {
            pg8::Gemm g{H, W1, NTOK, 4096, 1024}; pg8::StaticOrder S; S.init(NTOK, 4096, G, (int)blockIdx.x);
            pg8::EpiRelu2 E{U};
            pg8::gemm_phase<pg8::EpiRelu2, pg8::StaticOrder, true, true>(lds, g, S, E);
        }
    }
    SEAM(P + 7);
    if (IN(P + 8)) {
        const int Mrows = (G > 16 && IN(P + 7)) ? NPR : NTOK;
        pg8::Gemm g{(const pg8::bf16_t*)(a.ws + WS_BIG), (const pg8::bf16_t*)(a.ws + WS_W2), Mrows, 1024, 4096}; pg8::StaticOrder S; S.init(Mrows, 1024, G, (int)blockIdx.x);
        pg8::EpiRes E{a.out, a.out, a.out + (size_t)NPR * 1024, MODL + 5120, 0};
        pg8::gemm_phase<pg8::EpiRes, pg8::StaticOrder, true, true>(lds, g, S, E);
    }
    SEAM(P + 8);
}
__global__ void __launch_bounds__(512, 2) mega(Args a) {
    LAS unsigned char* lds = (LAS unsigned char*)lds_raw;
    const int tid = threadIdx.x, lane = tid & 63, wave = __builtin_amdgcn_readfirstlane(tid >> 6);
    const int G = gridDim.x, gw = blockIdx.x * 8 + wave, NGW = G * 8;
    if (tid == 0) {
#pragma unroll
        for (int i = 0; i < 46; ++i) *(LAS unsigned long long*)(lds + TAB_OFF + 8 * i) = (unsigned long long)a.in[i];
        *(LAS unsigned*)(lds + MISC_OFF + 32) = 0u; *(LAS unsigned*)(lds + MISC_OFF + 36) = 0u;
    }
    __syncthreads();
    XcdBarrier xbar; xbar.bar = (unsigned*)(a.ws + WS_CTL) + 4096; xbar.x = 0; xbar.st = (volatile LAS unsigned*)(lds + MISC_OFF + 32);
    if (a.ph_hi - a.ph_lo > 1) xbar = xcd_barrier_post((unsigned*)(a.ws + WS_CTL) + 4096, (volatile LAS unsigned*)(lds + MISC_OFF + 32));
    if (IN(0)) phase_conv_ada(a, lds, gw, NGW, wave, lane);
    SEAM(0);
    if (IN(1)) {
        pg8::Gemm g{(const pg8::bf16_t*)(a.ws + WS_CA), (const pg8::bf16_t*)(a.ws + WS_BIG), 256, 12288, 1024}; pg8::StaticOrder S; S.init(256, 12288, G, (int)blockIdx.x);
        pg8::EpiMod E{(float*)(a.ws + WS_MOD), INP(I_ADAB)};
        pg8::gemm_phase<pg8::EpiMod, pg8::StaticOrder, true, true>(lds, g, S, E);
        if ((int)blockIdx.x >= 48 && G > 48)
            phase_conv_layer(a, 0, lds, ((int)blockIdx.x - 48) * 8 + wave, (G - 48) * 8, wave, lane, 0, 10624);
        else if (G <= 48) phase_conv_layer(a, 0, lds, gw, NGW, wave, lane, 0, 10624);
    }
    SEAM(1);
    layer_phases<0>(a, lds, G, gw, NGW, wave, lane, xbar);
    layer_phases<1>(a, lds, G, gw, NGW, wave, lane, xbar);
#ifdef PROBE_SYNC
    for (int i = 0; i < 40; ++i) xcd_barrier(xbar);
#endif
    if (IN(20)) phase_final(a, gw, NGW, lane);
}

extern "C" void kernel_launch(void* const* d_in, const int* in_sizes, int n_in, void* d_out, int out_size, void* d_ws, size_t ws_size, hipStream_t stream) {
    static int grid = 0;
    if (grid == 0) {
        if (n_in != 46 || ws_size < WS_END) { fprintf(stderr, "kernel_launch: bad n_in %d or ws %zu (< %zu)\n", n_in, ws_size, (size_t)WS_END); grid = -1; return; }
        (void)hipFuncSetAttribute((const void*)mega, hipFuncAttributeMaxDynamicSharedMemorySize, LDS_BYTES);
        int dev = 0, cus = 0, per_cu = 0;
        (void)hipGetDevice(&dev); (void)hipDeviceGetAttribute(&cus, hipDeviceAttributeMultiprocessorCount, dev);
        (void)hipOccupancyMaxActiveBlocksPerMultiprocessor(&per_cu, (const void*)mega, 512, LDS_BYTES);
        if (per_cu < 1) fprintf(stderr, "kernel_launch: occupancy query says %d\n", per_cu);
        (void)hipGetLastError();
        grid = cus > 0 ? cus : 256;
    }
    if (grid < 0) return;
    (void)hipMemsetAsync((char*)d_ws + WS_CTL, 0, CTL_BYTES, stream);
    Args a{};
    for (int i = 0; i < 46; ++i) a.in[i] = (const float*)d_in[i];
    a.out = (float*)d_out; a.ws = (unsigned char*)d_ws;
#if MK_SINGLE
    a.ph_lo = 0; a.ph_hi = N_PHASES;
    void* args[] = {&a};
    hipError_t e = hipLaunchCooperativeKernel((const void*)mega, dim3(grid), dim3(512), args, LDS_BYTES, stream);
    if (e != hipSuccess) fprintf(stderr, "cooperative launch failed: %s (grid %d)\n", hipGetErrorString(e), grid);
#else
    for (int ph = 0; ph < N_PHASES; ++ph) { a.ph_lo = ph; a.ph_hi = ph + 1; hipLaunchKernelGGL(mega, dim3(grid), dim3(512), LDS_BYTES, stream, a); }
#endif
}
```

```cpp
#include <hip/hip_runtime.h>
#include <hip/hip_cooperative_groups.h>
#include <cstdio>
#include <cstdint>
namespace cg = cooperative_groups;
namespace pg8 {
#define PG8_LAS __attribute__((address_space(3)))
typedef unsigned short bf16_t;
typedef short bf16x8 __attribute__((ext_vector_type(8)));
typedef float f32x4 __attribute__((ext_vector_type(4)));
typedef unsigned u32x4 __attribute__((ext_vector_type(4)));
constexpr int BM = 256, BK = 64, HALF = 128, HTB = HALF * BK * 2  , STAGE_BYTES = 8 * HTB, NXCD = 8, WGM = 8;

__host__ __device__ __forceinline__ int lds_byte(int r, int c) { const int st = (r >> 4) * 2 + (c >> 5), rr = r & 15, cc = c & 31, ob = rr * 64 + cc * 2; return st * 1024 + (ob ^ (((ob >> 9) & 1) << 5)); }
__host__ __device__ __forceinline__ void stage_rc(int b, int& R, int& C) { const int st = b / 1024, sb = b % 1024, swz = sb ^ (((sb >> 9) & 1) << 5); R = (st >> 1) * 16 + swz / 64; C = (st & 1) * 32 + (swz % 64) / 2; }
__host__ __device__ __forceinline__ int perm32(int rho) { const int n = rho >> 4, i = rho & 15; return 8 * (i >> 2) + 4 * n + (i & 3); }

struct Unit { int pm, pn; };
struct Gemm { const bf16_t* A; const bf16_t* Bt; int M, N, K; };

struct StaticOrder {
    int nM, nN, nwg, G, c;
    __host__ __device__ void init(int M, int N, int G_, int c_) { nM = M / BM; nN = N / BM; nwg = nM * nN; G = G_; c = c_; }
    __host__ __device__ bool next(int i, Unit& u) const {
        const long L = (long)i * G + c; if (L >= nwg) return false;
        int wgid = (int)L; { const int q = nwg / NXCD, r = nwg % NXCD, xcd = wgid % NXCD, off = wgid / NXCD; wgid = (xcd < r ? xcd * (q + 1) : r * (q + 1) + (xcd - r) * q) + off; }
        const int nig = WGM * nN, gid = wgid / nig, fm = gid * WGM, gsz = (nM - fm) < WGM ? (nM - fm) : WGM;
        u.pm = fm + ((wgid % nig) % gsz); u.pn = (wgid % nig) / gsz; return true;
    }
    __device__ __forceinline__ void a_ready(const Unit&) const {}
    __device__ __forceinline__ void done(const Unit&) const {}
};

__device__ __forceinline__ unsigned cvt_pk_bf16(float lo, float hi) { unsigned r; asm volatile("v_cvt_pk_bf16_f32 %0, %1, %2" : "=v"(r) : "v"(lo), "v"(hi)); return r; }
__device__ __forceinline__ float sigm(float x) { return __builtin_amdgcn_rcpf(1.f + __expf(-x)); }
__device__ __forceinline__ float silu_(float x) { return x * sigm(x); }
__device__ __forceinline__ float tanh_(float u) { return 1.f - 2.f * __builtin_amdgcn_rcpf(__expf(2.f * u) + 1.f); }
__device__ __forceinline__ float gelu_tanh(float x) { const float u = 0.7978845608f * (x + 0.044715f * x * x * x); return 0.5f * x * (1.f + tanh_(u)); }
__device__ __forceinline__ int cond_of_row(int row) { return row < 16384 ? (row >> 11) : 8 + ((row - 16384) >> 3); }
__device__ __forceinline__ void unpack8(const u32x4 w, float (&f)[8]) {
    f[0] = __uint_as_float(w.x << 16); f[1] = __uint_as_float(w.x & 0xffff0000u); f[2] = __uint_as_float(w.y << 16); f[3] = __uint_as_float(w.y & 0xffff0000u);
    f[4] = __uint_as_float(w.z << 16); f[5] = __uint_as_float(w.z & 0xffff0000u); f[6] = __uint_as_float(w.w << 16); f[7] = __uint_as_float(w.w & 0xffff0000u);
}
__device__ __forceinline__ u32x4 pack8(const float (&f)[8]) { u32x4 w; w.x = cvt_pk_bf16(f[0], f[1]); w.y = cvt_pk_bf16(f[2], f[3]); w.z = cvt_pk_bf16(f[4], f[5]); w.w = cvt_pk_bf16(f[6], f[7]); return w; }

#define EPI_LOOP_BEGIN \
    _Pragma("unroll") for (int ai = 0; ai < 2; ++ai) _Pragma("unroll") for (int m = 0; m < 4; ++m) { const int row = u.pm * BM + ai * HALF + wr * 64 + m * 16 + fr; \
    _Pragma("unroll") for (int bj = 0; bj < 2; ++bj) { const int colb = u.pn * BM + bj * HALF; const int col = colb + wc * 32 + 8 * fq; \
        float v[8]; v[0] = acc[ai][bj][m][0][0]; v[1] = acc[ai][bj][m][0][1]; v[2] = acc[ai][bj][m][0][2]; v[3] = acc[ai][bj][m][0][3]; \
        v[4] = acc[ai][bj][m][1][0]; v[5] = acc[ai][bj][m][1][1]; v[6] = acc[ai][bj][m][1][2]; v[7] = acc[ai][bj][m][1][3];
#define EPI_LOOP_END } }

struct EpiProj {
    static constexpr bool PERM = true, AFTER_DRAIN = false, HOOK = false;
    bf16_t* O; const float* hgl; int layer;
    __device__ __forceinline__ void operator()(const f32x4 (&acc)[2][2][4][2], const Unit& u, int wr, int wc, int fr, int fq) const {
        EPI_LOOP_BEGIN
            const int sec = colb >> 7;
            if (sec < 4 || (sec >= 12 && sec < 16)) {
#pragma unroll
                for (int j = 0; j < 8; ++j) v[j] = silu_(v[j]);
            } else if (sec < 8) {
#pragma unroll
                for (int j = 0; j < 8; ++j) { const int c = col - 512 + j; const float lb = layer == 0 ? 0.f : __builtin_amdgcn_rcpf(1.f + __expf(hgl[c] - hgl[512 + c])); v[j] = (1.f - lb) * sigm(-v[j]); }
            } else if (sec >= 34 && sec < 38) {
#pragma unroll
                for (int j = 0; j < 8; ++j) v[j] = sigm(v[j]);
            } else if (sec >= 42) {
#pragma unroll
                for (int j = 0; j < 8; ++j) v[j] = gelu_tanh(v[j]);
            }
            *(u32x4*)(O + (size_t)row * 5888 + col) = pack8(v);
        EPI_LOOP_END
    }
};
struct EpiGate {
    static constexpr bool PERM = true, AFTER_DRAIN = false, HOOK = false;
    bf16_t* O; const float* bias;
    __device__ __forceinline__ void operator()(const f32x4 (&acc)[2][2][4][2], const Unit& u, int wr, int wc, int fr, int fq) const {
        EPI_LOOP_BEGIN
            const f32x4 b0 = *(const f32x4*)(bias + col), b1 = *(const f32x4*)(bias + col + 4);
            v[0] = sigm(v[0] + b0[0]); v[1] = sigm(v[1] + b0[1]); v[2] = sigm(v[2] + b0[2]); v[3] = sigm(v[3] + b0[3]);
            v[4] = sigm(v[4] + b1[0]); v[5] = sigm(v[5] + b1[1]); v[6] = sigm(v[6] + b1[2]); v[7] = sigm(v[7] + b1[3]);
            *(u32x4*)(O + (size_t)row * 4096 + col) = pack8(v);
        EPI_LOOP_END
    }
};
struct EpiMod {
    static constexpr bool PERM = true, AFTER_DRAIN = false, HOOK = false;
    float* O; const float* bias;
    __device__ __forceinline__ void operator()(const f32x4 (&acc)[2][2][4][2], const Unit& u, int wr, int wc, int fr, int fq) const {
        EPI_LOOP_BEGIN
            const f32x4 b0 = *(const f32x4*)(bias + col), b1 = *(const f32x4*)(bias + col + 4);
            *(f32x4*)(O + (size_t)row * 12288 + col) = (f32x4){v[0] + b0[0], v[1] + b0[1], v[2] + b0[2], v[3] + b0[3]};
            *(f32x4*)(O + (size_t)row * 12288 + col + 4) = (f32x4){v[4] + b1[0], v[5] + b1[1], v[6] + b1[2], v[7] + b1[3]};
        EPI_LOOP_END
    }
};
struct EpiBranch {
    static constexpr bool PERM = true, AFTER_DRAIN = false, HOOK = true;
    bf16_t* O; const bf16_t* G; const bf16_t* G2;
    __device__ __forceinline__ void hook(f32x4 (&acc)[2][2][4][2], const Unit& u, int kb, int wr, int wc, int fr, int fq) const {
        __builtin_amdgcn_sched_barrier(0);
#pragma unroll
        for (int ai = 0; ai < 2; ++ai)
#pragma unroll
            for (int m = 0; m < 4; ++m) { const int row = u.pm * BM + ai * HALF + wr * 64 + m * 16 + fr;
#pragma unroll
                for (int bj = 0; bj < 2; ++bj) { const int col = u.pn * BM + bj * HALF + wc * 32 + 8 * fq;
                    const bf16_t* gp = (row < 16384 ? G : G2) + (size_t)row * 4096 + kb * 1024 + col;
                    float g0[8], g1[8]; unpack8(*(const u32x4*)gp, g0); unpack8(*(const u32x4*)(gp + 1024), g1);
#pragma unroll
                    for (int j = 0; j < 4; ++j) { acc[ai][bj][m][0][j] *= g0[j] * __builtin_amdgcn_rcpf(g1[j]); acc[ai][bj][m][1][j] *= g0[4 + j] * __builtin_amdgcn_rcpf(g1[4 + j]); }
                }
                __builtin_amdgcn_sched_barrier(0); }
    }
    __device__ __forceinline__ void operator()(const f32x4 (&acc)[2][2][4][2], const Unit& u, int wr, int wc, int fr, int fq) const {
        EPI_LOOP_BEGIN
            float g[8]; unpack8(*(const u32x4*)((row < 16384 ? G : G2) + (size_t)row * 4096 + 3072 + col), g);
#pragma unroll
            for (int j = 0; j < 8; ++j) v[j] *= g[j];
            *(u32x4*)(O + (size_t)row * 1024 + col) = pack8(v);
        EPI_LOOP_END
    }
};
struct EpiRes {
    static constexpr bool PERM = true, AFTER_DRAIN = false, HOOK = false;
    float* X; const float* res0; const float* res1; const float* gmod; int row0;
    __device__ __forceinline__ void operator()(const f32x4 (&acc)[2][2][4][2], const Unit& u, int wr, int wc, int fr, int fq) const {
        EPI_LOOP_BEGIN
            const int grow = row + row0;
            const float* rp = (grow < 16384 ? res0 + (size_t)grow * 1024 : res1 + (size_t)(grow - 16384) * 1024) + col;
            const float* gp = gmod + (size_t)cond_of_row(grow) * 12288 + col;
            const f32x4 r0 = *(const f32x4*)rp, r1 = *(const f32x4*)(rp + 4), g0 = *(const f32x4*)gp, g1 = *(const f32x4*)(gp + 4);
            *(f32x4*)(X + (size_t)grow * 1024 + col) = (f32x4){r0[0] + g0[0] * v[0], r0[1] + g0[1] * v[1], r0[2] + g0[2] * v[2], r0[3] + g0[3] * v[3]};
            *(f32x4*)(X + (size_t)grow * 1024 + col + 4) = (f32x4){r1[0] + g1[0] * v[4], r1[1] + g1[1] * v[5], r1[2] + g1[2] * v[6], r1[3] + g1[3] * v[7]};
        EPI_LOOP_END
    }
};
struct EpiRelu2 {
    static constexpr bool PERM = true, AFTER_DRAIN = false, HOOK = false;
    bf16_t* O;
    __device__ __forceinline__ void operator()(const f32x4 (&acc)[2][2][4][2], const Unit& u, int wr, int wc, int fr, int fq) const {
        EPI_LOOP_BEGIN
#pragma unroll
            for (int j = 0; j < 8; ++j) { const float r = fmaxf(v[j], 0.f); v[j] = r * r; }
            *(u32x4*)(O + (size_t)row * 4096 + col) = pack8(v);
        EPI_LOOP_END
    }
};
template <class Epi, class Sched, bool ALIGN_EPI = false, bool SP2 = false>
__device__ __forceinline__ void gemm_phase(PG8_LAS unsigned char* lds, const Gemm g, const Sched& S, const Epi& E) {
    const int tid = threadIdx.x, wid = __builtin_amdgcn_readfirstlane(tid >> 6), lane = tid & 63, wr = wid >> 2, wc = wid & 3, fr = lane & 15, fq = lane >> 4;
    const int K = g.K, nt = K / BK;
    unsigned voffA[2], voffB[2];
#pragma unroll
    for (int i = 0; i < 2; ++i) { int R, C; stage_rc(tid * 16 + i * 8192, R, C); const int Rb = Epi::PERM ? ((R & ~31) + perm32(R & 31)) : R;
        voffA[i] = (unsigned)(R * K + C) * 2u; voffB[i] = (unsigned)(Rb * K + C) * 2u; }
    const size_t kstep = (size_t)(BK * 2);
    const size_t hstep = (size_t)HALF * K * 2;
    const size_t tstep = 2 * hstep;
    const unsigned ldsw = (unsigned)wid * 1024u;
    const int aoff = lds_byte(wr * 64 + fr, fq * 8), boff = lds_byte(wc * 32 + fr, fq * 8);
#define PG8_SA(b, h) (((b) * 2 + (h)) * HTB)
#define PG8_SB(b, h) ((4 + (b) * 2 + (h)) * HTB)
#define PG8_STAGE(bufoff, gbase, voff) do { _Pragma("unroll") for (int _i = 0; _i < 2; ++_i) \
        __builtin_amdgcn_global_load_lds((const unsigned*)((const char*)(gbase) + (voff)[_i]), (PG8_LAS unsigned*)(lds + (bufoff) + ldsw + _i * 8192), 16, 0, 0); } while (0)
#define PG8_LDA(dst, b, h) do { _Pragma("unroll") for (int m = 0; m < 4; ++m) _Pragma("unroll") for (int k = 0; k < 2; ++k) dst[m][k] = *(const PG8_LAS bf16x8*)(lds + PG8_SA(b, h) + aoff + m * 2048 + k * 1024); } while (0)
#define PG8_LDB(dst, b, h) do { _Pragma("unroll") for (int n = 0; n < 2; ++n) _Pragma("unroll") for (int k = 0; k < 2; ++k) dst[n][k] = *(const PG8_LAS bf16x8*)(lds + PG8_SB(b, h) + boff + n * 2048 + k * 1024); } while (0)
#define PG8_MMA(ai, bj, At, Bt) do { __builtin_amdgcn_s_setprio(1); _Pragma("unroll") for (int m = 0; m < 4; ++m) _Pragma("unroll") for (int n = 0; n < 2; ++n) _Pragma("unroll") for (int k = 0; k < 2; ++k) \
        acc[ai][bj][m][n] = __builtin_amdgcn_mfma_f32_16x16x32_bf16(Bt[n][k], At[m][k], acc[ai][bj][m][n], 0, 0, 0); __builtin_amdgcn_s_setprio(0); } while (0)
#define PG8_WAIT_V(n) asm volatile("s_waitcnt vmcnt(" #n ")" ::: "memory")
#define PG8_WAIT_L(n) asm volatile("s_waitcnt lgkmcnt(" #n ")" ::: "memory")
#define PG8_BAR __builtin_amdgcn_s_barrier()
#define PG8_SCHED __builtin_amdgcn_sched_barrier(0)
    Unit cur, nxt; int ui = 0;
    if (!S.next(0, cur)) return;
    f32x4 acc[2][2][4][2];
#pragma unroll
    for (int a = 0; a < 2; ++a)
#pragma unroll
        for (int b = 0; b < 2; ++b)
#pragma unroll
            for (int m = 0; m < 4; ++m)
#pragma unroll
                for (int n = 0; n < 2; ++n) acc[a][b][m][n] = (f32x4){0.f, 0.f, 0.f, 0.f};
    bf16x8 At[4][2], B0[2][2], B1[2][2];
    const char* cA = (const char*)g.A + (size_t)cur.pm * tstep; const char* cB = (const char*)g.Bt + (size_t)cur.pn * tstep;
    S.a_ready(cur);
    if constexpr (SP2) {
        PG8_STAGE(PG8_SB(0, 0), cB, voffB); PG8_STAGE(PG8_SB(0, 1), cB + hstep, voffB); PG8_STAGE(PG8_SA(0, 0), cA, voffA); PG8_STAGE(PG8_SA(0, 1), cA + hstep, voffA);
        if (wr == 1) PG8_BAR;
        PG8_WAIT_V(2); PG8_BAR;
        PG8_STAGE(PG8_SB(1, 0), cB + kstep, voffB); PG8_STAGE(PG8_SA(1, 0), cA + kstep, voffA); PG8_STAGE(PG8_SB(1, 1), cB + hstep + kstep, voffB);
        PG8_WAIT_V(6); PG8_BAR;
    } else {
        PG8_STAGE(PG8_SB(0, 0), cB, voffB); PG8_STAGE(PG8_SA(0, 0), cA, voffA); PG8_STAGE(PG8_SB(0, 1), cB + hstep, voffB); PG8_STAGE(PG8_SA(0, 1), cA + hstep, voffA);
        if (wr == 1) PG8_BAR;
        PG8_WAIT_V(4); PG8_BAR;
        PG8_STAGE(PG8_SB(1, 0), cB + kstep, voffB); PG8_STAGE(PG8_SA(1, 0), cA + kstep, voffA); PG8_STAGE(PG8_SB(1, 1), cB + hstep + kstep, voffB);
        PG8_WAIT_V(6); PG8_BAR;
    }
    for (;;) {
        const bool has_next = S.next(ui + 1, nxt);
        const char* nA = has_next ? (const char*)g.A + (size_t)nxt.pm * tstep : cA; const char* nB = has_next ? (const char*)g.Bt + (size_t)nxt.pn * tstep : cB;
        for (int t = 0; t < nt; t += 2) {
            const bool last = (t == nt - 2);
            const char* a1 = cA + (size_t)(t + 1) * kstep;
            const char* a2 = last ? nA : cA + (size_t)(t + 2) * kstep; const char* b2 = last ? nB : cB + (size_t)(t + 2) * kstep;
            const char* a3 = a2 + kstep; const char* b3 = b2 + kstep;
            if (last && has_next) S.a_ready(nxt);
            if constexpr (SP2) {
            PG8_LDB(B0, 0, 0); PG8_LDB(B1, 0, 1); PG8_SCHED; PG8_LDA(At, 0, 0); PG8_STAGE(PG8_SA(1, 1), a1 + hstep, voffA);
            PG8_WAIT_V(8); PG8_WAIT_L(0); PG8_BAR; PG8_MMA(0, 0, At, B0); PG8_MMA(0, 1, At, B1); PG8_BAR; PG8_SCHED;
            PG8_LDA(At, 0, 1); PG8_STAGE(PG8_SB(0, 0), b2, voffB); PG8_STAGE(PG8_SB(0, 1), b2 + hstep, voffB); PG8_STAGE(PG8_SA(0, 0), a2, voffA);
            PG8_WAIT_V(8); PG8_WAIT_L(0); PG8_BAR; PG8_MMA(1, 0, At, B0); PG8_MMA(1, 1, At, B1); PG8_BAR; PG8_SCHED;
            PG8_LDB(B0, 1, 0); PG8_LDB(B1, 1, 1); PG8_SCHED; PG8_LDA(At, 1, 0); PG8_STAGE(PG8_SA(0, 1), a2 + hstep, voffA);
            PG8_WAIT_V(8); PG8_WAIT_L(0); PG8_BAR; PG8_MMA(0, 0, At, B0); PG8_MMA(0, 1, At, B1); PG8_BAR; PG8_SCHED;
            PG8_LDA(At, 1, 1); PG8_STAGE(PG8_SB(1, 0), b3, voffB); PG8_STAGE(PG8_SB(1, 1), b3 + hstep, voffB); PG8_STAGE(PG8_SA(1, 0), a3, voffA);
            PG8_WAIT_V(8); PG8_WAIT_L(0); PG8_BAR; PG8_MMA(1, 0, At, B0); PG8_MMA(1, 1, At, B1); PG8_BAR; PG8_SCHED;
            } else {
            PG8_LDB(B0, 0, 0); PG8_SCHED; PG8_LDA(At, 0, 0); PG8_STAGE(PG8_SA(1, 1), a1 + hstep, voffA);
            PG8_WAIT_L(8); PG8_BAR; PG8_WAIT_L(0); PG8_MMA(0, 0, At, B0); PG8_BAR; PG8_SCHED;
            PG8_LDB(B1, 0, 1); PG8_STAGE(PG8_SB(0, 0), b2, voffB);
            PG8_BAR; PG8_WAIT_L(0); PG8_MMA(0, 1, At, B1); PG8_BAR;
            PG8_LDA(At, 0, 1); PG8_STAGE(PG8_SA(0, 0), a2, voffA);
            PG8_BAR; PG8_WAIT_L(0); PG8_MMA(1, 0, At, B0); PG8_BAR; PG8_SCHED;
            PG8_STAGE(PG8_SB(0, 1), b2 + hstep, voffB);
            PG8_WAIT_V(6); PG8_BAR; PG8_MMA(1, 1, At, B1); PG8_BAR;
            PG8_LDB(B0, 1, 0); PG8_SCHED; PG8_LDA(At, 1, 0); PG8_STAGE(PG8_SA(0, 1), a2 + hstep, voffA);
            PG8_WAIT_L(8); PG8_BAR; PG8_WAIT_L(0); PG8_MMA(0, 0, At, B0); PG8_BAR; PG8_SCHED;
            PG8_LDB(B1, 1, 1); PG8_STAGE(PG8_SB(1, 0), b3, voffB);
            PG8_BAR; PG8_WAIT_L(0); PG8_MMA(0, 1, At, B1); PG8_BAR;
            PG8_LDA(At, 1, 1); PG8_STAGE(PG8_SA(1, 0), a3, voffA);
            PG8_BAR; PG8_WAIT_L(0); PG8_MMA(1, 0, At, B0); PG8_BAR; PG8_SCHED;
            PG8_STAGE(PG8_SB(1, 1), b3 + hstep, voffB);
            PG8_WAIT_V(6); PG8_BAR; PG8_MMA(1, 1, At, B1); PG8_BAR;
            }
            if constexpr (Epi::HOOK) { if ((((t + 2) & 7) == 0) && !last) E.hook(acc, cur, ((t + 2) >> 3) - 1, wr, wc, fr, fq); }
        }
        if constexpr (ALIGN_EPI) { if (wr == 0) PG8_BAR; }
        if constexpr (!Epi::AFTER_DRAIN) { E(acc, cur, wr, wc, fr, fq); S.done(cur); }
        if (!has_next) break;
#pragma unroll
        for (int a = 0; a < 2; ++a)
#pragma unroll
            for (int b = 0; b < 2; ++b)
#pragma unroll
                for (int m = 0; m < 4; ++m)
#pragma unroll
                    for (int n = 0; n < 2; ++n) acc[a][b][m][n] = (f32x4){0.f, 0.f, 0.f, 0.f};
        cur = nxt; cA = nA; cB = nB; ++ui;
        if constexpr (ALIGN_EPI) { if (wr == 1) PG8_BAR; }
    }
    PG8_WAIT_V(0);
    if constexpr (!ALIGN_EPI) { if (wr == 0) PG8_BAR; }
    PG8_BAR;
    if constexpr (Epi::AFTER_DRAIN) { E.fused(acc, cur, wr, wc, fr, fq, lds, wid, lane); S.done(cur); }
#undef PG8_SA
#undef PG8_SB
#undef PG8_STAGE
#undef PG8_LDA
#undef PG8_LDB
#undef PG8_MMA
#undef PG8_WAIT_V
#undef PG8_WAIT_L
#undef PG8_BAR
#undef PG8_SCHED
}
}
#ifndef MK_SINGLE
#define MK_SINGLE 1
#endif
#define LAS __attribute__((address_space(3)))
typedef unsigned short bf16;
typedef unsigned v4u __attribute__((ext_vector_type(4)));
typedef unsigned v2u __attribute__((ext_vector_type(2)));
typedef float f32x4 __attribute__((ext_vector_type(4)));
using pg8::sigm; using pg8::silu_; using pg8::tanh_; using pg8::cvt_pk_bf16; using pg8::unpack8; using pg8::pack8; using pg8::cond_of_row;

constexpr int NTOK = 17408, NPR = 16384, DM = 1024, BW = 512, INC = 5888;
constexpr int LDS_BYTES = 147456, MISC_OFF = 144 * 1024 - 1024, TAB_OFF = MISC_OFF + 64;
constexpr size_t MiB = 1u << 20;
constexpr size_t WS_CTL = 0, CTL_BYTES = 65536;
constexpr size_t WS_MOD = 1 * MiB;
constexpr size_t WS_CA = 13 * MiB;
constexpr size_t WS_WIN = 14 * MiB;
constexpr size_t WS_WG = WS_WIN + 5888u * 1024 * 2;
constexpr size_t WS_WB = WS_WG + 8 * MiB;
constexpr size_t WS_WO = WS_WB + 4 * MiB;
constexpr size_t WS_W1 = WS_WO + 2 * MiB;
constexpr size_t WS_W2 = WS_W1 + 8 * MiB;
constexpr size_t WS_H = 56 * MiB;
constexpr size_t WS_BR = 90 * MiB;
constexpr size_t WS_G = 158 * MiB;
constexpr size_t WS_BIG = 192 * MiB;
constexpr size_t WS_SSP = WS_BIG + (size_t)NTOK * INC * 2;
constexpr size_t WS_RST = WS_SSP + (size_t)NTOK * 16 * 4;
constexpr size_t WS_GS = WS_RST + (size_t)NTOK * 32 * 4;
constexpr size_t WS_END = WS_GS + (size_t)(NTOK - NPR) * 4096 * 2;
static_assert(WS_W2 + 8 * MiB <= WS_H, "ws map");
constexpr size_t O_HG_P = 17825792, O_RW_P = 18874368, O_SH_P = 19398656, O_CV_P = 19427328, O_LH_P = 19673088, O_LC_P = 19681280;
constexpr size_t O_HG_S = 19705856, O_RW_S = 36483072, O_SH_S = 44871680, O_CV_S = 45330432, O_LH_S = 49262592, O_LC_S = 49393664;
enum { I_XP = 0, I_XS, I_SHG, I_SRW, I_SSH, I_SCV, I_SLH, I_SLC, I_CP, I_CS, I_ADAW, I_ADAB, I_NMIX, I_NMLP, I_NFIN, I_WIN, I_HGL, I_HGN, I_MU, I_W0, I_WUP, I_A0, I_AUP, I_GUP,
       I_KK, I_KA, I_RK, I_LNG, I_LNB, I_CFDW, I_CFDWB, I_CFLG, I_CFLB, I_LCW, I_LCB, I_LWA, I_LBA, I_LWX, I_LBX, I_LAM, I_WBR, I_WGATE, I_BGATE, I_WOUT, I_WM1, I_WM2 };

struct Args { const float* in[46]; float* out; unsigned char* ws; int ph_lo, ph_hi; };
struct MArgs { float* out; unsigned char* ws; };
extern __shared__ __attribute__((aligned(16))) unsigned char lds_raw[];
__device__ __forceinline__ const float* inp_(int i) {
    const LAS unsigned* t = (const LAS unsigned*)((LAS unsigned char*)lds_raw + TAB_OFF) + 2 * i;
    const unsigned lo = __builtin_amdgcn_readfirstlane(t[0]), hi = __builtin_amdgcn_readfirstlane(t[1]);
    return (const float*)(((unsigned long long)hi << 32) | lo);
}
#define INP(i) inp_(i)

template <int CTRL> __device__ __forceinline__ float dppf(float v) { return __builtin_bit_cast(float, __builtin_amdgcn_update_dpp(0, __builtin_bit_cast(int, v), CTRL, 0xF, 0xF, true)); }
__device__ __forceinline__ float red4(float v) { v += dppf<0xB1>(v); v += dppf<0x4E>(v); return v; }
__device__ __forceinline__ float red8(float v) { v = red4(v); v += dppf<0x141>(v); return v; }
__device__ __forceinline__ float red16(float v) { v = red8(v); v += dppf<0x140>(v); return v; }
__device__ __forceinline__ float wave_sum(float v) {
#pragma unroll
    for (int o = 1; o < 64; o <<= 1) v += __shfl_xor(v, o);
    return v;
}
__device__ __forceinline__ float bf2f(bf16 b) { return __uint_as_float((unsigned)b << 16); }
__device__ __forceinline__ void unpack4(const v2u w, float (&f)[4]) { f[0] = __uint_as_float(w.x << 16); f[1] = __uint_as_float(w.x & 0xffff0000u); f[2] = __uint_as_float(w.y << 16); f[3] = __uint_as_float(w.y & 0xffff0000u); }
__device__ __forceinline__ v2u pack4(float a, float b, float c, float d) { v2u w; w.x = cvt_pk_bf16(a, b); w.y = cvt_pk_bf16(c, d); return w; }
#define LDS_WAIT() asm volatile("s_waitcnt lgkmcnt(0)" ::: "memory")

__device__ __forceinline__ v4u gload16(const void* p) { v4u r; asm volatile("global_load_dwordx4 %0, %1, off" : "=v"(r) : "v"(p) : "memory"); return r; }
__device__ __forceinline__ v2u gload8(const void* p) { v2u r; asm volatile("global_load_dwordx2 %0, %1, off" : "=v"(r) : "v"(p) : "memory"); return r; }
__device__ __forceinline__ unsigned gload4(const void* p) { unsigned r; asm volatile("global_load_dword %0, %1, off" : "=v"(r) : "v"(p) : "memory"); return r; }
#define LDS_BARRIER() asm volatile("s_waitcnt lgkmcnt(0)\n\ts_barrier" ::: "memory")
#define VM_DRAIN_KNOWN() __builtin_amdgcn_s_waitcnt(0x0F70)
__device__ __forceinline__ void tr_item(const float* W, int K, int N, bf16* WT, int ldt, int row_off, int col_off, LAS float* scr, int item, int lane) {
    const int nblk = N / 32, kb = item / nblk, nb = item % nblk, k0 = 64 * kb, n0 = 32 * nb;
#pragma unroll 8
    for (int i = 0; i < 32; ++i) { const int kk = 2 * i + (lane >> 5); scr[kk * 33 + (lane & 31)] = W[(size_t)(k0 + kk) * N + n0 + (lane & 31)]; }
    LDS_WAIT(); asm volatile("" ::: "memory");
    const int c = lane & 7;
#pragma unroll
    for (int j = 0; j < 4; ++j) { const int n = (lane >> 3) + 8 * j; const LAS float* s = scr + (8 * c) * 33 + n;
        v4u o; o.x = cvt_pk_bf16(s[0 * 33], s[1 * 33]); o.y = cvt_pk_bf16(s[2 * 33], s[3 * 33]); o.z = cvt_pk_bf16(s[4 * 33], s[5 * 33]); o.w = cvt_pk_bf16(s[6 * 33], s[7 * 33]);
        *(v4u*)(WT + (size_t)(row_off + n0 + n) * ldt + col_off + k0 + 8 * c) = o; }
    LDS_WAIT(); asm volatile("" ::: "memory");
}

__device__ __forceinline__ void phase_conv_ada(const Args& a, LAS unsigned char* lds, int gw, int NGW, int wave, int lane) {
    LAS float* scr = (LAS float*)(lds + wave * 16384);
    bf16* ADAT = (bf16*)(a.ws + WS_BIG);
    constexpr int IPL = 16 * 192;
    for (int it = gw; it < 2 * IPL; it += NGW) { const int l = it / IPL; tr_item(INP(I_ADAW) + (size_t)l * 1024 * 6144, 1024, 6144, ADAT, 1024, l * 6144, 0, scr, it % IPL, lane); }
    bf16* CA = (bf16*)(a.ws + WS_CA);
    for (int r = gw; r < 256; r += NGW) {
        const float* cp = r < 8 ? INP(I_CP) + r * 1024 : INP(I_CS) + (r - 8) * 1024;
#pragma unroll
        for (int j = 0; j < 4; ++j) { const int c = (lane + 64 * j) * 4; f32x4 v = (f32x4){0.f, 0.f, 0.f, 0.f}; if (r < 136) { v = *(const f32x4*)(cp + c); v[0] = silu_(v[0]); v[1] = silu_(v[1]); v[2] = silu_(v[2]); v[3] = silu_(v[3]); }
            *(v2u*)(CA + r * 1024 + c) = pack4(v[0], v[1], v[2], v[3]); }
    }
}
__device__ __forceinline__ void phase_conv_layer(const Args& a, int l, LAS unsigned char* lds, int gw, int NGW, int wave, int lane, int it_lo, int it_hi) {
    LAS float* scr = (LAS float*)(lds + wave * 16384);
    constexpr int I_IN = 16 * 184, I_G = 16 * 128, I_B = 4 * 256, I_O = 16 * 32, I_1 = 16 * 128, I_2 = 64 * 32, NIT = I_IN + I_G + I_B + I_O + I_1 + I_2;
    static_assert(NIT == 10624 && NIT - I_2 == 8576, "item map");
    for (int it = it_lo + gw; it < it_hi; it += NGW) {
        int r = it;
        if (r < I_IN) { tr_item(INP(I_WIN) + (size_t)l * 1024 * 5888, 1024, 5888, (bf16*)(a.ws + WS_WIN), 1024, 0, 0, scr, r, lane); continue; } r -= I_IN;
        if (r < I_G) { tr_item(INP(I_WGATE) + (size_t)l * 1024 * 4096, 1024, 4096, (bf16*)(a.ws + WS_WG), 1024, 0, 0, scr, r, lane); continue; } r -= I_G;
        if (r < I_B) { const int k = r >> 8; tr_item(INP(I_WBR) + (size_t)(l * 4 + k) * 512 * 1024, 512, 1024, (bf16*)(a.ws + WS_WB), 2048, 0, k * 512, scr, r & 255, lane); continue; } r -= I_B;
        if (r < I_O) { tr_item(INP(I_WOUT) + (size_t)l * 1024 * 1024, 1024, 1024, (bf16*)(a.ws + WS_WO), 1024, 0, 0, scr, r, lane); continue; } r -= I_O;
        if (r < I_1) { tr_item(INP(I_WM1) + (size_t)l * 1024 * 4096, 1024, 4096, (bf16*)(a.ws + WS_W1), 1024, 0, 0, scr, r, lane); continue; } r -= I_1;
        tr_item(INP(I_WM2) + (size_t)l * 4096 * 1024, 4096, 1024, (bf16*)(a.ws + WS_W2), 4096, 0, 0, scr, r, lane);
    }
}
__device__ __forceinline__ void phase_norm(const Args& a, int l, int sel, int gw, int NGW, int lane, int row_lo = 0, int row_hi = NTOK) {
    const float* MOD = (const float*)(a.ws + WS_MOD); bf16* H = (bf16*)(a.ws + WS_H);
    const float* gn = (sel == 0 ? INP(I_NMIX) : INP(I_NMLP)) + l * 1024;
    for (int row = row_lo + gw; row < row_hi; row += NGW) {
        const float* xr = (l == 0 && sel == 0) ? (row < NPR ? INP(I_XP) + (size_t)row * 1024 : INP(I_XS) + (size_t)(row - NPR) * 1024) : a.out + (size_t)row * 1024;
        f32x4 v[4]; float ss = 0.f;
#pragma unroll
        for (int j = 0; j < 4; ++j) { v[j] = *(const f32x4*)(xr + (lane + 64 * j) * 4); ss += (v[j][0] * v[j][0] + v[j][1] * v[j][1]) + (v[j][2] * v[j][2] + v[j][3] * v[j][3]); }
        const float rstd = rsqrtf(wave_sum(ss) * (1.f / 1024.f) + 1e-6f);
        const float* mp = MOD + (size_t)cond_of_row(row) * 12288 + l * 6144 + sel * 3072;
#pragma unroll
        for (int j = 0; j < 4; ++j) { const int c = (lane + 64 * j) * 4; const f32x4 g = *(const f32x4*)(gn + c), sh = *(const f32x4*)(mp + c), sc = *(const f32x4*)(mp + 1024 + c);
            float o[4];
#pragma unroll
            for (int i = 0; i < 4; ++i) o[i] = v[j][i] * rstd * g[i] * (1.f + sc[i]) + sh[i];
            *(v2u*)(H + (size_t)row * 1024 + c) = pack4(o[0], o[1], o[2], o[3]); }
    }
}
__device__ __forceinline__ void phase_final(const Args& a, int gw, int NGW, int lane) {
    const float* gn = INP(I_NFIN);
    for (int row = gw; row < NTOK; row += NGW) {
        float* xr = a.out + (size_t)row * 1024;
        f32x4 v[4]; float ss = 0.f;
#pragma unroll
        for (int j = 0; j < 4; ++j) { v[j] = *(const f32x4*)(xr + (lane + 64 * j) * 4); ss += (v[j][0] * v[j][0] + v[j][1] * v[j][1]) + (v[j][2] * v[j][2] + v[j][3] * v[j][3]); }
        const float rstd = rsqrtf(wave_sum(ss) * (1.f / 1024.f) + 1e-6f);
#pragma unroll
        for (int j = 0; j < 4; ++j) { const int c = (lane + 64 * j) * 4; const f32x4 g = *(const f32x4*)(gn + c);
            *(f32x4*)(xr + c) = (f32x4){v[j][0] * rstd * g[0], v[j][1] * rstd * g[1], v[j][2] * rstd * g[2], v[j][3] * rstd * g[3]}; }
    }
}
__device__ __forceinline__ void phase_hg_post(const Args& a, int gw, int NGW, int lane) {
    bf16* BR = (bf16*)(a.ws + WS_BR); const float* SSP = (const float*)(a.ws + WS_SSP); const float* RST = (const float*)(a.ws + WS_RST); const bf16* GC = (const bf16*)(a.ws + WS_G);
    for (int row = gw; row < NTOK; row += NGW) {
        { const int h = lane >> 4; const f32x4 s4 = *(const f32x4*)(SSP + (size_t)row * 16 + h * 4);
          const float rstd = rsqrtf(((s4[0] + s4[1]) + (s4[2] + s4[3])) * (1.f / 128.f) + 1e-6f);
          bf16* p = BR + (size_t)row * 2048 + lane * 8; float v[8]; unpack8(*(const v4u*)p, v);
#pragma unroll
          for (int j = 0; j < 8; ++j) v[j] *= rstd;
          *(v4u*)p = pack8(v); }
        { const int h = lane >> 3; const f32x4 s4 = *(const f32x4*)(RST + (size_t)row * 32 + h * 4);
          const float mean = (s4[0] + s4[2]) * (1.f / 64.f), var = fmaxf((s4[1] + s4[3]) * (1.f / 64.f) - mean * mean, 0.f), rstd = rsqrtf(var + 64e-5f);
          bf16* p = BR + (size_t)row * 2048 + 512 + lane * 8; float y[8], c1[8], c2[8]; unpack8(*(const v4u*)p, y);
          unpack8(*(const v4u*)(GC + (size_t)row * 1024 + lane * 8), c1); unpack8(*(const v4u*)(GC + (size_t)row * 1024 + 512 + lane * 8), c2);
#pragma unroll
          for (int j = 0; j < 8; ++j) y[j] = (y[j] - mean) * rstd * c1[j] + c2[j];
          *(v4u*)p = pack8(y); }
    }
}

#define SEQ_SETUP const bool smp = seq >= 8; const int T = smp ? 8 : 2048; const int row0 = smp ? NPR + (seq - 8) * 8 : seq * 2048; const int bs = seq - 8; \
    const int Bg = smp ? 128 : 8; const int bo = smp ? bs : seq; (void)Bg; (void)bo; (void)bs;

typedef float f32x2 __attribute__((ext_vector_type(2)));
struct HgVec { f32x4 q0, q1, k0, k1, v4; };
__device__ __forceinline__ void hg_load(HgVec& X, const LAS float* b, const LAS float* pv) {
    X.q0 = *(const LAS f32x4*)b; X.q1 = *(const LAS f32x4*)(b + 4); X.k0 = *(const LAS f32x4*)(b + 8192); X.k1 = *(const LAS f32x4*)(b + 8192 + 4); X.v4 = *(const LAS f32x4*)pv;
}
__device__ __forceinline__ float hg_step1(f32x2 (&s)[4], const HgVec& X, float vv) {
    const f32x2 v2 = {vv, vv};
    s[0] = s[0] + X.k0.lo * (v2 - s[0]); s[1] = s[1] + X.k0.hi * (v2 - s[1]); s[2] = s[2] + X.k1.lo * (v2 - s[2]); s[3] = s[3] + X.k1.hi * (v2 - s[3]);
    f32x2 o = s[0] * X.q0.lo; o = s[1] * X.q0.hi + o; f32x2 p = s[2] * X.q1.lo; p = s[3] * X.q1.hi + p; o = o + p;
    return o.x + o.y;
}
__device__ __forceinline__ float hg_red4(float a, float b, float c, float d, bool s1, bool s2) {
    float k1 = s1 ? c : a, k2 = s1 ? d : b; const float n1 = s1 ? a : c, n2 = s1 ? b : d;
    k1 += dppf<0xB1>(n1); k2 += dppf<0xB1>(n2);
    float k = s2 ? k2 : k1; const float n = s2 ? k1 : k2;
    k += dppf<0x4E>(n);
    k += dppf<0x124>(k); k += dppf<0x128>(k);
    return k;
}
struct HgPre { v4u q, k, v; v2u og; };
#define HG_PF_WAIT(P) asm volatile("s_waitcnt vmcnt(0)" : "+v"(P.q), "+v"(P.k), "+v"(P.v), "+v"(P.og) :: "memory")
__device__ __forceinline__ void hg_prefetch(HgPre& P, const bf16* PROJ, int rowc, int tleft, int tid, int h, int vh) {
    const int t = tid >> 4;
    if (t < tleft) { const bf16* p = PROJ + (size_t)(rowc + t) * INC + h * 128; P.q = gload16(p + (tid & 15) * 8); P.k = gload16(p + 512 + (tid & 15) * 8); P.og = gload8(p + 1536 + vh * 64 + (tid & 15) * 4); }
    if (tid < 256 && (tid >> 3) < tleft) P.v = gload16(PROJ + (size_t)(rowc + (tid >> 3)) * INC + 1024 + h * 128 + vh * 64 + (tid & 7) * 8);
}
__device__ __forceinline__ void hg_unit(LAS unsigned char* lds, const MArgs& a, int tid_in, int l, int seq, int h, int vh, int mode) {
    SEQ_SETUP
    const int tid = tid_in, ds = tid & 15, v = ((tid >> 4) & 15) * 4;
    const bool rs1 = (ds & 1) != 0, rs2 = (ds & 2) != 0; const int rcol = 2 * (ds & 1) + ((ds >> 1) & 1);
    const bf16* PROJ = (const bf16*)(a.ws + WS_BIG); bf16* BR = (bf16*)(a.ws + WS_BR); float* SSP = (float*)(a.ws + WS_SSP);
    LAS float* SQ = (LAS float*)lds; LAS float* SK = SQ + 8192; LAS float* SV = SK + 8192; LAS float* SO = SV + 4096;
    HgPre P0, P1; P0.q = (v4u){0u, 0u, 0u, 0u}; P0.k = P0.q; P0.v = P0.q; P0.og = (v2u){0u, 0u}; P1 = P0;
    hg_prefetch(P0, PROJ, row0, T, tid, h, vh); hg_prefetch(P1, PROJ, row0 + 32, T - 32, tid, h, vh);
    f32x2 sc[4][4];
    if (smp && tid < 256) { const float* sp = INP(I_SHG) + ((size_t)(l * 128 + bs) * 4 + h) * 16384 + vh * 64 + v;
#pragma unroll
        for (int j = 0; j < 4; ++j) { const f32x4 x0 = *(const f32x4*)(sp + (ds * 8 + 2 * j) * 128), x1 = *(const f32x4*)(sp + (ds * 8 + 2 * j + 1) * 128);
#pragma unroll
            for (int c = 0; c < 4; ++c) sc[c][j] = (f32x2){x0[c], x1[c]}; } }
    else {
#pragma unroll
        for (int c = 0; c < 4; ++c)
#pragma unroll
            for (int j = 0; j < 4; ++j) sc[c][j] = (f32x2){0.f, 0.f}; }
    const f32x4 hg4 = *(const f32x4*)(INP(I_HGN) + l * 512 + h * 128 + vh * 64 + (tid & 15) * 4);
    VM_DRAIN_KNOWN();
    HG_PF_WAIT(P0); HG_PF_WAIT(P1);
    for (int t0 = 0; t0 < T; t0 += 64) {
        const int tc = (T - t0) < 64 ? (T - t0) : 64;
        const HgPre C0 = P0, C1 = P1;
        if (!(mode & 4)) {
#pragma unroll
          for (int hh = 0; hh < 2; ++hh) { const HgPre& C = hh ? C1 : C0; const int t = (tid >> 4) + 32 * hh, d8 = (tid & 15) * 8;
            if (t < tc) { float q[8], k[8]; unpack8(C.q, q); unpack8(C.k, k);
              *(LAS f32x4*)(SQ + t * 128 + d8) = (f32x4){q[0], q[1], q[2], q[3]}; *(LAS f32x4*)(SQ + t * 128 + d8 + 4) = (f32x4){q[4], q[5], q[6], q[7]};
              *(LAS f32x4*)(SK + t * 128 + d8) = (f32x4){k[0], k[1], k[2], k[3]}; *(LAS f32x4*)(SK + t * 128 + d8 + 4) = (f32x4){k[4], k[5], k[6], k[7]}; }
            if (tid < 256) { const int t2 = (tid >> 3) + 32 * hh, c8 = (tid & 7) * 8;
              if (t2 < tc) { float x[8]; unpack8(C.v, x);
                  *(LAS f32x4*)(SV + t2 * 64 + c8) = (f32x4){x[0], x[1], x[2], x[3]}; *(LAS f32x4*)(SV + t2 * 64 + c8 + 4) = (f32x4){x[4], x[5], x[6], x[7]}; } } } }
        if (t0 + 64 < T) { hg_prefetch(P0, PROJ, row0 + t0 + 64, T - t0 - 64, tid, h, vh); hg_prefetch(P1, PROJ, row0 + t0 + 96, T - t0 - 96, tid, h, vh); }
        LDS_BARRIER();
        if (tid < 256 && !(mode & 2)) { const LAS float* bq = SQ + ds * 8; const LAS float* pv = SV + v;
          HgVec A, B; hg_load(A, bq, pv);
          for (int t = 0; t < tc; t += 2) {
              hg_load(B, bq + (t + 1) * 128, pv + (t + 1) * 64);
              { const float o = hg_red4(hg_step1(sc[0], A, A.v4[0]), hg_step1(sc[1], A, A.v4[1]), hg_step1(sc[2], A, A.v4[2]), hg_step1(sc[3], A, A.v4[3]), rs1, rs2); if (ds < 4) SO[t * 64 + v + rcol] = o; }
              if (t + 2 < tc) hg_load(A, bq + (t + 2) * 128, pv + (t + 2) * 64);
              { const float o = hg_red4(hg_step1(sc[0], B, B.v4[0]), hg_step1(sc[1], B, B.v4[1]), hg_step1(sc[2], B, B.v4[2]), hg_step1(sc[3], B, B.v4[3]), rs1, rs2); if (ds < 4) SO[(t + 1) * 64 + v + rcol] = o; }
          } }
        LDS_BARRIER();
#pragma unroll
        for (int hh = 0; hh < 2; ++hh) { const HgPre& C = hh ? C1 : C0; const int t = (tid >> 4) + 32 * hh, c4 = (tid & 15) * 4;
          if (t < tc && !(mode & 1)) { const int row = row0 + t0 + t; const f32x4 o4 = *(const LAS f32x4*)(SO + t * 64 + c4);
              const float ssq = red8((o4[0] * o4[0] + o4[1] * o4[1]) + (o4[2] * o4[2] + o4[3] * o4[3]));
              if ((tid & 7) == 0) SSP[(size_t)row * 16 + h * 4 + vh * 2 + ((tid & 15) >> 3)] = ssq;
              float g[4]; unpack4(C.og, g);
              *(v2u*)(BR + (size_t)row * 2048 + h * 128 + vh * 64 + c4) = pack4(o4[0] * g[0] * hg4[0], o4[1] * g[1] * hg4[1], o4[2] * g[2] * hg4[2], o4[3] * g[3] * hg4[3]); } }
        HG_PF_WAIT(P0); HG_PF_WAIT(P1);
    }
    if (tid < 256 && !(mode & 1)) { float* so = a.out + (smp ? O_HG_S : O_HG_P) + ((size_t)(l * Bg + bo) * 4 + h) * 16384 + vh * 64 + v;
#pragma unroll
        for (int j = 0; j < 4; ++j) { *(f32x4*)(so + (ds * 8 + 2 * j) * 128) = (f32x4){sc[0][j].x, sc[1][j].x, sc[2][j].x, sc[3][j].x}; *(f32x4*)(so + (ds * 8 + 2 * j + 1) * 128) = (f32x4){sc[0][j].y, sc[1][j].y, sc[2][j].y, sc[3][j].y}; } }
    __syncthreads();
}

struct RwPre { v4u lc0, lc1, lp0, lp1; v2u rc, kc, vc, rp, kp, vp; };
__device__ __forceinline__ void rwkv_prefetch(RwPre& P, const bf16* PROJ, const float* shs, bool smp, int row0, int tg, int sub, int hc) {
    const bf16* pc = PROJ + (size_t)(row0 + tg) * INC + 2048;
    P.lc0 = gload16(pc + 1536 + sub * 16); P.lc1 = gload16(pc + 1536 + sub * 16 + 8);
    P.rc = gload8(pc + hc); P.kc = gload8(pc + 512 + hc); P.vc = gload8(pc + 1024 + hc);
    if (tg > 0) { P.lp0 = gload16(pc - INC + 1536 + sub * 16); P.lp1 = gload16(pc - INC + 1536 + sub * 16 + 8);
        P.rp = gload8(pc - INC + hc); P.kp = gload8(pc - INC + 512 + hc); P.vp = gload8(pc - INC + 1024 + hc); }
    else if (smp) {
        const float* q = shs + 1536 + sub * 16; float t8[8];
#pragma unroll
        for (int i = 0; i < 8; ++i) t8[i] = q[i];
        P.lp0 = pack8(t8);
#pragma unroll
        for (int i = 0; i < 8; ++i) t8[i] = q[8 + i];
        P.lp1 = pack8(t8);
        P.rp = pack4(shs[hc], shs[hc + 1], shs[hc + 2], shs[hc + 3]); P.kp = pack4(shs[512 + hc], shs[512 + hc + 1], shs[512 + hc + 2], shs[512 + hc + 3]);
        P.vp = pack4(shs[1024 + hc], shs[1024 + hc + 1], shs[1024 + hc + 2], shs[1024 + hc + 3]); }
    else { P.lp0 = (v4u){0u, 0u, 0u, 0u}; P.lp1 = P.lp0; P.rp = (v2u){0u, 0u}; P.kp = P.rp; P.vp = P.rp; }
}
#define RW_PF_WAIT(P) asm volatile("s_waitcnt vmcnt(0)" : "+v"(P.lc0), "+v"(P.lc1), "+v"(P.lp0), "+v"(P.lp1), "+v"(P.rc), "+v"(P.kc), "+v"(P.vc), "+v"(P.rp), "+v"(P.kp), "+v"(P.vp) :: "memory")
struct RwVec { f32x4 r, w, k, q, e; f32x2 vv; };
__device__ __forceinline__ void rw_load(RwVec& X, const LAS float* b, const LAS float* pv) {
    X.r = *(const LAS f32x4*)b; X.w = *(const LAS f32x4*)(b + 2048); X.k = *(const LAS f32x4*)(b + 4096); X.q = *(const LAS f32x4*)(b + 6144); X.e = *(const LAS f32x4*)(b + 8192); X.vv = *(const LAS f32x2*)pv;
}
__device__ __forceinline__ f32x2 rw_step2(f32x2 (&s0)[2], f32x2 (&s1)[2], const RwVec& X) {
    f32x2 a0 = s0[0] * X.q.lo; a0 = s0[1] * X.q.hi + a0; f32x2 a1 = s1[0] * X.q.lo; a1 = s1[1] * X.q.hi + a1;
    const float sa0 = -red16(a0.x + a0.y), sa1 = -red16(a1.x + a1.y);
    const f32x2 p0 = {sa0, sa0}, p1 = {sa1, sa1}, v0 = {X.vv.x, X.vv.x}, v1 = {X.vv.y, X.vv.y};
    s0[0] = s0[0] * X.w.lo + (p0 * X.e.lo + v0 * X.k.lo); s0[1] = s0[1] * X.w.hi + (p0 * X.e.hi + v0 * X.k.hi);
    s1[0] = s1[0] * X.w.lo + (p1 * X.e.lo + v1 * X.k.lo); s1[1] = s1[1] * X.w.hi + (p1 * X.e.hi + v1 * X.k.hi);
    f32x2 y0 = s0[0] * X.r.lo; y0 = s0[1] * X.r.hi + y0; f32x2 y1 = s1[0] * X.r.lo; y1 = s1[1] * X.r.hi + y1;
    return (f32x2){red16(y0.x + y0.y), red16(y1.x + y1.y)};
}
__device__ __forceinline__ void rwkv_unit(LAS unsigned char* lds, const MArgs& a, int tid_in, int l, int seq, int h, int half, int mode) {
    SEQ_SETUP
    const int tid = tid_in, lane = tid & 63, wave = __builtin_amdgcn_readfirstlane(tid >> 6);
    const bf16* PROJ = (const bf16*)(a.ws + WS_BIG); bf16* BR = (bf16*)(a.ws + WS_BR);
    LAS bf16* WUPT = (LAS bf16*)(lds + 65664); LAS bf16* AUPT = WUPT + 64 * 72; LAS bf16* GUPT = AUPT + 64 * 72;
    LAS bf16* LRB = (LAS bf16*)(lds + 65664 + 35840);
    LAS float* LWA = (LAS float*)(lds + 65664 + 52736);
    LAS float* SR = (LAS float*)(lds + 0); LAS float* SW = SR + 2048; LAS float* SK = SW + 2048; LAS float* SKK = SK + 2048; LAS float* SKA = SKK + 2048;
    LAS float* SV = SKA + 2048; LAS float* SG = SV + 2048; LAS float* SY = SG + 2048; LAS float* SB = SY + 2048;
    const int st = tid >> 4, sub = tid & 15, c4 = sub * 4, hc = h * 64 + c4;
    const float* mu = INP(I_MU) + l * 1792;
    const float* shs = INP(I_SSH) + (size_t)(l * 128 + (smp ? bs : 0)) * 1792;
    RwPre P;
    P.lc0 = (v4u){0u, 0u, 0u, 0u}; P.lc1 = P.lc0; P.lp0 = P.lc0; P.lp1 = P.lc0; P.rc = (v2u){0u, 0u}; P.kc = P.rc; P.vc = P.rc; P.rp = P.rc; P.kp = P.rc; P.vp = P.rc;
    if (st < T) rwkv_prefetch(P, PROJ, shs, smp, row0, st, sub, hc);
    RW_PF_WAIT(P);
    { const int j = tid >> 3, c8 = (tid & 7) * 8;
      const float* p = INP(I_WUP) + ((size_t)l * 64 + j) * 512 + h * 64 + c8; f32x4 x0 = *(const f32x4*)p, x1 = *(const f32x4*)(p + 4);
#pragma unroll
      for (int i = 0; i < 4; ++i) { WUPT[(c8 + i) * 72 + j] = (bf16)(cvt_pk_bf16(x0[i], 0.f) & 0xffffu); WUPT[(c8 + 4 + i) * 72 + j] = (bf16)(cvt_pk_bf16(x1[i], 0.f) & 0xffffu); }
      p = INP(I_AUP) + ((size_t)l * 64 + j) * 512 + h * 64 + c8; x0 = *(const f32x4*)p; x1 = *(const f32x4*)(p + 4);
#pragma unroll
      for (int i = 0; i < 4; ++i) { AUPT[(c8 + i) * 72 + j] = (bf16)(cvt_pk_bf16(x0[i], 0.f) & 0xffffu); AUPT[(c8 + 4 + i) * 72 + j] = (bf16)(cvt_pk_bf16(x1[i], 0.f) & 0xffffu); }
#pragma unroll
      for (int r = 0; r < 2; ++r) { const int jj = j + 64 * r; p = INP(I_GUP) + ((size_t)l * 128 + jj) * 512 + h * 64 + c8; x0 = *(const f32x4*)p; x1 = *(const f32x4*)(p + 4);
#pragma unroll
          for (int i = 0; i < 4; ++i) { GUPT[(c8 + i) * 136 + jj] = (bf16)(cvt_pk_bf16(x0[i], 0.f) & 0xffffu); GUPT[(c8 + 4 + i) * 136 + jj] = (bf16)(cvt_pk_bf16(x1[i], 0.f) & 0xffffu); } } }
    const bool both = smp;
    const int hsel = both ? (tid >> 8) : half;
    const int sv = hsel * 32 + ((tid >> 4) & 15) * 2, ks = tid & 15;
    f32x2 s0[2], s1[2];
    if (smp) { const float* sp = INP(I_SRW) + ((size_t)(l * 128 + bs) * 8 + h) * 4096 + sv * 64 + ks * 4; const f32x4 x0 = *(const f32x4*)sp, x1 = *(const f32x4*)(sp + 64);
        s0[0] = x0.lo; s0[1] = x0.hi; s1[0] = x1.lo; s1[1] = x1.hi; }
    else { s0[0] = (f32x2){0.f, 0.f}; s0[1] = s0[0]; s1[0] = s0[0]; s1[1] = s0[0]; }
    f32x4 pw0, pa0, pkk, pka, prk, plg, plb;
    { pw0 = *(const f32x4*)(INP(I_W0) + l * 512 + hc); pa0 = *(const f32x4*)(INP(I_A0) + l * 512 + hc); pkk = *(const f32x4*)(INP(I_KK) + l * 512 + hc); pka = *(const f32x4*)(INP(I_KA) + l * 512 + hc);
      prk = *(const f32x4*)(INP(I_RK) + l * 512 + hc); plg = *(const f32x4*)(INP(I_LNG) + l * 512 + hc); plb = *(const f32x4*)(INP(I_LNB) + l * 512 + hc); }
    VM_DRAIN_KNOWN();
    for (int t0 = 0; t0 < T; t0 += 32) {
        const int tc = (T - t0) < 32 ? (T - t0) : 32;
        const int grow = row0 + t0 + st;
        const RwPre C = P;
        if (st < tc && !(mode & 4)) { const int j0 = sub * 16;
#pragma unroll
            for (int hh = 0; hh < 2; ++hh) { float xc[8], xp[8]; unpack8(hh ? C.lc1 : C.lc0, xc); unpack8(hh ? C.lp1 : C.lp0, xp);
                const f32x4 m0 = *(const f32x4*)(mu + 1536 + j0 + 8 * hh), m1 = *(const f32x4*)(mu + 1536 + j0 + 8 * hh + 4);
                float o[8];
#pragma unroll
                for (int i = 0; i < 8; ++i) { float x = xc[i] + (xp[i] - xc[i]) * (i < 4 ? m0[i] : m1[i - 4]); o[i] = j0 < 64 ? tanh_(x) : (j0 < 128 ? x : sigm(x)); }
                *(LAS v4u*)(LRB + st * 264 + j0 + 8 * hh) = pack8(o); } }
        LDS_BARRIER();
        { const int mt = wave >> 2, nt = wave & 3, fr = lane & 15, fq = lane >> 4;
          if (mt * 16 < tc && !(mode & 4)) {
              f32x4 cw = {0.f, 0.f, 0.f, 0.f}, ca = {0.f, 0.f, 0.f, 0.f}, cgt = {0.f, 0.f, 0.f, 0.f};
              const LAS bf16* ar = LRB + (mt * 16 + fr) * 264 + fq * 8;
#pragma unroll
              for (int kk = 0; kk < 2; ++kk) {
                  cw = __builtin_amdgcn_mfma_f32_16x16x32_bf16(*(const LAS pg8::bf16x8*)(ar + kk * 32), *(const LAS pg8::bf16x8*)(WUPT + (nt * 16 + fr) * 72 + kk * 32 + fq * 8), cw, 0, 0, 0);
                  ca = __builtin_amdgcn_mfma_f32_16x16x32_bf16(*(const LAS pg8::bf16x8*)(ar + 64 + kk * 32), *(const LAS pg8::bf16x8*)(AUPT + (nt * 16 + fr) * 72 + kk * 32 + fq * 8), ca, 0, 0, 0); }
#pragma unroll
              for (int kk = 0; kk < 4; ++kk)
                  cgt = __builtin_amdgcn_mfma_f32_16x16x32_bf16(*(const LAS pg8::bf16x8*)(ar + 128 + kk * 32), *(const LAS pg8::bf16x8*)(GUPT + (nt * 16 + fr) * 136 + kk * 32 + fq * 8), cgt, 0, 0, 0);
#pragma unroll
              for (int j = 0; j < 4; ++j) { const int o = (mt * 16 + fq * 4 + j) * 64 + nt * 16 + fr; LWA[o] = cw[j]; LWA[2048 + o] = ca[j]; LWA[4096 + o] = cgt[j]; } } }
        LDS_BARRIER();
        if (st < tc && !(mode & 4)) {
            const f32x4 lw = *(const LAS f32x4*)(LWA + st * 64 + c4), la = *(const LAS f32x4*)(LWA + 2048 + st * 64 + c4), lg = *(const LAS f32x4*)(LWA + 4096 + st * 64 + c4);
            float r4[4], k4[4], v4[4];
            { float rc[4], kc[4], vc[4], rp[4], kp[4], vp[4]; unpack4(C.rc, rc); unpack4(C.kc, kc); unpack4(C.vc, vc); unpack4(C.rp, rp); unpack4(C.kp, kp); unpack4(C.vp, vp);
              const f32x4 mr = *(const f32x4*)(mu + hc), mk = *(const f32x4*)(mu + 512 + hc), mv = *(const f32x4*)(mu + 1024 + hc);
#pragma unroll
              for (int i = 0; i < 4; ++i) { r4[i] = rc[i] + (rp[i] - rc[i]) * mr[i]; k4[i] = kc[i] + (kp[i] - kc[i]) * mk[i]; v4[i] = vc[i] + (vp[i] - vc[i]) * mv[i]; } }
            float wd[4], av[4], kkr[4]; float ssq = 0.f;
#pragma unroll
            for (int i = 0; i < 4; ++i) { wd[i] = __expf(-0.606531f * sigm(pw0[i] + lw[i])); av[i] = sigm(pa0[i] + la[i]); kkr[i] = k4[i] * pkk[i]; ssq += kkr[i] * kkr[i]; }
            ssq = red16(ssq); const float inv = 1.f / fmaxf(sqrtf(ssq), 1e-12f);
            float bon = 0.f; float k2[4], kkv[4], kav[4];
#pragma unroll
            for (int i = 0; i < 4; ++i) { kkv[i] = kkr[i] * inv; k2[i] = k4[i] * (1.f + (av[i] - 1.f) * pka[i]); kav[i] = kkv[i] * av[i]; bon += r4[i] * k2[i] * prk[i]; }
            *(LAS f32x4*)(SR + st * 64 + c4) = (f32x4){r4[0], r4[1], r4[2], r4[3]}; *(LAS f32x4*)(SW + st * 64 + c4) = (f32x4){wd[0], wd[1], wd[2], wd[3]};
            *(LAS f32x4*)(SK + st * 64 + c4) = (f32x4){k2[0], k2[1], k2[2], k2[3]}; *(LAS f32x4*)(SKK + st * 64 + c4) = (f32x4){kkv[0], kkv[1], kkv[2], kkv[3]};
            *(LAS f32x4*)(SKA + st * 64 + c4) = (f32x4){kav[0], kav[1], kav[2], kav[3]}; *(LAS f32x4*)(SV + st * 64 + c4) = (f32x4){v4[0], v4[1], v4[2], v4[3]};
            *(LAS f32x4*)(SG + st * 64 + c4) = lg;
            bon = red16(bon); if (sub == 0) SB[st] = bon;
        }
        if (t0 + 32 + st < T) rwkv_prefetch(P, PROJ, shs, smp, row0, t0 + 32 + st, sub, hc);
        LDS_BARRIER();
        if ((both || tid < 256) && !(mode & 2)) { const LAS float* b0 = SR + ks * 4; const LAS float* pv = SV + sv;
          RwVec A, B; rw_load(A, b0, pv);
          for (int t = 0; t < tc; t += 2) {
              rw_load(B, b0 + (t + 1) * 64, pv + (t + 1) * 64);
              const f32x2 ya = rw_step2(s0, s1, A);
              if (ks == 0) *(LAS f32x2*)(SY + t * 64 + sv) = ya;
              if (t + 2 < tc) rw_load(A, b0 + (t + 2) * 64, pv + (t + 2) * 64);
              const f32x2 yb = rw_step2(s0, s1, B);
              if (ks == 0) *(LAS f32x2*)(SY + (t + 1) * 64 + sv) = yb;
          } }
        RW_PF_WAIT(P);
        LDS_BARRIER();
        if (st < tc && (both || (sub >> 3) == half) && !(mode & 1)) {
            const f32x4 y4 = *(const LAS f32x4*)(SY + st * 64 + c4);
            const float sy = red8((y4[0] + y4[1]) + (y4[2] + y4[3])), sq = red8((y4[0] * y4[0] + y4[1] * y4[1]) + (y4[2] * y4[2] + y4[3] * y4[3]));
            if ((sub & 7) == 0) *(f32x2*)((float*)(a.ws + WS_RST) + (size_t)grow * 32 + h * 4 + (sub >> 3) * 2) = (f32x2){sy, sq};
            const float bon = SB[st];
            const f32x4 vv4 = *(const LAS f32x4*)(SV + st * 64 + c4), gg4 = *(const LAS f32x4*)(SG + st * 64 + c4);
            float c1[4], c2[4];
#pragma unroll
            for (int i = 0; i < 4; ++i) { c1[i] = plg[i] * gg4[i]; c2[i] = (plb[i] + bon * vv4[i]) * gg4[i]; }
            *(v2u*)(BR + (size_t)grow * 2048 + 512 + hc) = pack4(y4[0], y4[1], y4[2], y4[3]);
            bf16* GC = (bf16*)(a.ws + WS_G) + (size_t)grow * 1024;
            *(v2u*)(GC + hc) = pack4(c1[0], c1[1], c1[2], c1[3]); *(v2u*)(GC + 512 + hc) = pack4(c2[0], c2[1], c2[2], c2[3]);
        }
    }
    if ((both || tid < 256) && !(mode & 1)) { float* so = a.out + (smp ? O_RW_S : O_RW_P) + ((size_t)(l * Bg + bo) * 8 + h) * 4096 + sv * 64 + ks * 4;
      *(f32x4*)so = (f32x4){s0[0].x, s0[0].y, s0[1].x, s0[1].y}; *(f32x4*)(so + 64) = (f32x4){s1[0].x, s1[0].y, s1[1].x, s1[1].y}; }
    { float* sh = a.out + (smp ? O_SH_S : O_SH_P) + (size_t)(l * Bg + bo) * 1792; const bf16* pl = PROJ + (size_t)(row0 + T - 1) * INC + 2048;
      if ((both || half == 0) && tid < 64 && !(mode & 1)) { sh[h * 64 + tid] = bf2f(pl[h * 64 + tid]); sh[512 + h * 64 + tid] = bf2f(pl[512 + h * 64 + tid]); sh[1024 + h * 64 + tid] = bf2f(pl[1024 + h * 64 + tid]); }
      if ((both || half == 0) && h == 0 && tid >= 256 && !(mode & 1)) sh[1536 + tid - 256] = bf2f(pl[1536 + tid - 256]); }
    __syncthreads();
}

__device__ __forceinline__ void rw_load16(RwVec& X, const LAS float* b, const LAS float* pv) {
    X.r = *(const LAS f32x4*)b; X.w = *(const LAS f32x4*)(b + 1024); X.k = *(const LAS f32x4*)(b + 2048); X.q = *(const LAS f32x4*)(b + 3072); X.e = *(const LAS f32x4*)(b + 4096); X.vv = *(const LAS f32x2*)pv;
}
#define RW_SCAN16(TLO, THI) do { const LAS float* b0_ = Sc + ks * 4; const LAS float* pv_ = Sc + 5120 + sv; LAS float* sy_ = SY + (c & 1) * 1024 + sv; \
        RwVec A_, B_; rw_load16(A_, b0_ + (TLO) * 64, pv_ + (TLO) * 64); \
        for (int t = (TLO); t < (THI); t += 2) { rw_load16(B_, b0_ + (t + 1) * 64, pv_ + (t + 1) * 64); \
            const f32x2 ya_ = rw_step2(s0, s1, A_); if (ks == 0) *(LAS f32x2*)(sy_ + t * 64) = ya_; \
            if (t + 2 < (THI)) rw_load16(A_, b0_ + (t + 2) * 64, pv_ + (t + 2) * 64); \
            const f32x2 yb_ = rw_step2(s0, s1, B_); if (ks == 0) *(LAS f32x2*)(sy_ + (t + 1) * 64) = yb_; } } while (0)
#define RWPC_PF_LR(P, pcp) do { P.lc0 = gload16((pcp) + 1536 + sub * 16); P.lc1 = gload16((pcp) + 1536 + sub * 16 + 8); P.lp0 = gload16((pcp) - INC + 1536 + sub * 16); P.lp1 = gload16((pcp) - INC + 1536 + sub * 16 + 8); } while (0)
#define RWPC_PF_RKV(P, pcp) do { P.rc = gload8((pcp) + hc); P.kc = gload8((pcp) + 512 + hc); P.vc = gload8((pcp) + 1024 + hc); P.rp = gload8((pcp) - INC + hc); P.kp = gload8((pcp) - INC + 512 + hc); P.vp = gload8((pcp) - INC + 1024 + hc); } while (0)
#define RWPC_WAIT_LR(P) asm volatile("s_waitcnt vmcnt(0)" : "+v"(P.lc0), "+v"(P.lc1), "+v"(P.lp0), "+v"(P.lp1) :: "memory")
#define RWPC_WAIT_RKV(P) asm volatile("s_waitcnt vmcnt(4)" : "+v"(P.rc), "+v"(P.kc), "+v"(P.vc), "+v"(P.rp), "+v"(P.kp), "+v"(P.vp) :: "memory")
__device__ __forceinline__ void rwkv_unit_pc(LAS unsigned char* lds, const MArgs& a, int tid_in, int l, int seq, int h, int half) {
    constexpr int T = 2048, NC = T / 16;
    const int row0 = seq * 2048;
    const int tid = tid_in, lane = tid & 63, wave = __builtin_amdgcn_readfirstlane(tid >> 6);
    const bool prod = wave >= 4;
    const bf16* PROJ = (const bf16*)(a.ws + WS_BIG); bf16* BR = (bf16*)(a.ws + WS_BR);
    LAS float* SS = (LAS float*)lds;
    LAS float* SY = (LAS float*)(lds + 57344);
    LAS float* SB = (LAS float*)(lds + 65536);
    LAS bf16* WUPT = (LAS bf16*)(lds + 65664); LAS bf16* AUPT = WUPT + 64 * 72; LAS bf16* GUPT = AUPT + 64 * 72;
    LAS bf16* LRB = (LAS bf16*)(lds + 101504);
    LAS float* LWA = (LAS float*)(lds + 109952);
    const int st = (tid & 255) >> 4, sub = tid & 15, c4 = sub * 4, hc = h * 64 + c4;
    const float* mu = INP(I_MU) + l * 1792;
    RwPre P;
    P.lc0 = (v4u){0u, 0u, 0u, 0u}; P.lc1 = P.lc0; P.lp0 = P.lc0; P.lp1 = P.lc0; P.rc = (v2u){0u, 0u}; P.kc = P.rc; P.vc = P.rc; P.rp = P.rc; P.kp = P.rc; P.vp = P.rc;
    if (prod) { rwkv_prefetch(P, PROJ, mu, false, row0, st, sub, hc); RW_PF_WAIT(P); }
    { const int j = tid >> 3, c8 = (tid & 7) * 8;
      const float* p = INP(I_WUP) + ((size_t)l * 64 + j) * 512 + h * 64 + c8; f32x4 x0 = *(const f32x4*)p, x1 = *(const f32x4*)(p + 4);
#pragma unroll
      for (int i = 0; i < 4; ++i) { WUPT[(c8 + i) * 72 + j] = (bf16)(cvt_pk_bf16(x0[i], 0.f) & 0xffffu); WUPT[(c8 + 4 + i) * 72 + j] = (bf16)(cvt_pk_bf16(x1[i], 0.f) & 0xffffu); }
      p = INP(I_AUP) + ((size_t)l * 64 + j) * 512 + h * 64 + c8; x0 = *(const f32x4*)p; x1 = *(const f32x4*)(p + 4);
#pragma unroll
      for (int i = 0; i < 4; ++i) { AUPT[(c8 + i) * 72 + j] = (bf16)(cvt_pk_bf16(x0[i], 0.f) & 0xffffu); AUPT[(c8 + 4 + i) * 72 + j] = (bf16)(cvt_pk_bf16(x1[i], 0.f) & 0xffffu); }
#pragma unroll
      for (int r = 0; r < 2; ++r) { const int jj = j + 64 * r; p = INP(I_GUP) + ((size_t)l * 128 + jj) * 512 + h * 64 + c8; x0 = *(const f32x4*)p; x1 = *(const f32x4*)(p + 4);
#pragma unroll
          for (int i = 0; i < 4; ++i) { GUPT[(c8 + i) * 136 + jj] = (bf16)(cvt_pk_bf16(x0[i], 0.f) & 0xffffu); GUPT[(c8 + 4 + i) * 136 + jj] = (bf16)(cvt_pk_bf16(x1[i], 0.f) & 0xffffu); } } }
    const int sv = half * 32 + ((tid >> 4) & 15) * 2, ks = tid & 15;
    f32x2 s0[2], s1[2];
    s0[0] = (f32x2){0.f, 0.f}; s0[1] = s0[0]; s1[0] = s0[0]; s1[1] = s0[0];
    const f32x4 pw0 = *(const f32x4*)(INP(I_W0) + l * 512 + hc), pa0 = *(const f32x4*)(INP(I_A0) + l * 512 + hc), pkk = *(const f32x4*)(INP(I_KK) + l * 512 + hc), pka = *(const f32x4*)(INP(I_KA) + l * 512 + hc);
    const f32x4 prk = *(const f32x4*)(INP(I_RK) + l * 512 + hc), plg = *(const f32x4*)(INP(I_LNG) + l * 512 + hc), plb = *(const f32x4*)(INP(I_LNB) + l * 512 + hc);
    const f32x4 mr = *(const f32x4*)(mu + hc), mk = *(const f32x4*)(mu + 512 + hc), mv = *(const f32x4*)(mu + 1024 + hc);
    f32x4 ml[4];
#pragma unroll
    for (int i = 0; i < 4; ++i) ml[i] = *(const f32x4*)(mu + 1536 + sub * 16 + 4 * i);
    VM_DRAIN_KNOWN();
    LDS_BARRIER();
    for (int c = -1; c < NC; ++c) {
        const int pc = c + 1;
        LAS float* Sp = SS + (pc & 1) * 7168; const LAS float* Sc = SS + (c & 1) * 7168;
        if (prod && pc < NC) { const bf16* pcp = PROJ + (size_t)(row0 + pc * 16 + st) * INC + 2048; RWPC_PF_RKV(P, pcp); }
        if (prod) {
            if (pc < NC) { const int j0 = sub * 16;
#pragma unroll
                for (int hh = 0; hh < 2; ++hh) { float xc[8], xp[8]; unpack8(hh ? P.lc1 : P.lc0, xc); unpack8(hh ? P.lp1 : P.lp0, xp);
                    float o[8];
#pragma unroll
                    for (int i = 0; i < 8; ++i) { const float m_ = ml[2 * hh + (i >> 2)][i & 3]; float x = xc[i] + (xp[i] - xc[i]) * m_; o[i] = j0 < 64 ? tanh_(x) : (j0 < 128 ? x : sigm(x)); }
                    *(LAS v4u*)(LRB + st * 264 + j0 + 8 * hh) = pack8(o); } }
            if (pc + 1 < NC) { const bf16* pcp = PROJ + (size_t)(row0 + (pc + 1) * 16 + st) * INC + 2048; RWPC_PF_LR(P, pcp); }
        } else {
            if (c >= 1 && (sub >> 3) == half) {
                const int cc = c - 1, grow = row0 + cc * 16 + st; const LAS float* Sq = SS + (cc & 1) * 7168;
                const f32x4 y4 = *(const LAS f32x4*)(SY + (cc & 1) * 1024 + st * 64 + c4);
                const float sy = red8((y4[0] + y4[1]) + (y4[2] + y4[3])), sq = red8((y4[0] * y4[0] + y4[1] * y4[1]) + (y4[2] * y4[2] + y4[3] * y4[3]));
                if ((sub & 7) == 0) *(f32x2*)((float*)(a.ws + WS_RST) + (size_t)grow * 32 + h * 4 + half * 2) = (f32x2){sy, sq};
                const float bon = SB[(cc & 1) * 16 + st];
                const f32x4 vv4 = *(const LAS f32x4*)(Sq + 5120 + st * 64 + c4), gg4 = *(const LAS f32x4*)(Sq + 6144 + st * 64 + c4);
                float c1[4], c2[4];
#pragma unroll
                for (int i = 0; i < 4; ++i) { c1[i] = plg[i] * gg4[i]; c2[i] = (plb[i] + bon * vv4[i]) * gg4[i]; }
                *(v2u*)(BR + (size_t)grow * 2048 + 512 + hc) = pack4(y4[0], y4[1], y4[2], y4[3]);
                bf16* GC = (bf16*)(a.ws + WS_G) + (size_t)grow * 1024;
                *(v2u*)(GC + hc) = pack4(c1[0], c1[1], c1[2], c1[3]); *(v2u*)(GC + 512 + hc) = pack4(c2[0], c2[1], c2[2], c2[3]);
            }
            if (c >= 0) RW_SCAN16(0, 6);
        }
        LDS_BARRIER();
        if (prod) {
            if (pc < NC) { const int nt = wave - 4, fr = lane & 15, fq = lane >> 4;
                f32x4 cw = {0.f, 0.f, 0.f, 0.f}, ca = {0.f, 0.f, 0.f, 0.f}, cgt = {0.f, 0.f, 0.f, 0.f};
                const LAS bf16* ar = LRB + fr * 264 + fq * 8;
#pragma unroll
                for (int kk = 0; kk < 2; ++kk) {
                    cw = __builtin_amdgcn_mfma_f32_16x16x32_bf16(*(const LAS pg8::bf16x8*)(ar + kk * 32), *(const LAS pg8::bf16x8*)(WUPT + (nt * 16 + fr) * 72 + kk * 32 + fq * 8), cw, 0, 0, 0);
                    ca = __builtin_amdgcn_mfma_f32_16x16x32_bf16(*(const LAS pg8::bf16x8*)(ar + 64 + kk * 32), *(const LAS pg8::bf16x8*)(AUPT + (nt * 16 + fr) * 72 + kk * 32 + fq * 8), ca, 0, 0, 0); }
#pragma unroll
                for (int kk = 0; kk < 4; ++kk)
                    cgt = __builtin_amdgcn_mfma_f32_16x16x32_bf16(*(const LAS pg8::bf16x8*)(ar + 128 + kk * 32), *(const LAS pg8::bf16x8*)(GUPT + (nt * 16 + fr) * 136 + kk * 32 + fq * 8), cgt, 0, 0, 0);
#pragma unroll
                for (int j = 0; j < 4; ++j) { const int o = (fq * 4 + j) * 64 + nt * 16 + fr; LWA[o] = cw[j]; LWA[1024 + o] = ca[j]; LWA[2048 + o] = cgt[j]; } }
        } else if (c >= 0) RW_SCAN16(6, 12);
        LDS_BARRIER();
        if (prod) {
            if (pc + 1 >= NC) asm volatile("s_waitcnt vmcnt(0)" ::: "memory");
            RWPC_WAIT_RKV(P);
            if (pc == 0 && st == 0) { P.rp = (v2u){0u, 0u}; P.kp = P.rp; P.vp = P.rp; }
            if (pc < NC) {
                const f32x4 lw = *(const LAS f32x4*)(LWA + st * 64 + c4), la = *(const LAS f32x4*)(LWA + 1024 + st * 64 + c4), lg = *(const LAS f32x4*)(LWA + 2048 + st * 64 + c4);
                float r4[4], k4[4], v4[4];
                { float rc[4], kc[4], vc[4], rp[4], kp[4], vp[4]; unpack4(P.rc, rc); unpack4(P.kc, kc); unpack4(P.vc, vc); unpack4(P.rp, rp); unpack4(P.kp, kp); unpack4(P.vp, vp);
#pragma unroll
                  for (int i = 0; i < 4; ++i) { r4[i] = rc[i] + (rp[i] - rc[i]) * mr[i]; k4[i] = kc[i] + (kp[i] - kc[i]) * mk[i]; v4[i] = vc[i] + (vp[i] - vc[i]) * mv[i]; } }
                float wd[4], av[4], kkr[4]; float ssq = 0.f;
#pragma unroll
                for (int i = 0; i < 4; ++i) { wd[i] = __expf(-0.606531f * sigm(pw0[i] + lw[i])); av[i] = sigm(pa0[i] + la[i]); kkr[i] = k4[i] * pkk[i]; ssq += kkr[i] * kkr[i]; }
                ssq = red16(ssq); const float inv = 1.f / fmaxf(sqrtf(ssq), 1e-12f);
                float bon = 0.f; float k2[4], kkv[4], kav[4];
#pragma unroll
                for (int i = 0; i < 4; ++i) { kkv[i] = kkr[i] * inv; k2[i] = k4[i] * (1.f + (av[i] - 1.f) * pka[i]); kav[i] = kkv[i] * av[i]; bon += r4[i] * k2[i] * prk[i]; }
                LAS float* d = Sp + st * 64 + c4;
                *(LAS f32x4*)d = (f32x4){r4[0], r4[1], r4[2], r4[3]}; *(LAS f32x4*)(d + 1024) = (f32x4){wd[0], wd[1], wd[2], wd[3]};
                *(LAS f32x4*)(d + 2048) = (f32x4){k2[0], k2[1], k2[2], k2[3]}; *(LAS f32x4*)(d + 3072) = (f32x4){kkv[0], kkv[1], kkv[2], kkv[3]};
                *(LAS f32x4*)(d + 4096) = (f32x4){kav[0], kav[1], kav[2], kav[3]}; *(LAS f32x4*)(d + 5120) = (f32x4){v4[0], v4[1], v4[2], v4[3]};
                *(LAS f32x4*)(d + 6144) = lg;
                bon = red16(bon); if (sub == 0) SB[(pc & 1) * 16 + st] = bon;
            }
            RWPC_WAIT_LR(P);
        } else if (c >= 0) RW_SCAN16(12, 16);
        LDS_BARRIER();
    }
    if (!prod && (sub >> 3) == half) {
        const int cc = NC - 1, grow = row0 + cc * 16 + st; const LAS float* Sq = SS + (cc & 1) * 7168;
        const f32x4 y4 = *(const LAS f32x4*)(SY + (cc & 1) * 1024 + st * 64 + c4);
        const float sy = red8((y4[0] + y4[1]) + (y4[2] + y4[3])), sq = red8((y4[0] * y4[0] + y4[1] * y4[1]) + (y4[2] * y4[2] + y4[3] * y4[3]));
        if ((sub & 7) == 0) *(f32x2*)((float*)(a.ws + WS_RST) + (size_t)grow * 32 + h * 4 + half * 2) = (f32x2){sy, sq};
        const float bon = SB[(cc & 1) * 16 + st];
        const f32x4 vv4 = *(const LAS f32x4*)(Sq + 5120 + st * 64 + c4), gg4 = *(const LAS f32x4*)(Sq + 6144 + st * 64 + c4);
        float c1[4], c2[4];
#pragma unroll
        for (int i = 0; i < 4; ++i) { c1[i] = plg[i] * gg4[i]; c2[i] = (plb[i] + bon * vv4[i]) * gg4[i]; }
        *(v2u*)(BR + (size_t)grow * 2048 + 512 + hc) = pack4(y4[0], y4[1], y4[2], y4[3]);
        bf16* GC = (bf16*)(a.ws + WS_G) + (size_t)grow * 1024;
        *(v2u*)(GC + hc) = pack4(c1[0], c1[1], c1[2], c1[3]); *(v2u*)(GC + 512 + hc) = pack4(c2[0], c2[1], c2[2], c2[3]);
    }
    if (!prod) { float* so = a.out + O_RW_P + ((size_t)(l * 8 + seq) * 8 + h) * 4096 + sv * 64 + ks * 4;
      *(f32x4*)so = (f32x4){s0[0].x, s0[0].y, s0[1].x, s0[1].y}; *(f32x4*)(so + 64) = (f32x4){s1[0].x, s1[0].y, s1[1].x, s1[1].y}; }
    { float* sh = a.out + O_SH_P + (size_t)(l * 8 + seq) * 1792; const bf16* pl = PROJ + (size_t)(row0 + T - 1) * INC + 2048;
      if (half == 0 && tid < 64) { sh[h * 64 + tid] = bf2f(pl[h * 64 + tid]); sh[512 + h * 64 + tid] = bf2f(pl[512 + h * 64 + tid]); sh[1024 + h * 64 + tid] = bf2f(pl[1024 + h * 64 + tid]); }
      if (half == 0 && h == 0 && tid >= 256) sh[1536 + tid - 256] = bf2f(pl[1536 + tid - 256]); }
    __syncthreads();
}

struct LrPre { v2u x0, x1, x2, x3, g; };
#define LR_PF_WAIT(P) asm volatile("s_waitcnt vmcnt(0)" : "+v"(P.x0), "+v"(P.x1), "+v"(P.x2), "+v"(P.x3), "+v"(P.g) :: "memory")
__device__ __forceinline__ void lru_prefetch(LrPre& P, const bf16* PROJ, const float* cst, bool smp, int row0, int tg, int ch) {
    const bf16* p = PROJ + (size_t)(row0 + tg) * INC + 4864 + ch;
    P.g = gload8(p + 512); P.x3 = gload8(p);
    if (tg >= 3) { P.x2 = gload8(p - INC); P.x1 = gload8(p - 2 * INC); P.x0 = gload8(p - 3 * INC); }
    else {
        v2u* dst[3] = {&P.x2, &P.x1, &P.x0};
#pragma unroll
        for (int j = 0; j < 3; ++j) { const int ts = tg - 1 - j;
            if (ts >= 0) *dst[j] = gload8(p - (j + 1) * INC);
            else if (smp) { const float* q = cst + (3 + ts) * 512 + ch; *dst[j] = pack4(q[0], q[1], q[2], q[3]); }
            else *dst[j] = (v2u){0u, 0u}; } }
}
__device__ __forceinline__ void lru_unit(LAS unsigned char* lds, const MArgs& a, int tid_in, int l, int seq, int n) {
    SEQ_SETUP
    const int tid = tid_in, lane = tid & 63, wave = __builtin_amdgcn_readfirstlane(tid >> 6);
    const bf16* PROJ = (const bf16*)(a.ws + WS_BIG); bf16* BR = (bf16*)(a.ws + WS_BR);
    LAS bf16* WAT = (LAS bf16*)lds; LAS bf16* WXT = WAT + 64 * 72; LAS bf16* XCB = WXT + 64 * 72;
    LAS float* RA = (LAS float*)(lds + 23040); LAS float* RI = RA + 2048; LAS float* AA = RI + 2048; LAS float* BB = AA + 2048; LAS float* HS = BB + 2048;
    const int st = tid >> 4, sub = tid & 15, d4 = sub * 4, ch = n * 64 + d4;
    const float* cst = INP(I_SLC) + (size_t)(l * 128 + (smp ? bs : 0)) * 3 * 512;
    LrPre P; P.x0 = (v2u){0u, 0u}; P.x1 = P.x0; P.x2 = P.x0; P.x3 = P.x0; P.g = P.x0;
    if (st < T) lru_prefetch(P, PROJ, cst, smp, row0, st, ch);
    LR_PF_WAIT(P);
    { const int c = tid >> 3, d8 = (tid & 7) * 8;
      const float* p = INP(I_LWA) + (size_t)(l * 8 + n) * 4096 + c * 64 + d8; f32x4 x0 = *(const f32x4*)p, x1 = *(const f32x4*)(p + 4);
#pragma unroll
      for (int i = 0; i < 4; ++i) { WAT[(d8 + i) * 72 + c] = (bf16)(cvt_pk_bf16(x0[i], 0.f) & 0xffffu); WAT[(d8 + 4 + i) * 72 + c] = (bf16)(cvt_pk_bf16(x1[i], 0.f) & 0xffffu); }
      p = INP(I_LWX) + (size_t)(l * 8 + n) * 4096 + c * 64 + d8; x0 = *(const f32x4*)p; x1 = *(const f32x4*)(p + 4);
#pragma unroll
      for (int i = 0; i < 4; ++i) { WXT[(d8 + i) * 72 + c] = (bf16)(cvt_pk_bf16(x0[i], 0.f) & 0xffffu); WXT[(d8 + 4 + i) * 72 + c] = (bf16)(cvt_pk_bf16(x1[i], 0.f) & 0xffffu); } }
    float hprev = (smp && wave == 0) ? INP(I_SLH)[(size_t)(l * 128 + bs) * 512 + n * 64 + lane] : 0.f;
    float cw[4][4], cb[4], ba[4], bx[4], sp[4];
#pragma unroll
    for (int i = 0; i < 4; ++i) {
#pragma unroll
        for (int j = 0; j < 4; ++j) cw[j][i] = INP(I_LCW)[(l * 4 + j) * 512 + ch + i];
        cb[i] = INP(I_LCB)[l * 512 + ch + i]; ba[i] = INP(I_LBA)[l * 512 + ch + i]; bx[i] = INP(I_LBX)[l * 512 + ch + i];
        const float lam = INP(I_LAM)[l * 512 + ch + i]; sp[i] = log1pf(__expf(-lam)); }
    VM_DRAIN_KNOWN();
    for (int t0 = 0; t0 < T; t0 += 32) {
        const int tc = (T - t0) < 32 ? (T - t0) : 32;
        const int grow = row0 + t0 + st;
        const LrPre C = P;
        float xc[4], gl[4];
        if (st < tc) { float x0[4], x1[4], x2[4], x3[4]; unpack4(C.x0, x0); unpack4(C.x1, x1); unpack4(C.x2, x2); unpack4(C.x3, x3); unpack4(C.g, gl);
#pragma unroll
            for (int i = 0; i < 4; ++i) xc[i] = cb[i] + cw[0][i] * x0[i] + cw[1][i] * x1[i] + cw[2][i] * x2[i] + cw[3][i] * x3[i];
            *(LAS v2u*)(XCB + st * 72 + d4) = pack4(xc[0], xc[1], xc[2], xc[3]); }
        LDS_BARRIER();
        { const int mt = wave >> 2, nq = wave & 3, fr = lane & 15, fq = lane >> 4;
          if (mt * 16 < tc) {
              f32x4 ca = {0.f, 0.f, 0.f, 0.f}, cx = {0.f, 0.f, 0.f, 0.f};
#pragma unroll
              for (int kk = 0; kk < 2; ++kk) { const pg8::bf16x8 av = *(const LAS pg8::bf16x8*)(XCB + (mt * 16 + fr) * 72 + kk * 32 + fq * 8);
                  ca = __builtin_amdgcn_mfma_f32_16x16x32_bf16(av, *(const LAS pg8::bf16x8*)(WAT + (nq * 16 + fr) * 72 + kk * 32 + fq * 8), ca, 0, 0, 0);
                  cx = __builtin_amdgcn_mfma_f32_16x16x32_bf16(av, *(const LAS pg8::bf16x8*)(WXT + (nq * 16 + fr) * 72 + kk * 32 + fq * 8), cx, 0, 0, 0); }
#pragma unroll
              for (int j = 0; j < 4; ++j) { const int o = (mt * 16 + fq * 4 + j) * 64 + nq * 16 + fr; RA[o] = ca[j]; RI[o] = cx[j]; } } }
        LDS_BARRIER();
        if (st < tc) {
            const f32x4 ra = *(const LAS f32x4*)(RA + st * 64 + d4), ri = *(const LAS f32x4*)(RI + st * 64 + d4);
            float av[4], bv[4];
#pragma unroll
            for (int i = 0; i < 4; ++i) { const float rg = sigm(ra[i] + ba[i]), ig = sigm(ri[i] + bx[i]); const float la = -8.f * rg * sp[i]; av[i] = __expf(la); bv[i] = sqrtf(1.f - __expf(2.f * la)) * (ig * xc[i]); }
            *(LAS f32x4*)(AA + st * 64 + d4) = (f32x4){av[0], av[1], av[2], av[3]}; *(LAS f32x4*)(BB + st * 64 + d4) = (f32x4){bv[0], bv[1], bv[2], bv[3]};
        }
        if (t0 + 32 + st < T) lru_prefetch(P, PROJ, cst, smp, row0, t0 + 32 + st, ch);
        LDS_BARRIER();
        if (wave == 0) { float ar[32], br[32];
#pragma unroll
            for (int t = 0; t < 32; ++t) { ar[t] = AA[t * 64 + lane]; br[t] = BB[t * 64 + lane]; }
            float hh = hprev;
#pragma unroll
            for (int t = 0; t < 32; ++t) { if (t < tc) { hh = ar[t] * hh + br[t]; br[t] = hh; } }
#pragma unroll
            for (int t = 0; t < 32; ++t) HS[t * 64 + lane] = br[t];
            hprev = hh; }
        LDS_BARRIER();
        if (st < tc) { const f32x4 hs = *(const LAS f32x4*)(HS + st * 64 + d4);
            *(v2u*)(BR + (size_t)grow * 2048 + 1536 + ch) = pack4(hs[0] * gl[0], hs[1] * gl[1], hs[2] * gl[2], hs[3] * gl[3]); }
        LR_PF_WAIT(P);
    }
    if (wave == 0) a.out[(smp ? O_LH_S : O_LH_P) + (size_t)(l * Bg + bo) * 512 + n * 64 + lane] = hprev;
    if (tid < 192) { const int i = tid >> 6, c = tid & 63; a.out[(smp ? O_LC_S : O_LC_P) + ((size_t)(l * Bg + bo) * 3 + i) * 512 + n * 64 + c] = bf2f(PROJ[(size_t)(row0 + T - 3 + i) * INC + 4864 + n * 64 + c]); }
    __syncthreads();
}

template <int TC> __device__ __forceinline__ void cf_unit(LAS unsigned char* lds, const MArgs& a, int tid_in, int l, int seq, int t0, int tc) {
    SEQ_SETUP
    const int tid = tid_in, lane = tid & 63, wave = tid >> 6, c = tid;
    const bf16* PROJ = (const bf16*)(a.ws + WS_BIG); bf16* BR = (bf16*)(a.ws + WS_BR);
    LAS float* U = (LAS float*)lds;
    const float* cst = INP(I_SCV) + (size_t)(l * 128 + (smp ? bs : 0)) * 30 * 512;
    constexpr int NR = TC + 30, NP = (NR + 7) / 8;
    { v4u va[NP], vg[NP];
#pragma unroll
      for (int k = 0; k < NP; ++k) { const int i = wave + 8 * k, tt = t0 - 30 + i;
          if (i < tc + 30 && tt >= 0) { const bf16* p = PROJ + (size_t)(row0 + tt) * INC + 3840 + lane * 8; va[k] = *(const v4u*)p; vg[k] = *(const v4u*)(p + 512); } }
#pragma unroll
      for (int k = 0; k < NP; ++k) { const int i = wave + 8 * k, tt = t0 - 30 + i;
          if (i < tc + 30) { float u[8];
              if (tt >= 0) { float x[8], g[8]; unpack8(va[k], x); unpack8(vg[k], g);
#pragma unroll
                  for (int j = 0; j < 8; ++j) u[j] = x[j] * g[j]; }
              else if (smp) { const float* q = cst + (30 + tt) * 512 + lane * 8; const f32x4 q0 = *(const f32x4*)q, q1 = *(const f32x4*)(q + 4);
                  u[0] = q0[0]; u[1] = q0[1]; u[2] = q0[2]; u[3] = q0[3]; u[4] = q1[0]; u[5] = q1[1]; u[6] = q1[2]; u[7] = q1[3]; }
              else {
#pragma unroll
                  for (int j = 0; j < 8; ++j) u[j] = 0.f; }
              *(LAS f32x4*)(U + i * 512 + lane * 8) = (f32x4){u[0], u[1], u[2], u[3]}; *(LAS f32x4*)(U + i * 512 + lane * 8 + 4) = (f32x4){u[4], u[5], u[6], u[7]}; } } }
    float w[31];
#pragma unroll
    for (int j = 0; j < 31; ++j) w[j] = INP(I_CFDW)[(size_t)(l * 31 + j) * 512 + c];
    const float bias = INP(I_CFDWB)[l * 512 + c];
    __syncthreads();
    { float acc[TC];
#pragma unroll
      for (int t = 0; t < TC; ++t) acc[t] = bias;
#pragma unroll
      for (int i = 0; i < NR; ++i) { const float u = U[i * 512 + c];
#pragma unroll
          for (int t = 0; t < TC; ++t) { if (i - t >= 0 && i - t <= 30) acc[t] += u * w[i - t]; } }
#pragma unroll
      for (int t = 0; t < TC; ++t) { if (t < tc) U[t * 512 + c] = acc[t]; } }
    if (t0 + tc == T) { float* so = a.out + (smp ? O_CV_S : O_CV_P) + (size_t)(l * Bg + bo) * 30 * 512 + c;
#pragma unroll 6
        for (int i = 0; i < 30; ++i) so[i * 512] = U[(tc + i) * 512 + c]; }
    __syncthreads();
    for (int t = wave; t < tc; t += 8) {
        const f32x4 x0 = *(const LAS f32x4*)(U + t * 512 + lane * 8), x1 = *(const LAS f32x4*)(U + t * 512 + lane * 8 + 4);
        const float mean = wave_sum((x0[0] + x0[1]) + (x0[2] + x0[3]) + (x1[0] + x1[1]) + (x1[2] + x1[3])) * (1.f / 512.f);
        float d[8] = {x0[0] - mean, x0[1] - mean, x0[2] - mean, x0[3] - mean, x1[0] - mean, x1[1] - mean, x1[2] - mean, x1[3] - mean};
        float q = 0.f;
#pragma unroll
        for (int j = 0; j < 8; ++j) q += d[j] * d[j];
        const float rstd = rsqrtf(wave_sum(q) * (1.f / 512.f) + 1e-5f);
        const float* g = INP(I_CFLG) + l * 512 + lane * 8; const float* b = INP(I_CFLB) + l * 512 + lane * 8;
#pragma unroll
        for (int j = 0; j < 8; ++j) d[j] = silu_(d[j] * rstd * g[j] + b[j]);
        *(v4u*)(BR + (size_t)(row0 + t0 + t) * 2048 + 1024 + lane * 8) = pack8(d);
    }
    __syncthreads();
}

__device__ __forceinline__ void phase_mixers(const Args& a, int l, LAS unsigned char* lds, int rep = 0, int ulo = 0, int uhi = 3968, int mode = 0) {
    unsigned* ctr = (unsigned*)(a.ws + WS_CTL) + 64 * (1 + l + 2 * rep);
    volatile LAS unsigned* slot = (volatile LAS unsigned*)(lds + MISC_OFF);
    for (;;) {
        if (threadIdx.x == 0) slot[0] = atomicAdd(ctr, 1u);
        __syncthreads();
        const int u = (int)slot[0] + ulo;
        __syncthreads();
        if (u >= uhi) break;
        int kind, seq, p1, p2 = 0;
        if (u < 128) { kind = 0; seq = u >> 4; p1 = (u >> 1) & 7; p2 = u & 1; }
        else if (u < 192) { const int v = u - 128; kind = 1; seq = v >> 3; p1 = (v >> 1) & 3; p2 = v & 1; }
        else if (u < 256) { const int v = u - 192; kind = 2; seq = v >> 3; p1 = v & 7; }
        else if (u < 768) { const int v = u - 256; kind = 3; seq = v >> 6; p1 = (v & 63) * 32; p2 = 32; }
        else if (u < 1792) { const int v = u - 768; kind = 1; seq = 8 + (v >> 3); p1 = (v >> 1) & 3; p2 = v & 1; }
        else if (u < 2816) { const int v = u - 1792; kind = 0; seq = 8 + (v >> 3); p1 = v & 7; p2 = 0; }
        else if (u < 3840) { const int v = u - 2816; kind = 2; seq = 8 + (v >> 3); p1 = v & 7; }
        else { const int v = u - 3840; kind = 3; seq = 8 + v; p1 = 0; p2 = 8; }
        MArgs m; m.out = a.out; m.ws = a.ws; int ll = l;
        int tl = threadIdx.x;
        int md = mode;
        asm volatile("" : "+s"(m.out), "+s"(m.ws), "+s"(ll), "+v"(tl), "+s"(md));
        if (kind == 0) { if (seq < 8) rwkv_unit_pc(lds, m, tl, ll, seq, p1, p2); else rwkv_unit(lds, m, tl, ll, seq, p1, p2, md); }
        else if (kind == 1) hg_unit(lds, m, tl, ll, seq, p1, p2, md);
        else if (kind == 2) lru_unit(lds, m, tl, ll, seq, p1);
        else cf_unit<32>(lds, m, tl, ll, seq, p1, p2);
    }
}

#define XB_TMO      128
#define XB_XCNT(j)  (256  + 64 * (j))
#define XB_XSUB(j)  (1280 + 64 * (j))
#define XB_XGEN(j)  (2304 + 64 * (j))
#define XB_TOP      3328
#define XB_TOPGEN   3392
#define XCD_BAR_WORDS 3456
#define XB_SPIN_CAP (1u << 18)

__device__ __forceinline__ unsigned xb_ld(unsigned* p)              { return __hip_atomic_load(p, __ATOMIC_RELAXED, __HIP_MEMORY_SCOPE_AGENT); }
__device__ __forceinline__ unsigned xb_add(unsigned* p, unsigned v) { return __hip_atomic_fetch_add(p, v, __ATOMIC_RELAXED, __HIP_MEMORY_SCOPE_AGENT); }
__device__ __forceinline__ unsigned xb_xcc_id() { return (unsigned)__builtin_amdgcn_s_getreg((3 << 11) | 20) & 0xFu; }
#define XB_SPIN(cond, bar) do { unsigned _sp = 0; while (cond) { __builtin_amdgcn_s_sleep(1); \
    if ((++_sp & 255u) == 0u) { if (xb_ld(&(bar)[XB_TMO])) break; if (_sp > XB_SPIN_CAP) { atomicAdd(&(bar)[XB_TMO], 1u); break; } } } } while (0)

struct XcdBarrier {
    unsigned* bar; unsigned x;
    volatile LAS unsigned* st;
};

__device__ __forceinline__ XcdBarrier xcd_barrier_post(unsigned* bar, volatile LAS unsigned* st) {
    XcdBarrier b; b.bar = bar; b.x = xb_xcc_id(); b.st = st;
    if (threadIdx.x == 0) (void)xb_add(&bar[XB_XCNT(b.x)], 1u);
    return b;
}
__device__ __forceinline__ void xcd_barrier_complete(unsigned* bar, unsigned x, unsigned& nloc, unsigned& nx) {
    const unsigned G = gridDim.x * gridDim.y * gridDim.z;
    unsigned sum, cnt, mine, sp = 0u;
    for (;;) {
        sum = 0u; cnt = 0u; mine = 0u;
#pragma unroll
        for (unsigned j = 0; j < 16; ++j) { const unsigned c = xb_ld(&bar[XB_XCNT(j)]); sum += c; cnt += (c > 0u) ? 1u : 0u; mine = (j == x) ? c : mine; }
        if (sum == G) break;
        __builtin_amdgcn_s_sleep(1);
        if ((++sp & 255u) == 0u) { if (xb_ld(&bar[XB_TMO])) break; if (sp > XB_SPIN_CAP) { atomicAdd(&bar[XB_TMO], 1u); break; } }
    }
    nloc = mine > 0u ? mine : 1u; nx = cnt > 0u ? cnt : 1u;
}

__device__ __forceinline__ void xcd_barrier(const XcdBarrier& b) {
    asm volatile("s_waitcnt vmcnt(0)" ::: "memory");
    __syncthreads();
    if (threadIdx.x == 0) {
        unsigned* bar = b.bar;
        __builtin_amdgcn_s_waitcnt(0);
        unsigned nloc = b.st[0], nx = b.st[1];
        if (nloc == 0u) { xcd_barrier_complete(bar, b.x, nloc, nx); b.st[0] = nloc; b.st[1] = nx; }
        const unsigned old = xb_add(&bar[XB_XSUB(b.x)], 1u);
        const unsigned gen = old / nloc;
        if (old + 1u == (gen + 1u) * nloc) {
            __builtin_amdgcn_fence(__ATOMIC_RELEASE, "agent");
            asm volatile("s_waitcnt vmcnt(0)" ::: "memory");
            const unsigned og = xb_add(&bar[XB_TOP], 1u);
            const unsigned tg = og / nx;
            if (og + 1u == (tg + 1u) * nx) xb_add(&bar[XB_TOPGEN], 1u);
            else XB_SPIN(xb_ld(&bar[XB_TOPGEN]) == tg, bar);
            __builtin_amdgcn_fence(__ATOMIC_ACQUIRE, "agent");
            xb_add(&bar[XB_XGEN(b.x)], 1u);
            asm volatile("s_waitcnt vmcnt(0)" ::: "memory");
        } else {
            XB_SPIN(xb_ld(&bar[XB_XGEN(b.x)]) == gen, bar);
            __builtin_amdgcn_fence(__ATOMIC_ACQUIRE, "agent");
            asm volatile("s_waitcnt vmcnt(0)" ::: "memory");
        }
    }
    __syncthreads();
}

constexpr int N_PHASES = 21;
#define IN(k) (a.ph_lo <= (k) && (k) < a.ph_hi)
#define SEAM(k) do { if (IN(k) && IN((k) + 1)) { if (a.ph_hi == 0x7fffffff) cg::this_grid().sync(); xcd_barrier(xbar); } } while (0)
template <int l> __device__ __forceinline__ void layer_phases(const Args& a, LAS unsigned char* lds, int G, int gw, int NGW, int wave, int lane, const XcdBarrier& xbar) {
    constexpr int P = 2 + 9 * l;
    const bf16* H = (const bf16*)(a.ws + WS_H);
    const float* MODL = (const float*)(a.ws + WS_MOD) + l * 6144;
    if (IN(P + 0)) { if (l == 1) phase_conv_layer(a, 1, lds, gw, NGW, wave, lane, G > 80 ? 6528 : 0, 10624); phase_norm(a, l, 0, gw, NGW, lane); }
    SEAM(P + 0);
    const bool fuse13 = G == 256 && IN(P + 1) && IN(P + 3) && IN(P + 4);
    if (IN(P + 1)) {
        pg8::Gemm g{H, (const pg8::bf16_t*)(a.ws + WS_WIN), NTOK, INC, 1024}; pg8::StaticOrder S; S.init(NTOK, INC, G, (int)blockIdx.x);
        pg8::EpiProj E{(pg8::bf16_t*)(a.ws + WS_BIG), INP(I_HGL), l};
        pg8::gemm_phase<pg8::EpiProj, pg8::StaticOrder, true, true>(lds, g, S, E);
        if (fuse13 && (int)blockIdx.x >= 28 && (int)blockIdx.x < 92) {
            pg8::Gemm g2{H + (size_t)NPR * 1024, (const pg8::bf16_t*)(a.ws + WS_WG), NTOK - NPR, 4096, 1024}; pg8::StaticOrder S2; S2.init(NTOK - NPR, 4096, 64, (int)blockIdx.x - 28);
            pg8::EpiGate E2{(pg8::bf16_t*)(a.ws + WS_GS), INP(I_BGATE) + l * 4096};
            pg8::gemm_phase<pg8::EpiGate, pg8::StaticOrder, true, true>(lds, g2, S2, E2);
        }
    }
    SEAM(P + 1);
#ifdef PROBE_MIX
    if (IN(P + 2)) { phase_mixers(a, l, lds); xcd_barrier(xbar); phase_mixers(a, l, lds, 1, PROBE_LO, PROBE_HI, PROBE_MODE); }
#else
    if (IN(P + 2)) phase_mixers(a, l, lds);
#endif
    SEAM(P + 2);
    if (IN(P + 3)) {
        phase_hg_post(a, gw, NGW, lane);
        const int Mg = fuse13 ? NPR : NTOK;
        pg8::Gemm g{H, (const pg8::bf16_t*)(a.ws + WS_WG), Mg, 4096, 1024}; pg8::StaticOrder S; S.init(Mg, 4096, G, (int)blockIdx.x);
        pg8::EpiGate E{(pg8::bf16_t*)(a.ws + WS_BIG), INP(I_BGATE) + l * 4096};
        pg8::gemm_phase<pg8::EpiGate, pg8::StaticOrder, true, true>(lds, g, S, E);
    }
    SEAM(P + 3);
    if (IN(P + 4)) {
        pg8::Gemm g{(const pg8::bf16_t*)(a.ws + WS_BR), (const pg8::bf16_t*)(a.ws + WS_WB), NTOK, 1024, 2048}; pg8::StaticOrder S; S.init(NTOK, 1024, G, (int)blockIdx.x);
        pg8::EpiBranch E{(pg8::bf16_t*)(a.ws + WS_G), (const pg8::bf16_t*)(a.ws + WS_BIG), fuse13 ? (const pg8::bf16_t*)(a.ws + WS_GS) - (size_t)NPR * 4096 : (const pg8::bf16_t*)(a.ws + WS_BIG)};
        pg8::gemm_phase<pg8::EpiBranch, pg8::StaticOrder, true, true>(lds, g, S, E);
    }
    SEAM(P + 4);
    if (IN(P + 5)) {
        pg8::Gemm g{(const pg8::bf16_t*)(a.ws + WS_G), (const pg8::bf16_t*)(a.ws + WS_WO), NTOK, 1024, 1024}; pg8::StaticOrder S; S.init(NTOK, 1024, G, (int)blockIdx.x);
        pg8::EpiRes E{a.out, l == 0 ? INP(I_XP) : a.out, l == 0 ? INP(I_XS) : a.out + (size_t)NPR * 1024, MODL + 2048, 0};
        pg8::gemm_phase<pg8::EpiRes, pg8::StaticOrder, true, true>(lds, g, S, E);
    }
    SEAM(P + 5);
    const bool fuse67 = G > 64 && IN(P + 6) && IN(P + 7) && IN(P + 8);
    if (IN(P + 6)) {
        if (fuse67) {
            phase_norm(a, l, 1, gw, NGW, lane, NPR, NTOK);
            xcd_barrier(xbar);
            if ((int)blockIdx.x < 64) {
                pg8::Gemm g{H + (size_t)NPR * 1024, (const pg8::bf16_t*)(a.ws + WS_W1), NTOK - NPR, 4096, 1024}; pg8::StaticOrder S; S.init(NTOK - NPR, 4096, 64, (int)blockIdx.x);
                pg8::EpiRelu2 E{(pg8::bf16_t*)(a.ws + WS_BIG) + (size_t)NPR * 4096};
                pg8::gemm_phase<pg8::EpiRelu2, pg8::StaticOrder, true, true>(lds, g, S, E);
            } else phase_norm(a, l, 1, ((int)blockIdx.x - 64) * 8 + wave, (G - 64) * 8, lane, 0, NPR);
        } else phase_norm(a, l, 1, gw, NGW, lane);
    }
    SEAM(P + 6);
    if (IN(P + 7)) {
        const pg8::bf16_t* W1 = (const pg8::bf16_t*)(a.ws + WS_W1); pg8::bf16_t* U = (pg8::bf16_t*)(a.ws + WS_BIG);
        if (G > 16 && IN(P + 8)) {
            if (!fuse67) {
              { pg8::Gemm g{H + (size_t)NPR * 1024, W1, NTOK - NPR, 4096, 1024}; pg8::StaticOrder S; S.init(NTOK - NPR, 4096, G, (int)blockIdx.x);
                pg8::EpiRelu2 E{U + (size_t)NPR * 4096};
                pg8::gemm_phase<pg8::EpiRelu2, pg8::StaticOrder, true, true>(lds, g, S, E); }
              xcd_barrier(xbar);
            }
            if ((int)blockIdx.x < 16) {
                pg8::Gemm g{U + (size_t)NPR * 4096, (const pg8::bf16_t*)(a.ws + WS_W2), NTOK - NPR, 1024, 4096}; pg8::StaticOrder S; S.init(NTOK - NPR, 1024, 16, (int)blockIdx.x);
                pg8::EpiRes E{a.out, a.out, a.out + (size_t)NPR * 1024, MODL + 5120, NPR};
                pg8::gemm_phase<pg8::EpiRes, pg8::StaticOrder, true, true>(lds, g, S, E);
            } else {
                pg8::Gemm g{H, W1, NPR, 4096, 1024}; pg8::StaticOrder S; S.init(NPR, 4096, G - 16, (int)blockIdx.x - 16);
                pg8::EpiRelu2 E{U};
                pg8::gemm_phase<pg8::EpiRelu2, pg8::StaticOrder, true, true>(lds, g, S, E);
                if (l == 0 && (int)blockIdx.x >= 80 && G > 80)
                    phase_conv_layer(a, 1, lds, ((int)blockIdx.x - 80) * 8 + wave, (G - 80) * 8, wave, lane, 0, 6528);
            }
        } else {
            pg8::Gemm g{H, W1, NTOK, 4096, 1024}; pg8::StaticOrder S; S.init(NTOK, 4096, G, (int)blockIdx.x);
            pg8::EpiRelu2 E{U};
            pg8::gemm_phase<pg8::EpiRelu2, pg8::StaticOrder, true, true>(lds, g, S, E);
        }
    }
    SEAM(P + 7);
    if (IN(P + 8)) {
        const int Mrows = (G > 16 && IN(P + 7)) ? NPR : NTOK;
        pg8::Gemm g{(const pg8::bf16_t*)(a.ws + WS_BIG), (const pg8::bf16_t*)(a.ws + WS_W2), Mrows, 1024, 4096}; pg8::StaticOrder S; S.init(Mrows, 1024, G, (int)blockIdx.x);
        pg8::EpiRes E{a.out, a.out, a.out + (size_t)NPR * 1024, MODL + 5120, 0};
        pg8::gemm_phase<pg8::EpiRes, pg8::StaticOrder, true, true>(lds, g, S, E);
    }
    SEAM(P + 8);
}
__global__ void __launch_bounds__(512, 2) mega(Args a) {
    LAS unsigned char* lds = (LAS unsigned char*)lds_raw;
    const int tid = threadIdx.x, lane = tid & 63, wave = __builtin_amdgcn_readfirstlane(tid >> 6);
    const int G = gridDim.x, gw = blockIdx.x * 8 + wave, NGW = G * 8;
    if (tid == 0) {
#pragma unroll
        for (int i = 0; i < 46; ++i) *(LAS unsigned long long*)(lds + TAB_OFF + 8 * i) = (unsigned long long)a.in[i];
        *(LAS unsigned*)(lds + MISC_OFF + 32) = 0u; *(LAS unsigned*)(lds + MISC_OFF + 36) = 0u;
    }
    __syncthreads();
    XcdBarrier xbar; xbar.bar = (unsigned*)(a.ws + WS_CTL) + 4096; xbar.x = 0; xbar.st = (volatile LAS unsigned*)(lds + MISC_OFF + 32);
    if (a.ph_hi - a.ph_lo > 1) xbar = xcd_barrier_post((unsigned*)(a.ws + WS_CTL) + 4096, (volatile LAS unsigned*)(lds + MISC_OFF + 32));
    if (IN(0)) phase_conv_ada(a, lds, gw, NGW, wave, lane);
    SEAM(0);
    if (IN(1)) {
        pg8::Gemm g{(const pg8::bf16_t*)(a.ws + WS_CA), (const pg8::bf16_t*)(a.ws + WS_BIG), 256, 12288, 1024}; pg8::StaticOrder S; S.init(256, 12288, G, (int)blockIdx.x);
        pg8::EpiMod E{(float*)(a.ws + WS_MOD), INP(I_ADAB)};
        pg8::gemm_phase<pg8::EpiMod, pg8::StaticOrder, true, true>(lds, g, S, E);
        if ((int)blockIdx.x >= 48 && G > 48)
            phase_conv_layer(a, 0, lds, ((int)blockIdx.x - 48) * 8 + wave, (G - 48) * 8, wave, lane, 0, 10624);
        else if (G <= 48) phase_conv_layer(a, 0, lds, gw, NGW, wave, lane, 0, 10624);
    }
    SEAM(1);
    layer_phases<0>(a, lds, G, gw, NGW, wave, lane, xbar);
    layer_phases<1>(a, lds, G, gw, NGW, wave, lane, xbar);
#ifdef PROBE_SYNC
    for (int i = 0; i < 40; ++i) xcd_barrier(xbar);
#endif
    if (IN(20)) phase_final(a, gw, NGW, lane);
}

extern "C" void kernel_launch(void* const* d_in, const int* in_sizes, int n_in, void* d_out, int out_size, void* d_ws, size_t ws_size, hipStream_t stream) {
    static int grid = 0;
    if (grid == 0) {
        if (n_in != 46 || ws_size < WS_END) { fprintf(stderr, "kernel_launch: bad n_in %d or ws %zu (< %zu)\n", n_in, ws_size, (size_t)WS_END); grid = -1; return; }
        (void)hipFuncSetAttribute((const void*)mega, hipFuncAttributeMaxDynamicSharedMemorySize, LDS_BYTES);
        int dev = 0, cus = 0, per_cu = 0;
        (void)hipGetDevice(&dev); (void)hipDeviceGetAttribute(&cus, hipDeviceAttributeMultiprocessorCount, dev);
        (void)hipOccupancyMaxActiveBlocksPerMultiprocessor(&per_cu, (const void*)mega, 512, LDS_BYTES);
        if (per_cu < 1) fprintf(stderr, "kernel_launch: occupancy query says %d\n", per_cu);
        (void)hipGetLastError();
        grid = cus > 0 ? cus : 256;
    }
    if (grid < 0) return;
    (void)hipMemsetAsync((char*)d_ws + WS_CTL, 0, CTL_BYTES, stream);
    Args a{};
    for (int i = 0; i < 46; ++i) a.in[i] = (const float*)d_in[i];
    a.out = (float*)d_out; a.ws = (unsigned char*)d_ws;
#if MK_SINGLE
    a.ph_lo = 0; a.ph_hi = N_PHASES;
    void* args[] = {&a};
    hipError_t e = hipLaunchCooperativeKernel((const void*)mega, dim3(grid), dim3(512), args, LDS_BYTES, stream);
    if (e != hipSuccess) fprintf(stderr, "cooperative launch failed: %s (grid %d)\n", hipGetErrorString(e), grid);
#else
    for (int ph = 0; ph < N_PHASES; ++ph) { a.ph_lo = ph; a.ph_hi = ph + 1; hipLaunchKernelGGL(mega, dim3(grid), dim3(512), LDS_BYTES, stream, a); }
#endif
}
```
